# Optimizing an MI355X kernel written in HIP

```python
import math
import jax
import jax.numpy as jnp
from jax import lax
import numpy as np

D_MODEL = 1024
BATCH = 8
SEQ = 4096
DEPTH = 4

CTX_LEN = 256
GRID_W = 64
HEAD_DIM = 64
DN_HEADS = 4
GA_HEADS = 4
GA_KV_HEADS = 2
WA_HEADS = 4
WA_KV_HEADS = 2
FT_GROUPS = 4
FT_GROUP_DIM = 64
D_MIX = (DN_HEADS + GA_HEADS + WA_HEADS) * HEAD_DIM + FT_GROUPS * FT_GROUP_DIM
DN_DIM = DN_HEADS * HEAD_DIM
DN_COLS = 4 * DN_DIM + 4 * DN_HEADS
GA_COLS = (GA_HEADS + 2 * GA_KV_HEADS) * HEAD_DIM
WA_COLS = (WA_HEADS + 2 * WA_KV_HEADS) * HEAD_DIM
FT_COLS = FT_GROUPS * FT_GROUP_DIM
IN_COLS = DN_COLS + GA_COLS + WA_COLS + FT_COLS
CONV_W = 3
DN_CHUNK = 64
Q_BLOCK = 128
WINDOW = 128
ROPE_THETA = 10000.0
FFN_HIDDEN = 256 * math.ceil(8 * D_MODEL / (3 * 256))
N_MOD = 6
EPS = 1e-6
NEG_INF = -1e30

kernel_name = 'hybrid_dit_deltanet_gqa_window_fourier'


def _split(t, sizes):
    return jnp.split(t, [int(s) for s in np.cumsum(sizes)[:-1]], axis=-1)


def rms_norm(t, gain):
    tf = t.astype(jnp.float32)
    y = tf * lax.rsqrt(jnp.mean(tf * tf, -1, keepdims=True) + EPS)
    return (y * gain.astype(jnp.float32)).astype(t.dtype)


def l2_normalize(t):
    return t * lax.rsqrt(jnp.sum(t * t, -1, keepdims=True) + EPS)


def modulate(h, shift, scale):
    return h * (1 + scale) + shift


def swiglu(h, w_gate, w_up, w_down):
    return (jax.nn.silu(h @ w_gate) * (h @ w_up)) @ w_down


def axial_rope(n_tokens):
    rows = n_tokens // GRID_W
    row = jnp.repeat(jnp.arange(rows, dtype=jnp.float32), GRID_W)
    col = jnp.tile(jnp.arange(GRID_W, dtype=jnp.float32), rows)
    n_freq = HEAD_DIM // 4
    inv_freq = ROPE_THETA ** (-jnp.arange(n_freq, dtype=jnp.float32) / n_freq)
    ang = jnp.concatenate([row[:, None] * inv_freq, col[:, None] * inv_freq], -1)
    return jnp.cos(ang), jnp.sin(ang)


def apply_rope(t, cos, sin):
    tf = t.astype(jnp.float32)
    t1, t2 = tf[..., :HEAD_DIM // 2], tf[..., HEAD_DIM // 2:]
    cs, sn = cos[:, None, :], sin[:, None, :]
    return jnp.concatenate([t1 * cs - t2 * sn, t1 * sn + t2 * cs], -1).astype(t.dtype)


def short_conv(t, w):
    r = CONV_W // 2
    n = t.shape[1]
    tp = jnp.pad(t, ((0, 0), (r, r), (0, 0)))
    out = tp[:, 0:n] * w[0]
    for j in range(1, CONV_W):
        out = out + tp[:, j:j + n] * w[j]
    return out


def deltanet_prep(p, conv_w, A_log, dt_bias):
    B, S, _ = p.shape
    qkv, z, a, b = _split(p, [3 * DN_DIM, DN_DIM, 2 * DN_HEADS, 2 * DN_HEADS])
    qkv = jax.nn.silu(short_conv(qkv, conv_w)).astype(jnp.float32)
    q, k, v = [t.reshape(B, S, DN_HEADS, HEAD_DIM) for t in jnp.split(qkv, 3, -1)]
    q = l2_normalize(q) * HEAD_DIM ** -0.5
    k = l2_normalize(k)
    a = a.astype(jnp.float32).reshape(B, S, 2, DN_HEADS)
    b = b.astype(jnp.float32).reshape(B, S, 2, DN_HEADS)
    g = -jnp.exp(A_log.astype(jnp.float32)) * jax.nn.softplus(a + dt_bias.astype(jnp.float32))
    beta = jax.nn.sigmoid(b)
    return q, k, v, g, beta, z


def gated_delta_chunked(q, k, v, g, beta, state0):
    B, S, H, dk = q.shape
    dv = v.shape[-1]
    C = DN_CHUNK
    N = S // C

    def chunks(t):
        t = t.reshape((B, N, C, H) + t.shape[3:])
        return jnp.moveaxis(t, (1, 3), (0, 2))

    qc, kc, vc, gc, bc = [chunks(t) for t in (q, k, v, g, beta)]
    gcum = jnp.cumsum(gc, -1)
    idx = jnp.arange(C)
    incl = idx[:, None] >= idx[None, :]
    strict = idx[:, None] > idx[None, :]
    decay = jnp.exp(jnp.where(incl, gcum[..., :, None] - gcum[..., None, :], NEG_INF))
    kb = kc * bc[..., None]
    a_mat = jnp.where(strict, jnp.einsum('nbhid,nbhjd->nbhij', kb, kc) * decay, 0.0)
    rhs = jnp.concatenate([vc * bc[..., None], kb * jnp.exp(gcum)[..., None]], -1)
    sol = lax.linalg.triangular_solve(a_mat, rhs, left_side=True, lower=True, unit_diagonal=True)
    u, w = sol[..., :dv], sol[..., dv:]
    intra = jnp.where(incl, jnp.einsum('nbhid,nbhjd->nbhij', qc, kc) * decay, 0.0)
    q_dec = qc * jnp.exp(gcum)[..., None]
    k_dec = kc * jnp.exp(gcum[..., -1:] - gcum)[..., None]
    g_end = jnp.exp(gcum[..., -1])

    def step(state, xs):
        q_i, a_i, u_i, w_i, k_i, ge_i = xs
        v_new = u_i - jnp.einsum('bhcd,bhde->bhce', w_i, state)
        o_i = jnp.einsum('bhcd,bhde->bhce', q_i, state) + jnp.einsum('bhij,bhje->bhie', a_i, v_new)
        state = state * ge_i[..., None, None] + jnp.einsum('bhcd,bhce->bhde', k_i, v_new)
        return state, o_i

    state, o = lax.scan(step, state0, (q_dec, intra, u, w, k_dec, g_end))
    o = jnp.moveaxis(o, (0, 2), (1, 3)).reshape(B, S, H, dv)
    return o, state


def _flip(t, direction):
    return jnp.flip(t, 1) if direction == 1 else t


def gated_head_out(o, z, norm_g):
    B, S = o.shape[:2]
    zh = z.reshape(B, S, DN_HEADS, HEAD_DIM).astype(jnp.float32)
    return (rms_norm(o, norm_g) * jax.nn.silu(zh)).reshape(B, S, DN_DIM).astype(z.dtype)


def deltanet_mixer(p, pc, conv_w, A_log, dt_bias, norm_g, with_ctx):
    q, k, v, g, beta, z = deltanet_prep(p, conv_w, A_log, dt_bias)
    qc, kc, vc, gc, bc, zc = deltanet_prep(pc, conv_w, A_log, dt_bias)
    zero = jnp.zeros((p.shape[0], DN_HEADS, HEAD_DIM, HEAD_DIM), jnp.float32)
    o_lat, o_ctx = [], []
    for d in range(2):
        oc, state = gated_delta_chunked(_flip(qc, d), _flip(kc, d), _flip(vc, d),
                                        _flip(gc[:, :, d], d), _flip(bc[:, :, d], d), zero)
        ol, _ = gated_delta_chunked(_flip(q, d), _flip(k, d), _flip(v, d),
                                    _flip(g[:, :, d], d), _flip(beta[:, :, d], d), state)
        o_lat.append(_flip(ol, d))
        o_ctx.append(_flip(oc, d))
    y = gated_head_out(o_lat[0] + o_lat[1], z, norm_g)
    yc = gated_head_out(o_ctx[0] + o_ctx[1], zc, norm_g) if with_ctx else None
    return y, yc


def attn_heads(p, n_q, n_kv, q_gain, k_gain, rope):
    B, S, _ = p.shape
    q, k, v = _split(p, [n_q * HEAD_DIM, n_kv * HEAD_DIM, n_kv * HEAD_DIM])
    q = rms_norm(q.reshape(B, S, n_q, HEAD_DIM), q_gain)
    k = rms_norm(k.reshape(B, S, n_kv, HEAD_DIM), k_gain)
    v = v.reshape(B, S, n_kv, HEAD_DIM)
    if rope is not None:
        q = apply_rope(q, *rope)
        k = apply_rope(k, *rope)
    return q, k, v


def context_attention(qc, kc, vc, sink=None):
    B, L, Hq, d = qc.shape
    Hkv = kc.shape[2]
    G = Hq // Hkv
    qg = qc.reshape(B, L, Hkv, G, d)
    s = jnp.einsum('bqhgd,bkhd->bhgqk', qg, kc, preferred_element_type=jnp.float32) * d ** -0.5
    if sink is not None:
        sink_col = jnp.broadcast_to(sink.reshape(1, Hkv, G, 1, 1).astype(jnp.float32), s.shape[:-1] + (1,))
        s = jnp.concatenate([s, sink_col], -1)
    p = jax.nn.softmax(s, -1)[..., :L].astype(vc.dtype)
    return jnp.einsum('bhgqk,bkhd->bqhgd', p, vc).reshape(B, L, Hq * d)


def global_attention(q, k, v, kc, vc):
    B, S, Hq, d = q.shape
    Hkv = k.shape[2]
    G = Hq // Hkv
    nb = S // Q_BLOCK
    keys = jnp.concatenate([kc, k], 1)
    vals = jnp.concatenate([vc, v], 1)
    qb = jnp.moveaxis(q.reshape(B, nb, Q_BLOCK, Hkv, G, d), 1, 0)

    def one_block(qi):
        s = jnp.einsum('bqhgd,bkhd->bhgqk', qi, keys, preferred_element_type=jnp.float32) * d ** -0.5
        p = jax.nn.softmax(s, -1).astype(vals.dtype)
        return jnp.einsum('bhgqk,bkhd->bqhgd', p, vals)

    o = lax.map(one_block, qb)
    return jnp.moveaxis(o, 0, 1).reshape(B, S, Hq * d)


def window_attention(q, k, v, kc, vc, sink):
    B, S, Hq, d = q.shape
    Hkv = k.shape[2]
    G = Hq // Hkv
    L = kc.shape[1]
    nb = S // Q_BLOCK
    band = 3 * Q_BLOCK

    def bands(t):
        tp = jnp.pad(t, ((0, 0), (Q_BLOCK, Q_BLOCK), (0, 0), (0, 0))).reshape(B, nb + 2, Q_BLOCK, Hkv, d)
        return jnp.concatenate([tp[:, :-2], tp[:, 1:-1], tp[:, 2:]], axis=2)

    kb, vb = bands(k), bands(v)
    qb = q.reshape(B, nb, Q_BLOCK, Hkv, G, d)
    scale = d ** -0.5
    s_loc = jnp.einsum('bnqhgd,bnkhd->bnhgqk', qb, kb, preferred_element_type=jnp.float32) * scale
    s_ctx = jnp.einsum('bnqhgd,bkhd->bnhgqk', qb, kc, preferred_element_type=jnp.float32) * scale
    qpos = jnp.arange(nb)[:, None] * Q_BLOCK + jnp.arange(Q_BLOCK)[None]
    kpos = jnp.arange(nb)[:, None] * Q_BLOCK - Q_BLOCK + jnp.arange(band)[None]
    valid = ((jnp.abs(qpos[:, :, None] - kpos[:, None, :]) <= WINDOW)
             & (kpos[:, None, :] >= 0) & (kpos[:, None, :] < S))
    s_loc = jnp.where(valid[None, :, None, None], s_loc, NEG_INF)
    sink_col = jnp.broadcast_to(sink.reshape(1, 1, Hkv, G, 1, 1).astype(jnp.float32), s_loc.shape[:-1] + (1,))
    p = jax.nn.softmax(jnp.concatenate([s_loc, s_ctx, sink_col], -1), -1).astype(v.dtype)
    o = (jnp.einsum('bnhgqk,bnkhd->bnqhgd', p[..., :band], vb)
         + jnp.einsum('bnhgqk,bkhd->bnqhgd', p[..., band:band + L], vc))
    return o.reshape(B, S, Hq * d)


def fourier_mix(u):
    B, S, _ = u.shape
    uf = u.astype(jnp.float32).reshape(B, S, FT_GROUPS, FT_GROUP_DIM)
    y = jnp.fft.fft2(uf, axes=(1, 3), norm='ortho').real
    return y.reshape(B, S, FT_COLS).astype(u.dtype)


def hybrid_mixer(p, pc, rope, conv_w, A_log, dt_bias, dn_norm_g, ga_qn, ga_kn, wa_qn, wa_kn, sink, with_ctx):
    p_dn, p_ga, p_wa, p_ft = _split(p, [DN_COLS, GA_COLS, WA_COLS, FT_COLS])
    c_dn, c_ga, c_wa, c_ft = _split(pc, [DN_COLS, GA_COLS, WA_COLS, FT_COLS])
    y_dn, yc_dn = deltanet_mixer(p_dn, c_dn, conv_w, A_log, dt_bias, dn_norm_g, with_ctx)
    q1, k1, v1 = attn_heads(p_ga, GA_HEADS, GA_KV_HEADS, ga_qn, ga_kn, rope)
    qc1, kc1, vc1 = attn_heads(c_ga, GA_HEADS, GA_KV_HEADS, ga_qn, ga_kn, None)
    y_ga = global_attention(q1, k1, v1, kc1, vc1)
    q2, k2, v2 = attn_heads(p_wa, WA_HEADS, WA_KV_HEADS, wa_qn, wa_kn, rope)
    qc2, kc2, vc2 = attn_heads(c_wa, WA_HEADS, WA_KV_HEADS, wa_qn, wa_kn, None)
    y_wa = window_attention(q2, k2, v2, kc2, vc2, sink)
    y_ft = fourier_mix(p_ft)
    y = jnp.concatenate([y_dn, y_ga, y_wa, y_ft], -1)
    if not with_ctx:
        return y, None
    yc = jnp.concatenate([yc_dn, context_attention(qc1, kc1, vc1),
                          context_attention(qc2, kc2, vc2, sink), fourier_mix(c_ft)], -1)
    return y, yc


def setup_inputs(seed: int = 0) -> dict:
    key = jax.random.key(seed)
    ks = jax.random.split(key, 22)
    f32 = jnp.float32

    def normal(k, shape, scale):
        return jax.random.normal(k, shape, f32) * scale

    def gain(k, shape):
        return 1.0 + 0.02 * jax.random.normal(k, shape, f32)

    dt = jnp.exp(jax.random.uniform(ks[11], (DEPTH, 2, DN_HEADS), f32, math.log(1e-3), math.log(1e-1)))
    return {
        'x': normal(ks[0], (BATCH, SEQ, D_MODEL), 1.0),
        'c': normal(ks[1], (BATCH, D_MODEL), 1.0),
        'ctx': normal(ks[2], (BATCH, CTX_LEN, D_MODEL), 1.0),
        'c_ctx': normal(ks[3], (D_MODEL,), 1.0),
        'norm1_g': gain(ks[4], (DEPTH, D_MODEL)),
        'norm2_g': gain(ks[5], (DEPTH, D_MODEL)),
        'w_ada': normal(ks[6], (DEPTH, D_MODEL, N_MOD * D_MODEL), 0.5 * D_MODEL ** -0.5),
        'b_ada': normal(ks[7], (DEPTH, N_MOD * D_MODEL), 0.01),
        'w_in': normal(ks[8], (DEPTH, D_MODEL, IN_COLS), D_MODEL ** -0.5),
        'dn_conv_w': normal(ks[9], (DEPTH, CONV_W, 3 * DN_DIM), CONV_W ** -0.5),
        'dn_A_log': jnp.log(jax.random.uniform(ks[10], (DEPTH, 2, DN_HEADS), f32, 1.0, 16.0)),
        'dn_dt_bias': dt + jnp.log(-jnp.expm1(-dt)),
        'dn_norm_g': gain(ks[12], (DEPTH, HEAD_DIM)),
        'ga_q_norm': gain(ks[13], (DEPTH, HEAD_DIM)),
        'ga_k_norm': gain(ks[14], (DEPTH, HEAD_DIM)),
        'wa_q_norm': gain(ks[15], (DEPTH, HEAD_DIM)),
        'wa_k_norm': gain(ks[16], (DEPTH, HEAD_DIM)),
        'wa_sink': normal(ks[17], (DEPTH, WA_HEADS), 0.5),
        'w_out': normal(ks[18], (DEPTH, D_MIX, D_MODEL), D_MIX ** -0.5),
        'w_ffn_gate': normal(ks[19], (DEPTH, D_MODEL, FFN_HIDDEN), D_MODEL ** -0.5),
        'w_ffn_up': normal(ks[20], (DEPTH, D_MODEL, FFN_HIDDEN), D_MODEL ** -0.5),
        'w_ffn_down': normal(ks[21], (DEPTH, FFN_HIDDEN, D_MODEL), FFN_HIDDEN ** -0.5),
    }


def reference(x, c, ctx, c_ctx, norm1_g, norm2_g, w_ada, b_ada, w_in, dn_conv_w, dn_A_log, dn_dt_bias,
              dn_norm_g, ga_q_norm, ga_k_norm, wa_q_norm, wa_k_norm, wa_sink, w_out,
              w_ffn_gate, w_ffn_up, w_ffn_down):
    rope = axial_rope(x.shape[1])
    xc = ctx
    silu_c = jax.nn.silu(c)
    silu_cc = jax.nn.silu(c_ctx)
    for l in range(DEPTH):
        with_ctx = l < DEPTH - 1
        mod = (silu_c @ w_ada[l] + b_ada[l])[:, None, :]
        mod_c = silu_cc @ w_ada[l] + b_ada[l]
        sh1, sc1, gt1, sh2, sc2, gt2 = jnp.split(mod, N_MOD, -1)
        sh1c, sc1c, gt1c, sh2c, sc2c, gt2c = jnp.split(mod_c, N_MOD, -1)
        h = modulate(rms_norm(x, norm1_g[l]), sh1, sc1)
        hc = modulate(rms_norm(xc, norm1_g[l]), sh1c, sc1c)
        y, yc = hybrid_mixer(h @ w_in[l], hc @ w_in[l], rope, dn_conv_w[l], dn_A_log[l], dn_dt_bias[l],
                             dn_norm_g[l], ga_q_norm[l], ga_k_norm[l], wa_q_norm[l], wa_k_norm[l],
                             wa_sink[l], with_ctx)
        x = x + gt1 * (y @ w_out[l])
        x = x + gt2 * swiglu(modulate(rms_norm(x, norm2_g[l]), sh2, sc2),
                             w_ffn_gate[l], w_ffn_up[l], w_ffn_down[l])
        if with_ctx:
            xc = xc + gt1c * (yc @ w_out[l])
            xc = xc + gt2c * swiglu(modulate(rms_norm(xc, norm2_g[l]), sh2c, sc2c),
                                    w_ffn_gate[l], w_ffn_up[l], w_ffn_down[l])
    return x
```

```cpp
#include <hip/hip_runtime.h>
#include <hip/hip_cooperative_groups.h>
#include <stdint.h>
#include <stdio.h>
namespace cg = cooperative_groups;

typedef unsigned short bf16_t;
typedef short bf16x8 __attribute__((ext_vector_type(8)));
typedef short bf16x4 __attribute__((ext_vector_type(4)));
typedef float f32x4 __attribute__((ext_vector_type(4)));
typedef unsigned u32x4 __attribute__((ext_vector_type(4)));
#define DI __device__ __forceinline__
#define MFMA16(a, b, c) __builtin_amdgcn_mfma_f32_16x16x32_bf16((a), (b), (c), 0, 0, 0)

constexpr int NB = 8, SEQ = 4096, LC = 256, TB = 4352, T = NB * TB, DM = 1024, PW = 2064, HID = 2816, NCH = 68;
constexpr int NIN_PAD = 2560;
constexpr float EPS = 1e-6f;
constexpr float LOG2E = 1.4426950408889634f;

constexpr size_t OFF_MOD = 0;
constexpr size_t OFF_ROPEC = 1u << 20;
constexpr size_t OFF_ROPES = OFF_ROPEC + 524288;
constexpr size_t OFF_CS64 = OFF_ROPES + 524288;
constexpr size_t OFF_ADFTC = OFF_CS64 + 16384;
constexpr size_t OFF_CTR = OFF_ADFTC + 262144;
constexpr size_t OFF_BAR = OFF_CTR + 4096;
constexpr size_t OFF_XC = 2621440;
constexpr size_t OFF_HB = OFF_XC + 8388608;
constexpr size_t SZ_HB = (size_t)T * 1024 * 2;
constexpr size_t OFF_QA = OFF_HB;
constexpr size_t OFF_KA = OFF_QA + (size_t)2 * T * 256 * 2;
constexpr size_t OFF_VT = OFF_KA + (size_t)2 * T * 128 * 2;
constexpr size_t OFF_P = OFF_HB + SZ_HB;
constexpr size_t SZ_P = (size_t)T * PW * 2;
constexpr size_t OFF_YMIX = OFF_P;
constexpr size_t OFF_ODN = OFF_P + SZ_HB;
constexpr size_t OFF_Z = OFF_P + SZ_P;
constexpr size_t OFF_BTFT = OFF_Z + (size_t)T * 256 * 2;
constexpr size_t OFF_BTFTC = OFF_BTFT + (size_t)2048 * 8192 * 2;
constexpr size_t OFF_HM = OFF_P;
constexpr size_t OFF_ADFT = OFF_BTFTC + (size_t)2048 * 512 * 2;
constexpr size_t OFF_RSS1 = OFF_ADFT + (size_t)4096 * 4160 * 2;
constexpr size_t OFF_RSS2 = OFF_RSS1 + (size_t)T * 4;
constexpr size_t OFF_BIAS1 = OFF_RSS2 + (size_t)T * 4;
constexpr size_t OFF_BIAS2 = OFF_BIAS1 + (size_t)4 * 9 * 2560 * 4;
constexpr size_t OFF_DN = OFF_ADFT + (size_t)4096 * 8192 * 2;
constexpr size_t SZ_CB = 40960;
constexpr int NCB = NB * 4 * 2 * NCH;
constexpr size_t OFF_GEND = OFF_DN + (size_t)NCB * SZ_CB;
constexpr size_t WS_NEED = OFF_GEND + (size_t)NCB * 64 * 4;
constexpr size_t OFF_WIN = OFF_BIAS2 + (size_t)4 * 9 * 5632 * 4;
constexpr size_t OFF_WOUT = OFF_WIN + (size_t)NIN_PAD * 1024 * 2;
constexpr size_t OFF_WGU = OFF_WOUT + (size_t)1024 * 1024 * 2;
constexpr size_t OFF_WD = OFF_WGU + (size_t)5632 * 1024 * 2;
static_assert(OFF_WD + (size_t)1024 * 2816 * 2 <= OFF_ADFT + (size_t)4096 * 8192 * 2, "weights overflow the ADFT region tail");
static_assert((size_t)T * HID * 2 <= OFF_ADFT - OFF_P, "Hm alias overflow");

struct Params {
  const float *x, *c, *ctx, *c_ctx, *norm1_g, *norm2_g, *w_ada, *b_ada, *w_in, *conv_w, *A_log, *dt_bias, *dn_norm_g,
      *ga_qn, *ga_kn, *wa_qn, *wa_kn, *wa_sink, *w_out, *w_gate, *w_up, *w_down;
  float* out;
  char* ws;
};

constexpr int HALF_SMEM = 53248;
constexpr int LDS_BYTES = 131072 + 8192;
#define LAS __attribute__((address_space(3)))
#define WAIT_V(n) asm volatile("s_waitcnt vmcnt(%0)" ::"n"(n) : "memory")

DI unsigned pk(float a, float b) {
  typedef __bf16 bf2 __attribute__((ext_vector_type(2)));
  typedef float f2 __attribute__((ext_vector_type(2)));
  f2 v = {a, b};
  bf2 r = __builtin_convertvector(v, bf2);
  return __builtin_bit_cast(unsigned, r);
}
DI bf16_t f2bf(float a) { return (bf16_t)(pk(a, 0.f) & 0xffffu); }
DI float bf2f(bf16_t h) { return __uint_as_float(((unsigned)h) << 16); }
DI float bflo(unsigned u) { return __uint_as_float(u << 16); }
DI float bfhi(unsigned u) { return __uint_as_float(u & 0xffff0000u); }
DI int ltid_full() { int t = threadIdx.x; asm volatile("" : "+v"(t)); return t; }
DI int ltid() { return ltid_full() & 255; }
DI float silu_f(float x) { return x * __builtin_amdgcn_rcpf(1.f + __expf(-x)); }
DI int permk(int x) { return ((x >> 5) << 5) + (((x >> 2) & 3) << 3) + (((x >> 4) & 1) << 2) + (x & 3); }

DI float* xrow(const Params& p, int t) {
  int b = t / TB, tb = t - b * TB;
  return tb < LC ? (float*)(p.ws + OFF_XC) + ((size_t)(b * LC + tb)) * DM : p.out + ((size_t)(b * SEQ + tb - LC)) * DM;
}
DI const float* xrow_in(const Params& p, int t) {
  int b = t / TB, tb = t - b * TB;
  return tb < LC ? p.ctx + ((size_t)(b * LC + tb)) * DM : p.x + ((size_t)(b * SEQ + tb - LC)) * DM;
}
DI int bidx_of(int t) { const int b = t / TB, tb = t - b * TB; return tb < LC ? 8 : b; }
DI const float* modrow(const Params& p, int l, int t) {
  int b = t / TB, tb = t - b * TB;
  int bi = tb < LC ? 8 : b;
  return (const float*)(p.ws + OFF_MOD) + ((size_t)(l * 9 + bi)) * 6144;
}

enum { EP_P = 0, EP_RES1 = 1, EP_GU = 2, EP_RES2 = 3, EP_FT = 4, EP_FTC = 5, EP_DUMMY = 6 };
#ifndef EXP
#define EXP 0
#endif

DI int lds_byte(int r, int c) {
  const int st = (r >> 4) * 2 + (c >> 5), ob = (r & 15) * 64 + (c & 31) * 2;
  return st * 1024 + (ob ^ (((ob >> 9) & 1) << 5));
}
DI void stage_rc(int b, int& R, int& C) {
  const int st = b >> 10, sb = b & 1023, swz = sb ^ (((sb >> 9) & 1) << 5);
  R = (st >> 1) * 16 + swz / 64;
  C = (st & 1) * 32 + (swz % 64) / 2;
}

template <int MODE>
DI void gemm_epilogue(const Params& p, int l, const f32x4 (&acc)[8][4], int m0, int n0, int wr, int wc, int fr, int fq, const LAS float* cst) {
#pragma unroll
  for (int i = 0; i < 8; ++i) {
    const int m = m0 + wr * 128 + i * 16 + fr;
    if (MODE == EP_P) {
      bf16_t* Pp = (bf16_t*)(p.ws + OFF_P) + (size_t)m * PW;
      bf16_t* Zp = (bf16_t*)(p.ws + OFF_Z) + (size_t)m * 256;
      const float rs = rsqrtf(cst[wr * 128 + i * 16 + fr] * (1.f / 1024.f) + EPS);
#pragma unroll
      for (int j = 0; j < 4; ++j) {
        const int n = n0 + wc * 64 + j * 16 + fq * 4;
        const f32x4 bq = *(const LAS f32x4*)(cst + 256 + wc * 64 + j * 16 + fq * 4);
        uint2 v = {pk(acc[i][j][0] * rs + bq[0], acc[i][j][1] * rs + bq[1]), pk(acc[i][j][2] * rs + bq[2], acc[i][j][3] * rs + bq[3])};
        if (n < 768) *(uint2*)(Pp + n) = v;
        else if (n < 1024) *(uint2*)(Zp + (n - 768)) = v;
        else if (n < 2320) *(uint2*)(Pp + (n - 256)) = v;
      }
    } else if (MODE == EP_RES1 || MODE == EP_RES2) {
      float* xo = xrow(p, m);
      const bool emit = (MODE == EP_RES1) || (l < 3);
      bf16_t* hb = (bf16_t*)(p.ws + OFF_HB) + (size_t)m * 1024;
      float4 xv[4];
#pragma unroll
      for (int j = 0; j < 4; ++j) xv[j] = *(const float4*)(xo + n0 + wc * 64 + j * 16 + fq * 4);
      float ssq = 0.f;
#pragma unroll
      for (int j = 0; j < 4; ++j) {
        const int n = n0 + wc * 64 + j * 16 + fq * 4;
        const f32x4 gq = *(const LAS f32x4*)(cst + 256 + wc * 64 + j * 16 + fq * 4), mq = *(const LAS f32x4*)(cst + 512 + wc * 64 + j * 16 + fq * 4);
        const float4 gv = {gq[0], gq[1], gq[2], gq[3]}, mv = {mq[0], mq[1], mq[2], mq[3]};
        xv[j].x += gv.x * acc[i][j][0]; xv[j].y += gv.y * acc[i][j][1]; xv[j].z += gv.z * acc[i][j][2]; xv[j].w += gv.w * acc[i][j][3];
        *(float4*)(xo + n) = xv[j];
        if (emit) {
          ssq += xv[j].x * xv[j].x + xv[j].y * xv[j].y + xv[j].z * xv[j].z + xv[j].w * xv[j].w;
          *(uint2*)(hb + n) = uint2{pk(xv[j].x * mv.x, xv[j].y * mv.y), pk(xv[j].z * mv.z, xv[j].w * mv.w)};
        }
      }
      if (emit) {
        ssq += __shfl_xor(ssq, 16);
        ssq += __shfl_xor(ssq, 32);
        if (fq == 0) unsafeAtomicAdd((float*)(p.ws + (MODE == EP_RES1 ? OFF_RSS2 : OFF_RSS1)) + m, ssq);
      }
    } else if (MODE == EP_GU) {
      bf16_t* hp = (bf16_t*)(p.ws + OFF_HM) + (size_t)m * HID;
      const float rs = rsqrtf(cst[wr * 128 + i * 16 + fr] * (1.f / 1024.f) + EPS);
#pragma unroll
      for (int jj = 0; jj < 2; ++jj) {
        const int hcol = ((n0 + wc * 64) >> 1) + jj * 16 + fq * 4;
        const f32x4 bg = *(const LAS f32x4*)(cst + 256 + wc * 64 + (2 * jj) * 16 + fq * 4), bu = *(const LAS f32x4*)(cst + 256 + wc * 64 + (2 * jj + 1) * 16 + fq * 4);
        const float bgv[4] = {bg[0], bg[1], bg[2], bg[3]}, buv[4] = {bu[0], bu[1], bu[2], bu[3]};
        float o[4];
#pragma unroll
        for (int r = 0; r < 4; ++r) o[r] = silu_f(acc[i][2 * jj][r] * rs + bgv[r]) * (acc[i][2 * jj + 1][r] * rs + buv[r]);
        uint2 v = {pk(o[0], o[1]), pk(o[2], o[3])};
        *(uint2*)(hp + hcol) = v;
      }
    } else if (MODE == EP_DUMMY) {
      bf16_t* dp = (bf16_t*)(p.ws + OFF_DN + (size_t)40 * 1024 * 1024) + (size_t)m * 1024;
#pragma unroll
      for (int j = 0; j < 4; ++j) {
        const int n = n0 + wc * 64 + j * 16 + fq * 4;
        *(uint2*)(dp + n) = uint2{pk(acc[i][j][0], acc[i][j][1]), pk(acc[i][j][2], acc[i][j][3])};
      }
    } else {
      bf16_t* Y = (bf16_t*)(p.ws + OFF_YMIX);
      const float scale = (MODE == EP_FT) ? (1.f / 512.f) : (1.f / 128.f);
#pragma unroll
      for (int j = 0; j < 4; ++j) {
        const int n = n0 + wc * 64 + j * 16 + fq * 4;
        const int b = n >> 8;
        const size_t row = (size_t)b * TB + (MODE == EP_FT ? LC : 0) + m;
        uint2 v = {pk(acc[i][j][0] * scale, acc[i][j][1] * scale), pk(acc[i][j][2] * scale, acc[i][j][3] * scale)};
        *(uint2*)(Y + row * 1024 + 768 + (n & 255)) = v;
      }
    }
  }
}

constexpr int G8_TILE_B = 256 * 64 * 2, G8_STAGE_B = 2 * G8_TILE_B;
#define G8_STAGE(Ab_, Bb_, buf, kt)                                                                                                            \
  do {                                                                                                                                        \
    _Pragma("unroll") for (int i = 0; i < 4; ++i) {                                                                                           \
      __builtin_amdgcn_global_load_lds((const unsigned*)((Ab_) + offA[i] + (kt) * 64), (LAS unsigned*)(lds + (buf) * G8_STAGE_B + wid * 1024 + i * 8192), 16, 0, 0);               \
      __builtin_amdgcn_global_load_lds((const unsigned*)((Bb_) + offB[i] + (kt) * 64), (LAS unsigned*)(lds + (buf) * G8_STAGE_B + G8_TILE_B + wid * 1024 + i * 8192), 16, 0, 0);   \
    }                                                                                                                                         \
  } while (0)
#define G8_COMPUTE(buf)                                                                                                                       \
  do {                                                                                                                                        \
    const LAS char* sa = lds + (buf) * G8_STAGE_B;                                                                                            \
    const LAS char* sb = sa + G8_TILE_B;                                                                                                      \
    _Pragma("unroll") for (int ks = 0; ks < 2; ++ks) {                                                                                        \
      bf16x8 bfr[4];                                                                                                                          \
      _Pragma("unroll") for (int j = 0; j < 4; ++j) bfr[j] = *(const LAS bf16x8*)(sb + lds_byte(wc * 64 + j * 16 + fr, ks * 32 + fq * 8));    \
      bf16x8 a_cur = *(const LAS bf16x8*)(sa + lds_byte(wr * 128 + fr, ks * 32 + fq * 8));                                                    \
      _Pragma("unroll") for (int i = 0; i < 8; ++i) {                                                                                         \
        bf16x8 a_nxt = a_cur;                                                                                                                 \
        if (i < 7) a_nxt = *(const LAS bf16x8*)(sa + lds_byte(wr * 128 + (i + 1) * 16 + fr, ks * 32 + fq * 8));          \
        _Pragma("unroll") for (int j = 0; j < 4; ++j) acc[i][j] = MFMA16(bfr[j], a_cur, acc[i][j]);                                           \
        __builtin_amdgcn_sched_group_barrier(0x100, 1, 0);                                                                                    \
        __builtin_amdgcn_sched_group_barrier(0x008, 4, 0);                                                                                    \
        a_cur = a_nxt;                                                                                                                        \
      }                                                                                                                                       \
    }                                                                                                                                         \
  } while (0)
#define G8_SETUP()                                                                                                                            \
  const int tid = ltid_full(), wid = tid >> 6, lane = tid & 63;                                                                               \
  const int wr = wid >> 2, wc = wid & 3, fr = lane & 15, fq = lane >> 4;                                                                      \
  int offA[4], offB[4];                                                                                                                       \
  _Pragma("unroll") for (int i = 0; i < 4; ++i) {                                                                                             \
    int R, C;                                                                                                                                 \
    stage_rc(wid * 1024 + i * 8192 + lane * 16, R, C);                                                                                        \
    offA[i] = R * lda + C;                                                                                                                    \
    offB[i] = R * ldb + C;                                                                                                                    \
  }

template <int MODE>
DI void gemm8(const Params& p, int l, const bf16_t* A, int lda, const bf16_t* Bt, int ldb, int K, int m0, int n0, LAS char* lds) {
  G8_SETUP();
  f32x4 acc[8][4];
#pragma unroll
  for (int i = 0; i < 8; ++i)
#pragma unroll
    for (int j = 0; j < 4; ++j) acc[i][j] = f32x4{0.f, 0.f, 0.f, 0.f};
  const bf16_t* Ab = A + (size_t)m0 * lda;
  const bf16_t* Bb = Bt + (size_t)n0 * ldb;
  const int nt = K >> 6;
  G8_STAGE(Ab, Bb, 0, 0);
  WAIT_V(0);
  __syncthreads();
  for (int t = 0; t < nt; ++t) {
    const int cur = t & 1;
    if (t + 1 < nt) G8_STAGE(Ab, Bb, cur ^ 1, t + 1);
    G8_COMPUTE(cur);
    WAIT_V(0);
    __syncthreads();
  }
  gemm_epilogue<MODE>(p, l, acc, m0, n0, wr, wc, fr, fq, (const LAS float*)(lds + 131072));
}

struct GTile { int m0, n0, kb, nk, atomic; };
template <int MODE>
DI bool gemm_next_tile(int k, int nM, int nN, int Kit, GTile& g, bool skipctx = false) {
  const int ntl = nM * nN, per = ntl >> 3;
  const int nb8 = gridDim.x >> 3, xcd = blockIdx.x & 7, j = blockIdx.x >> 3;
  const int R = per / nb8, rem = per - R * nb8;
  int loc;
  g.kb = 0; g.nk = Kit; g.atomic = 0;
  if (k < R) loc = k * nb8 + j;
  else if (k == R && rem > 0) {
    int S = 1;
    if (false) { S = nb8 / rem; while (S > 1 && (Kit % S)) --S; }
    if (j >= rem * S) return false;
    loc = R * nb8 + j / S;
    if (S > 1) { g.nk = Kit / S; g.kb = (j % S) * g.nk; g.atomic = 1; }
  } else return false;
  const int L = xcd * per + loc;
  const int nig = 8 * nN, gid = L / nig, fm = gid * 8, gsz = (nM - fm) < 8 ? (nM - fm) : 8;
  int pm = fm + ((L % nig) % gsz);
  if (skipctx) pm += pm / 16 + 1;
  g.m0 = pm * 256;
  g.n0 = ((L % nig) / gsz) * 256;
  return true;
}

template <int MODE>
DI void gemm_phase(const Params& p, int l, const bf16_t* A, int lda, const bf16_t* Bt, int ldb, int K, int nM, int nN, LAS char* lds, bool skipctx = false) {
  G8_SETUP();
  const int Kit = K >> 6;
  GTile cur, nxt;
  bool have = gemm_next_tile<MODE>(0, nM, nN, Kit, cur, skipctx);
  if (have) G8_STAGE(A + (size_t)cur.m0 * lda, Bt + (size_t)cur.n0 * ldb, 0, cur.kb);
  for (int k = 0; have; ++k) {
    const bool hn = gemm_next_tile<MODE>(k + 1, nM, nN, Kit, nxt, skipctx);
    f32x4 acc[8][4];
#pragma unroll
    for (int i = 0; i < 8; ++i)
#pragma unroll
      for (int j = 0; j < 4; ++j) acc[i][j] = f32x4{0.f, 0.f, 0.f, 0.f};
    const bf16_t* Ab = A + (size_t)cur.m0 * lda;
    const bf16_t* Bb = Bt + (size_t)cur.n0 * ldb;
    LAS float* cst = (LAS float*)(lds + 131072 + (k & 1) * 4096);
    if (MODE == EP_P || MODE == EP_GU) {
      const float* rss = (const float*)(p.ws + (MODE == EP_P ? OFF_RSS1 : OFF_RSS2));
      const float* bias = (const float*)(p.ws + (MODE == EP_P ? OFF_BIAS1 : OFF_BIAS2)) + ((size_t)(l * 9 + bidx_of(cur.m0))) * (MODE == EP_P ? 2560 : 5632);
      cst[tid] = tid < 256 ? rss[cur.m0 + tid] : bias[cur.n0 + tid - 256];
    }
    if (MODE == EP_RES1 || MODE == EP_RES2) {
      const float* mrow = modrow(p, l, cur.m0);
      const int c = cur.n0 + (tid & 255);
      if (tid < 256) cst[256 + tid] = mrow[(MODE == EP_RES1 ? 2048 : 5120) + c];
      else {
        const float* ng = (MODE == EP_RES1) ? p.norm2_g + l * 1024 : p.norm1_g + (l < 3 ? l + 1 : 0) * 1024;
        const float* nsc = (MODE == EP_RES1) ? mrow + 4096 : modrow(p, l < 3 ? l + 1 : 0, cur.m0) + 1024;
        cst[256 + tid] = ng[c] * (1.f + nsc[c]);
      }
    }
    WAIT_V(0);
    __syncthreads();
    for (int t = 0; t < cur.nk; ++t) {
      const int cb = t & 1;
      if (t + 1 < cur.nk) G8_STAGE(Ab, Bb, cb ^ 1, cur.kb + t + 1);
      G8_COMPUTE(cb);
      WAIT_V(0);
      __syncthreads();
    }
    if (hn) G8_STAGE(A + (size_t)nxt.m0 * lda, Bt + (size_t)nxt.n0 * ldb, 0, nxt.kb);
    gemm_epilogue<MODE>(p, l, acc, cur.m0, cur.n0, wr, wc, fr, fq, cst);
    cur = nxt;
    have = hn;
  }
}

template <int MODE>
DI void gemm_epilogue8(const Params& p, int l, const f32x4 (&acc)[2][2][4][2], int m0, int n0, int wr, int wc, int fr, int fq, const LAS float* cst) {
#pragma unroll
  for (int ai = 0; ai < 2; ++ai)
#pragma unroll
    for (int mm = 0; mm < 4; ++mm) {
      const int rl = ai * 128 + wr * 64 + mm * 16 + fr;
      const int m = m0 + rl;
      if (MODE == EP_P) {
        bf16_t* Pp = (bf16_t*)(p.ws + OFF_P) + (size_t)m * PW;
        bf16_t* Zp = (bf16_t*)(p.ws + OFF_Z) + (size_t)m * 256;
        const float rs = rsqrtf(cst[rl] * (1.f / 1024.f) + EPS);
#pragma unroll
        for (int bj = 0; bj < 2; ++bj)
#pragma unroll
          for (int nn = 0; nn < 2; ++nn) {
            const int cl = bj * 128 + wc * 32 + nn * 16 + fq * 4, n = n0 + cl;
            const f32x4 bq = *(const LAS f32x4*)(cst + 256 + cl);
            const f32x4& a = acc[ai][bj][mm][nn];
            uint2 v = {pk(a[0] * rs + bq[0], a[1] * rs + bq[1]), pk(a[2] * rs + bq[2], a[3] * rs + bq[3])};
            if (n < 768) *(uint2*)(Pp + n) = v;
            else if (n < 1024) *(uint2*)(Zp + (n - 768)) = v;
            else if (n < 2320) *(uint2*)(Pp + (n - 256)) = v;
          }
      } else if (MODE == EP_RES1 || MODE == EP_RES2) {
        float* xo = xrow(p, m);
        const bool emit = (MODE == EP_RES1) || (l < 3);
        bf16_t* hb = (bf16_t*)(p.ws + OFF_HB) + (size_t)m * 1024;
        float4 xv[4];
#pragma unroll
        for (int q4 = 0; q4 < 4; ++q4) xv[q4] = *(const float4*)(xo + n0 + (q4 >> 1) * 128 + wc * 32 + (q4 & 1) * 16 + fq * 4);
        float ssq = 0.f;
#pragma unroll
        for (int q4 = 0; q4 < 4; ++q4) {
          const int cl = (q4 >> 1) * 128 + wc * 32 + (q4 & 1) * 16 + fq * 4, n = n0 + cl;
          const f32x4 gq = *(const LAS f32x4*)(cst + 256 + cl), mq = *(const LAS f32x4*)(cst + 512 + cl);
          const f32x4& a = acc[ai][q4 >> 1][mm][q4 & 1];
          xv[q4].x += gq[0] * a[0]; xv[q4].y += gq[1] * a[1]; xv[q4].z += gq[2] * a[2]; xv[q4].w += gq[3] * a[3];
          *(float4*)(xo + n) = xv[q4];
          if (emit) {
            ssq += xv[q4].x * xv[q4].x + xv[q4].y * xv[q4].y + xv[q4].z * xv[q4].z + xv[q4].w * xv[q4].w;
            *(uint2*)(hb + n) = uint2{pk(xv[q4].x * mq[0], xv[q4].y * mq[1]), pk(xv[q4].z * mq[2], xv[q4].w * mq[3])};
          }
        }
        if (emit) {
          ssq += __shfl_xor(ssq, 16);
          ssq += __shfl_xor(ssq, 32);
          if (fq == 0) unsafeAtomicAdd((float*)(p.ws + (MODE == EP_RES1 ? OFF_RSS2 : OFF_RSS1)) + m, ssq);
        }
      } else if (MODE == EP_GU) {
        bf16_t* hp = (bf16_t*)(p.ws + OFF_HM) + (size_t)m * HID;
        const float rs = rsqrtf(cst[rl] * (1.f / 1024.f) + EPS);
#pragma unroll
        for (int bj = 0; bj < 2; ++bj) {
          const int cl = bj * 128 + wc * 32 + fq * 4;
          const int hcol = ((n0 + bj * 128 + wc * 32) >> 1) + fq * 4;
          const f32x4 bg = *(const LAS f32x4*)(cst + 256 + cl), bu = *(const LAS f32x4*)(cst + 256 + cl + 16);
          const f32x4& ag = acc[ai][bj][mm][0];
          const f32x4& au = acc[ai][bj][mm][1];
          float o[4];
#pragma unroll
          for (int r = 0; r < 4; ++r) o[r] = silu_f(ag[r] * rs + bg[r]) * (au[r] * rs + bu[r]);
          *(uint2*)(hp + hcol) = uint2{pk(o[0], o[1]), pk(o[2], o[3])};
        }
      } else {
        bf16_t* dp = (bf16_t*)(p.ws + OFF_DN + (size_t)40 * 1024 * 1024) + (size_t)m * 1024;
#pragma unroll
        for (int q4 = 0; q4 < 4; ++q4) {
          const f32x4& a = acc[ai][q4 >> 1][mm][q4 & 1];
          *(uint2*)(dp + n0 + (q4 >> 1) * 128 + wc * 32 + (q4 & 1) * 16 + fq * 4) = uint2{pk(a[0], a[1]), pk(a[2], a[3])};
        }
      }
    }
}

template <int MODE>
DI void gemm_phase8(const Params& p, int l, const bf16_t* A, const bf16_t* Bt, int K, int nM, int nN, LAS char* lds, bool skipctx) {
  constexpr int HT = 128 * 64;
  const int tid = ltid_full(), wid = tid >> 6, lane = tid & 63;
  const int wr = wid >> 2, wc = wid & 3, fr = lane & 15, fq = lane >> 4;
  unsigned soff[2];
#pragma unroll
  for (int i = 0; i < 2; ++i) { int R, C; stage_rc(tid * 16 + i * 8192, R, C); soff[i] = (unsigned)(R * K + C) * 2u; }
#define P8_SA(b, h) (lds + (((b) * 2 + (h)) * HT) * 2)
#define P8_SB(b, h) (lds + ((4 + (b) * 2 + (h)) * HT) * 2)
#define P8_STAGE(P_, BASE_, br_, kt_)                                                                                                          \
  do {                                                                                                                                        \
    const unsigned long long _gi = (unsigned long long)((BASE_) + (size_t)(br_) * K + (size_t)(kt_) * 64);                                       \
    const char* _g = (const char*)(((unsigned long long)(unsigned)__builtin_amdgcn_readfirstlane((int)(_gi >> 32)) << 32) |                    \
                                   (unsigned)__builtin_amdgcn_readfirstlane((int)(unsigned)_gi));     \
    _Pragma("unroll") for (int _i = 0; _i < 2; ++_i)                                                                                          \
      __builtin_amdgcn_global_load_lds((const unsigned*)(_g + soff[_i]), (LAS unsigned*)((P_) + wid * 1024 + _i * 8192), 16, 0, 0);            \
  } while (0)
#define P8_LDA(dst, b, h)                                                                                                                     \
  _Pragma("unroll") for (int m_ = 0; m_ < 4; ++m_) _Pragma("unroll") for (int k_ = 0; k_ < 2; ++k_)                                           \
    dst[m_][k_] = *(const LAS bf16x8*)(P8_SA(b, h) + lds_byte(wr * 64 + m_ * 16 + fr, k_ * 32 + fq * 8))
#define P8_LDB(dst, b, h)                                                                                                                     \
  _Pragma("unroll") for (int n_ = 0; n_ < 2; ++n_) _Pragma("unroll") for (int k_ = 0; k_ < 2; ++k_)                                           \
    dst[n_][k_] = *(const LAS bf16x8*)(P8_SB(b, h) + lds_byte(wc * 32 + n_ * 16 + fr, k_ * 32 + fq * 8))
#define P8_MMA(ai, bj, At_, Bt_)                                                                                                              \
  do {                                                                                                                                        \
    __builtin_amdgcn_s_setprio(1);                                                                                                            \
    _Pragma("unroll") for (int m_ = 0; m_ < 4; ++m_) _Pragma("unroll") for (int n_ = 0; n_ < 2; ++n_) _Pragma("unroll") for (int k_ = 0; k_ < 2; ++k_) \
      acc[ai][bj][m_][n_] = MFMA16(Bt_[n_][k_], At_[m_][k_], acc[ai][bj][m_][n_]);                                                            \
    __builtin_amdgcn_s_setprio(0);                                                                                                            \
  } while (0)
#define P8_WAIT_L(n) asm volatile("s_waitcnt lgkmcnt(%0)" ::"n"(n) : "memory")
#define P8_BAR __builtin_amdgcn_s_barrier()
#define P8_SCHED __builtin_amdgcn_sched_barrier(0)
  const int nt = K >> 6;
  GTile cur;
  for (int k = 0; gemm_next_tile<EP_P>(k, nM, nN, nt, cur, skipctx); ++k) {
    const int brow = cur.m0, bcol = cur.n0;
    LAS float* cst = (LAS float*)(lds + 131072 + (k & 1) * 4096);
    if (MODE == EP_P || MODE == EP_GU) {
      const float* rss = (const float*)(p.ws + (MODE == EP_P ? OFF_RSS1 : OFF_RSS2));
      const float* bias = (const float*)(p.ws + (MODE == EP_P ? OFF_BIAS1 : OFF_BIAS2)) + ((size_t)(l * 9 + bidx_of(brow))) * (MODE == EP_P ? 2560 : 5632);
      cst[tid] = tid < 256 ? rss[brow + tid] : bias[bcol + tid - 256];
    }
    if (MODE == EP_RES1 || MODE == EP_RES2) {
      const float* mrow = modrow(p, l, brow);
      const int c = bcol + (tid & 255);
      if (tid < 256) cst[256 + tid] = mrow[(MODE == EP_RES1 ? 2048 : 5120) + c];
      else {
        const float* ng = (MODE == EP_RES1) ? p.norm2_g + l * 1024 : p.norm1_g + (l < 3 ? l + 1 : 0) * 1024;
        const float* nsc = (MODE == EP_RES1) ? mrow + 4096 : modrow(p, l < 3 ? l + 1 : 0, brow) + 1024;
        cst[256 + tid] = ng[c] * (1.f + nsc[c]);
      }
    }
    f32x4 acc[2][2][4][2];
#pragma unroll
    for (int a_ = 0; a_ < 2; ++a_)
#pragma unroll
      for (int b_ = 0; b_ < 2; ++b_)
#pragma unroll
        for (int m_ = 0; m_ < 4; ++m_)
#pragma unroll
          for (int n_ = 0; n_ < 2; ++n_) acc[a_][b_][m_][n_] = f32x4{0.f, 0.f, 0.f, 0.f};
    bf16x8 At[4][2], B0[2][2], B1[2][2];
    __syncthreads();
    P8_STAGE(P8_SB(0, 0), Bt, bcol, 0); P8_STAGE(P8_SA(0, 0), A, brow, 0);
    P8_STAGE(P8_SB(0, 1), Bt, bcol + 128, 0); P8_STAGE(P8_SA(0, 1), A, brow + 128, 0);
    if (wr == 1) P8_BAR;
    WAIT_V(4); P8_BAR;
    P8_STAGE(P8_SB(1, 0), Bt, bcol, 1); P8_STAGE(P8_SA(1, 0), A, brow, 1); P8_STAGE(P8_SB(1, 1), Bt, bcol + 128, 1);
    WAIT_V(6); P8_BAR;
    for (int t = 0; t < nt - 2; t += 2) {
      P8_LDB(B0, 0, 0); P8_SCHED; P8_LDA(At, 0, 0); P8_STAGE(P8_SA(1, 1), A, brow + 128, t + 1);
      P8_WAIT_L(8); P8_BAR; P8_WAIT_L(0); P8_MMA(0, 0, At, B0); P8_BAR; P8_SCHED;
      P8_LDB(B1, 0, 1); P8_STAGE(P8_SB(0, 0), Bt, bcol, t + 2);
      P8_BAR; P8_WAIT_L(0); P8_MMA(0, 1, At, B1); P8_BAR;
      P8_LDA(At, 0, 1); P8_STAGE(P8_SA(0, 0), A, brow, t + 2);
      P8_BAR; P8_WAIT_L(0); P8_MMA(1, 0, At, B0); P8_BAR; P8_SCHED;
      P8_STAGE(P8_SB(0, 1), Bt, bcol + 128, t + 2);
      WAIT_V(6); P8_BAR; P8_MMA(1, 1, At, B1); P8_BAR;
      P8_LDB(B0, 1, 0); P8_SCHED; P8_LDA(At, 1, 0); P8_STAGE(P8_SA(0, 1), A, brow + 128, t + 2);
      P8_WAIT_L(8); P8_BAR; P8_WAIT_L(0); P8_MMA(0, 0, At, B0); P8_BAR; P8_SCHED;
      P8_LDB(B1, 1, 1); P8_STAGE(P8_SB(1, 0), Bt, bcol, t + 3);
      P8_BAR; P8_WAIT_L(0); P8_MMA(0, 1, At, B1); P8_BAR;
      P8_LDA(At, 1, 1); P8_STAGE(P8_SA(1, 0), A, brow, t + 3);
      P8_BAR; P8_WAIT_L(0); P8_MMA(1, 0, At, B0); P8_BAR; P8_SCHED;
      P8_STAGE(P8_SB(1, 1), Bt, bcol + 128, t + 3);
      WAIT_V(6); P8_BAR; P8_MMA(1, 1, At, B1); P8_BAR;
    }
    { P8_LDB(B0, 0, 0); P8_LDA(At, 0, 0); P8_STAGE(P8_SA(1, 1), A, brow + 128, nt - 1);
      P8_BAR; P8_WAIT_L(0); P8_MMA(0, 0, At, B0); P8_BAR;
      P8_LDB(B1, 0, 1); P8_BAR; P8_WAIT_L(0); P8_MMA(0, 1, At, B1); P8_BAR;
      P8_LDA(At, 0, 1); WAIT_V(4); P8_BAR; P8_WAIT_L(0); P8_MMA(1, 0, At, B0); P8_MMA(1, 1, At, B1); P8_BAR; }
    { P8_LDB(B0, 1, 0); P8_LDA(At, 1, 0); WAIT_V(2); P8_BAR; P8_WAIT_L(0); P8_MMA(0, 0, At, B0); P8_BAR;
      P8_LDB(B1, 1, 1); WAIT_V(0); P8_BAR; P8_WAIT_L(0); P8_MMA(0, 1, At, B1); P8_BAR;
      P8_LDA(At, 1, 1); P8_BAR; P8_WAIT_L(0); P8_MMA(1, 0, At, B0); P8_MMA(1, 1, At, B1); P8_BAR; }
    if (wr == 0) P8_BAR;
    gemm_epilogue8<MODE>(p, l, acc, brow, bcol, wr, wc, fr, fq, cst);
  }
}

template <bool BIAS>
DI void wconv_tile(const float* src0, const float* src1, int N, int K, bf16_t* dst, int kind, int kt, int nt, char* smem, const float* shvec = nullptr, float* bias = nullptr, int npad = 0) {
  float* tile = (float*)smem;
  const int tid = ltid();
  __syncthreads();
  {
    const int nn = tid & 63, kk0 = tid >> 6;
    const int R = nt * 64 + nn;
    const float* src = src0;
    int col = R;
    bool ok = true;
    if (kind == 1) {
      const int grp = R >> 5, up = (R >> 4) & 1;
      col = grp * 16 + (R & 15);
      src = up ? src1 : src0;
    } else ok = R < N;
    float wv[16];
#pragma unroll
    for (int i = 0; i < 16; ++i) wv[i] = ok ? src[(size_t)(kt * 64 + kk0 + i * 4) * N + col] : 0.f;
#pragma unroll
    for (int i = 0; i < 16; ++i) tile[(kk0 + i * 4) * 65 + nn] = wv[i];
    if (BIAS) {
      float* svs = tile + 64 * 65;
      for (int o = tid; o < 9 * 64; o += 256) svs[o] = shvec[(size_t)(o >> 6) * 6144 + kt * 64 + (o & 63)];
    }
  }
  __syncthreads();
  {
    const int rr = tid >> 2, kc = (tid & 3) * 16;
    unsigned o[8];
#pragma unroll
    for (int e = 0; e < 8; ++e) o[e] = pk(tile[(kc + 2 * e) * 65 + rr], tile[(kc + 2 * e + 1) * 65 + rr]);
    bf16_t* d = dst + (size_t)(nt * 64 + rr) * K + kt * 64 + kc;
    *(uint4*)d = uint4{o[0], o[1], o[2], o[3]};
    *(uint4*)(d + 8) = uint4{o[4], o[5], o[6], o[7]};
  }
  if (BIAS) {
    for (int o = tid; o < 9 * 64; o += 256) {
      const int bq = o >> 6, nn = o & 63;
      const float* sv = tile + 64 * 65 + bq * 64;
      float a = 0.f;
#pragma unroll 8
      for (int kk = 0; kk < 64; ++kk) a += sv[kk] * tile[kk * 65 + nn];
      unsafeAtomicAdd(bias + (size_t)bq * npad + nt * 64 + nn, a);
    }
  }
}

DI void mod_item(const Params& p, int item, char* smem) {
  const int l = item / 96, cgp = item % 96;
  float* sc = (float*)smem;
  float* red = sc + 9 * 1024;
  const int tid = ltid();
  __syncthreads();
  for (int i = tid; i < 9 * 1024; i += 256) {
    const int r = i >> 10, k = i & 1023;
    const float v = r < 8 ? p.c[r * 1024 + k] : p.c_ctx[k];
    sc[i] = silu_f(v);
  }
  __syncthreads();
  const int kq = tid >> 6, cc = tid & 63, col = cgp * 64 + cc;
  float acc[9];
#pragma unroll
  for (int r = 0; r < 9; ++r) acc[r] = 0.f;
  const float* wp = p.w_ada + (size_t)l * 1024 * 6144 + col;
#pragma unroll 8
  for (int k = kq * 256; k < kq * 256 + 256; ++k) {
    const float wv = wp[(size_t)k * 6144];
#pragma unroll
    for (int r = 0; r < 9; ++r) acc[r] += sc[r * 1024 + k] * wv;
  }
#pragma unroll
  for (int r = 0; r < 9; ++r) red[(kq * 9 + r) * 64 + cc] = acc[r];
  __syncthreads();
  for (int i = tid; i < 9 * 64; i += 256) {
    const int r = i >> 6, c2 = i & 63;
    const float s = red[(0 * 9 + r) * 64 + c2] + red[(1 * 9 + r) * 64 + c2] + red[(2 * 9 + r) * 64 + c2] + red[(3 * 9 + r) * 64 + c2];
    ((float*)(p.ws + OFF_MOD))[((size_t)(l * 9 + r)) * 6144 + cgp * 64 + c2] = s + p.b_ada[l * 6144 + cgp * 64 + c2];
  }
}

DI void phase0(const Params& p, char* smem) {
  const int tid = ltid(), hf = ltid_full() >> 8;
  constexpr int N_MOD_IT = 384, N_ROPE = 512, N_CS = 32, N_ADC = 512, N_AD = 4160;
  constexpr int TOT = N_MOD_IT + N_ROPE + N_CS + N_ADC + N_AD;
  if (blockIdx.x == 0 && hf == 0 && tid < 64) ((int*)(p.ws + OFF_CTR))[tid] = 0;
  for (int i = blockIdx.x * 512 + ltid_full(); i < 4 * 9 * (2560 + 5632); i += gridDim.x * 512) ((float*)(p.ws + OFF_BIAS1))[i] = 0.f;
  for (int pi = blockIdx.x; pi < TOT / 2; pi += gridDim.x) {
    int i = pi * 2 + hf;
    if (i < N_MOD_IT) { mod_item(p, i, smem + hf * HALF_SMEM); continue; }
    i -= N_MOD_IT;
    if (i < N_ROPE) {
      const int e = i * 256 + tid;
      const int pos = e >> 5, f = e & 31;
      const float pv = (f < 16) ? (float)(pos >> 6) : (float)(pos & 63);
      const float invf = powf(10000.f, -(float)(f & 15) / 16.f);
      const float ang = pv * invf;
      float s, c;
      sincosf(ang, &s, &c);
      ((float*)(p.ws + OFF_ROPEC))[e] = c;
      ((float*)(p.ws + OFF_ROPES))[e] = s;
      continue;
    }
    i -= N_ROPE;
    if (i < N_CS) {
      const int e = i * 256 + tid;
      const int r = e >> 6, n2 = e & 63;
      const int idx = ((r & 63) * n2) & 63;
      float s, c;
      sincospif((float)idx / 32.f, &s, &c);
      ((bf16_t*)(p.ws + OFF_CS64))[e] = f2bf(r < 64 ? c : s);
      continue;
    }
    i -= N_CS;
    if (i < N_ADC) {
      const int e = i * 256 + tid;
      const int k1 = e >> 9, cc = e & 511, n1 = cc & 255;
      const int idx = (k1 * n1) & 255;
      float s, c;
      sincospif((float)idx / 128.f, &s, &c);
      ((bf16_t*)(p.ws + OFF_ADFTC))[e] = f2bf(cc < 256 ? c : -s);
      continue;
    }
    i -= N_ADC;
    if (i < N_AD) {
      const size_t e0 = (size_t)i * 4096 + (size_t)tid * 16;
      const int k1 = (int)(e0 / 4160), c0 = (int)(e0 % 4160);
      unsigned o[8];
#pragma unroll
      for (int e = 0; e < 8; ++e) {
        float v[2];
#pragma unroll
        for (int h = 0; h < 2; ++h) {
          const int cc = c0 + 2 * e + h;
          const int n1 = cc < 2112 ? cc : cc - 2112;
          const int idx = (k1 * n1) & 4095;
          float sn, cs;
          sincospif((float)idx / 2048.f, &sn, &cs);
          v[h] = cc < 2112 ? (cc <= 2048 ? cs : 0.f) : -sn;
        }
        o[e] = pk(v[0], v[1]);
      }
      bf16_t* dd = (bf16_t*)(p.ws + OFF_ADFT) + e0;
      *(uint4*)dd = uint4{o[0], o[1], o[2], o[3]};
      *(uint4*)(dd + 8) = uint4{o[4], o[5], o[6], o[7]};
      continue;
    }
  }
}

DI void norm_item(const Params& p, int item) {
  const int tid = ltid();
  const int w = tid >> 6, lane = tid & 63;
  const int t = item * 4 + w;
  const float* xr = xrow_in(p, t);
  const float* md = modrow(p, 0, t);
  const float* g = p.norm1_g;
  float4 v[4];
  float ss = 0.f;
#pragma unroll
  for (int j = 0; j < 4; ++j) {
    v[j] = *(const float4*)(xr + j * 256 + lane * 4);
    ss += v[j].x * v[j].x + v[j].y * v[j].y + v[j].z * v[j].z + v[j].w * v[j].w;
  }
#pragma unroll
  for (int off = 32; off >= 1; off >>= 1) ss += __shfl_xor(ss, off);
  if (lane == 0) ((float*)(p.ws + OFF_RSS1))[t] = ss;
  float* xo = xrow(p, t);
  bf16_t* hb = (bf16_t*)(p.ws + OFF_HB) + (size_t)t * 1024;
#pragma unroll
  for (int j = 0; j < 4; ++j) {
    const int c = j * 256 + lane * 4;
    *(float4*)(xo + c) = v[j];
    const float4 gg = *(const float4*)(g + c), sc = *(const float4*)(md + 1024 + c);
    *(uint2*)(hb + c) = uint2{pk(v[j].x * gg.x * (1.f + sc.x), v[j].y * gg.y * (1.f + sc.y)), pk(v[j].z * gg.z * (1.f + sc.z), v[j].w * gg.w * (1.f + sc.w))};
  }
}

DI void aprep_item(const Params& p, int l, int item, char* smem) {
  const int b = item / NCH, c = item % NCH;
  const int tok0 = b * TB + c * 64;
  const bool isctx = c < 4;
  int tid_ = ltid();
  const int tid = tid_, lane = tid & 63, w = tid >> 6;
  const bf16_t* P = (const bf16_t*)(p.ws + OFF_P);
  for (int it = 0; it < 12; ++it) {
    const int task = it * 64 + (tid >> 2);
    const int cq = tid & 3;
    const int type = task / 384, rem = task % 384, hr = rem >> 6, tk = rem & 63;
    const int t = tok0 + tk;
    const int pcol = (type ? 1296 : 784) + hr * 64;
    const bf16_t* src = P + (size_t)t * PW + pcol;
    const uint4 u1 = *(const uint4*)(src + cq * 8), u2 = *(const uint4*)(src + 32 + cq * 8);
    float a[8], bb[8];
    a[0] = bflo(u1.x); a[1] = bfhi(u1.x); a[2] = bflo(u1.y); a[3] = bfhi(u1.y); a[4] = bflo(u1.z); a[5] = bfhi(u1.z); a[6] = bflo(u1.w); a[7] = bfhi(u1.w);
    bb[0] = bflo(u2.x); bb[1] = bfhi(u2.x); bb[2] = bflo(u2.y); bb[3] = bfhi(u2.y); bb[4] = bflo(u2.z); bb[5] = bfhi(u2.z); bb[6] = bflo(u2.w); bb[7] = bfhi(u2.w);
    float ss = 0.f;
#pragma unroll
    for (int e = 0; e < 8; ++e) ss += a[e] * a[e] + bb[e] * bb[e];
    ss += __shfl_xor(ss, 1);
    ss += __shfl_xor(ss, 2);
    const float rs = rsqrtf(ss * (1.f / 64.f) + EPS);
    const float* gn = (type ? (hr < 4 ? p.wa_qn : p.wa_kn) : (hr < 4 ? p.ga_qn : p.ga_kn)) + l * 64;
    const float qs = hr < 4 ? 0.125f * LOG2E : 1.f;
    float o1[8], o2[8];
#pragma unroll
    for (int e = 0; e < 8; ++e) {
      a[e] = a[e] * rs * gn[cq * 8 + e];
      bb[e] = bb[e] * rs * gn[32 + cq * 8 + e];
    }
    if (!isctx) {
      const int pos = c * 64 + tk - LC;
      const float* rc = (const float*)(p.ws + OFF_ROPEC) + pos * 32 + cq * 8;
      const float* rsn = (const float*)(p.ws + OFF_ROPES) + pos * 32 + cq * 8;
#pragma unroll
      for (int e = 0; e < 8; ++e) {
        const float cs = rc[e], sn = rsn[e];
        o1[e] = (a[e] * cs - bb[e] * sn) * qs;
        o2[e] = (a[e] * sn + bb[e] * cs) * qs;
      }
    } else {
#pragma unroll
      for (int e = 0; e < 8; ++e) { o1[e] = a[e] * qs; o2[e] = bb[e] * qs; }
    }
    bf16_t* dst = hr < 4 ? (bf16_t*)(p.ws + OFF_QA) + ((size_t)type * T + t) * 256 + hr * 64
                         : (bf16_t*)(p.ws + OFF_KA) + ((size_t)type * T + t) * 128 + (hr - 4) * 64;
    *(uint4*)(dst + cq * 8) = uint4{pk(o1[0], o1[1]), pk(o1[2], o1[3]), pk(o1[4], o1[5]), pk(o1[6], o1[7])};
    *(uint4*)(dst + 32 + cq * 8) = uint4{pk(o2[0], o2[1]), pk(o2[2], o2[3]), pk(o2[4], o2[5]), pk(o2[6], o2[7])};
  }
  {
    bf16_t* sT = (bf16_t*)smem;
#pragma unroll 1
    for (int type = 0; type < 2; ++type) {
      const int vcol = (type ? 1296 : 784) + 384;
      __syncthreads();
#pragma unroll
      for (int i = 0; i < 4; ++i) {
        const int q = tid + i * 256, tk = q >> 4, ch = q & 15;
        *(uint4*)(sT + tk * 136 + ch * 8) = *(const uint4*)(P + (size_t)(tok0 + tk) * PW + vcol + ch * 8);
      }
      __syncthreads();
      const int kd = tid & 127, th = tid >> 7;
      bf16_t* dst = (bf16_t*)(p.ws + OFF_VT) + (((size_t)(type * NB + b) * 128 + kd)) * TB + c * 64 + th * 32;
#pragma unroll
      for (int j0 = 0; j0 < 32; j0 += 8) {
        unsigned o[4];
#pragma unroll
        for (int e = 0; e < 4; ++e) {
          const unsigned lo = sT[(th * 32 + j0 + 2 * e) * 136 + kd], hi = sT[(th * 32 + j0 + 2 * e + 1) * 136 + kd];
          o[e] = lo | (hi << 16);
        }
        *(uint4*)(dst + j0) = uint4{o[0], o[1], o[2], o[3]};
      }
    }
  }
  {
    const int g = w, lr = lane & 15, lq = lane >> 4;
    const bf16_t* CS = (const bf16_t*)(p.ws + OFF_CS64);
    const int cl = c - 4;
    if (isctx || cl <= 32) {
#pragma unroll 1
      for (int nh = 0; nh < 2; ++nh) {
      bf16x8 bs[2][2], bd[2][2];
#pragma unroll
      for (int ntl = 0; ntl < 2; ++ntl) {
        const int nt = nh * 2 + ntl;
        const int n1 = cl * 64 + nt * 16 + lr;
        const bool mir = !isctx && n1 >= 1 && n1 <= 2047;
        const bool zero = !isctx && n1 > 2048;
#pragma unroll
        for (int ks = 0; ks < 2; ++ks) {
          const int coff = 1808 + g * 64 + ks * 32 + lq * 8;
          uint4 a = *(const uint4*)(P + (size_t)(tok0 + nt * 16 + lr) * PW + coff);
          uint4 m = {0u, 0u, 0u, 0u};
          if (mir) m = *(const uint4*)(P + (size_t)(b * TB + LC + 4096 - n1) * PW + coff);
          if (zero) a = uint4{0u, 0u, 0u, 0u};
          const unsigned ua[4] = {a.x, a.y, a.z, a.w}, um[4] = {m.x, m.y, m.z, m.w};
          unsigned os[4], od[4];
#pragma unroll
          for (int e = 0; e < 4; ++e) {
            const float a0 = bflo(ua[e]), a1 = bfhi(ua[e]), m0 = bflo(um[e]), m1 = bfhi(um[e]);
            os[e] = pk(a0 + m0, a1 + m1);
            od[e] = pk(a0 - m0, a1 - m1);
          }
          bs[ntl][ks] = __builtin_bit_cast(bf16x8, uint4{os[0], os[1], os[2], os[3]});
          bd[ntl][ks] = __builtin_bit_cast(bf16x8, uint4{od[0], od[1], od[2], od[3]});
        }
      }
#pragma unroll 1
      for (int mt = 0; mt < 8; ++mt) {
        bf16x8 af[2];
#pragma unroll
        for (int ks = 0; ks < 2; ++ks) af[ks] = *(const bf16x8*)(CS + (mt * 16 + lr) * 64 + ks * 32 + lq * 8);
#pragma unroll
        for (int ntl = 0; ntl < 2; ++ntl) {
          const int nt = nh * 2 + ntl;
          f32x4 acc = {0.f, 0.f, 0.f, 0.f};
          const bool sinpart = mt >= 4;
          acc = MFMA16(af[0], (sinpart && !isctx) ? bd[ntl][0] : bs[ntl][0], acc);
          acc = MFMA16(af[1], (sinpart && !isctx) ? bd[ntl][1] : bs[ntl][1], acc);
#pragma unroll
          for (int r = 0; r < 4; ++r) {
            const int k2row = mt * 16 + lq * 4 + r, k2 = k2row & 63, part = k2row >> 6;
            const int tk = c * 64 + nt * 16 + lr;
            if (isctx) ((bf16_t*)(p.ws + OFF_BTFTC))[((size_t)(b * 256 + g * 64 + k2)) * 512 + part * 256 + tk] = f2bf(acc[r]);
            else {
              const int n1 = tk - LC;
              if (part == 0 || n1 < 2048) ((bf16_t*)(p.ws + OFF_BTFT))[((size_t)(b * 256 + g * 64 + k2)) * 4160 + part * 2112 + n1] = f2bf(acc[r]);
            }
          }
        }
      }
      }
    }
  }
}

DI int dn_step(int c, int d) { return c < 4 ? (d ? 3 - c : c) : 4 + (d ? 67 - c : c - 4); }

DI void dnprep_item(const Params& p, int l, int item, char* smem, char* dsm0) {
  const int b = item / (4 * NCH), h = (item / NCH) & 3, c = item % NCH;
  bf16_t* qb = (bf16_t*)smem;
  bf16_t* kb = qb + 64 * 72;
  float* kf = (float*)(smem + 18432);
  float* vf = kf + 4096;
  float* Am = kf;
  int tid_ = ltid();
  const int tid = tid_, lane = tid & 63, w = tid >> 6, lr = lane & 15, lq = lane >> 4;
  const int tok0 = b * TB + c * 64;
  const bool isctx = c < 4;
  const int sbeg = isctx ? b * TB : b * TB + LC, send = isctx ? b * TB + LC : (b + 1) * TB;
  const bf16_t* P = (const bf16_t*)(p.ws + OFF_P);
  const int tau = tid >> 2, cq = tid & 3;
  const int t = tok0 + tau;
  float qv[16], kv[16], vv[16];
  __syncthreads();
#pragma unroll
  for (int part = 0; part < 3; ++part) {
    const int col = part * 256 + h * 64 + cq * 16;
    const float* cw = p.conv_w + (size_t)l * 3 * 768 + col;
    const bool hasp = t - 1 >= sbeg, hasn = t + 1 < send;
    const u32x4 z4 = {0u, 0u, 0u, 0u};
    const u32x4 a1l = *(const u32x4*)(P + (size_t)t * PW + col), a1h = *(const u32x4*)(P + (size_t)t * PW + col + 8);
    u32x4 a0l = z4, a0h = z4, a2l = z4, a2h = z4;
    if (hasp) { a0l = *(const u32x4*)(P + (size_t)(t - 1) * PW + col); a0h = *(const u32x4*)(P + (size_t)(t - 1) * PW + col + 8); }
    if (hasn) { a2l = *(const u32x4*)(P + (size_t)(t + 1) * PW + col); a2h = *(const u32x4*)(P + (size_t)(t + 1) * PW + col + 8); }
#pragma unroll
    for (int e = 0; e < 16; ++e) {
      const unsigned w0 = e < 8 ? a0l[(e & 7) >> 1] : a0h[(e & 7) >> 1];
      const unsigned w1 = e < 8 ? a1l[(e & 7) >> 1] : a1h[(e & 7) >> 1];
      const unsigned w2 = e < 8 ? a2l[(e & 7) >> 1] : a2h[(e & 7) >> 1];
      const float x0 = (e & 1) ? bfhi(w0) : bflo(w0);
      const float x1 = (e & 1) ? bfhi(w1) : bflo(w1);
      const float x2 = (e & 1) ? bfhi(w2) : bflo(w2);
      const float y = x0 * cw[e] + x1 * cw[768 + e] + x2 * cw[1536 + e];
      const float sv = silu_f(y);
      if (part == 0) qv[e] = sv; else if (part == 1) kv[e] = sv; else vv[e] = sv;
    }
    asm volatile("" ::: "memory");
  }
  {
    float sq = 0.f, sk = 0.f;
#pragma unroll
    for (int e = 0; e < 16; ++e) { sq += qv[e] * qv[e]; sk += kv[e] * kv[e]; }
    sq += __shfl_xor(sq, 1); sq += __shfl_xor(sq, 2);
    sk += __shfl_xor(sk, 1); sk += __shfl_xor(sk, 2);
    const float rq = rsqrtf(sq + EPS) * 0.125f, rk = rsqrtf(sk + EPS);
#pragma unroll
    for (int e = 0; e < 16; ++e) { qv[e] *= rq; kv[e] *= rk; }
  }
  float* gl = (float*)(dsm0 + (ltid_full() >> 8) * HALF_SMEM + 18432 + 32768);
  float* bl = gl + 128;
  float* gc = bl + 128;
  float* bd = gc + 128;
  if (tid < 128) {
    const int d = tid >> 6, i = tid & 63, ta = d ? 63 - i : i;
    const bf16_t* pr = P + (size_t)(tok0 + ta) * PW + 768;
    const float a = bf2f(pr[d * 4 + h]), bb = bf2f(pr[8 + d * 4 + h]);
    const float xx = a + p.dt_bias[l * 8 + d * 4 + h];
    const float ex = __expf(xx);
    const float sp = xx > 20.f ? xx : (ex < 0.03f ? ex * (1.f - ex * (0.5f - ex * (1.f / 3.f - 0.25f * ex))) : __logf(1.f + ex));
    float v = -__expf(p.A_log[l * 8 + d * 4 + h]) * sp;
#pragma unroll
    for (int off = 1; off < 64; off <<= 1) {
      const float tq = __shfl_up(v, off);
      if (i >= off) v += tq;
    }
    gc[d * 64 + i] = v;
    bd[d * 64 + i] = 1.f / (1.f + __expf(-bb));
  }
  {
#pragma unroll
    for (int e = 0; e < 16; e += 4) {
      *(uint2*)(qb + tau * 72 + cq * 16 + e) = uint2{pk(qv[e], qv[e + 1]), pk(qv[e + 2], qv[e + 3])};
      *(uint2*)(kb + tau * 72 + cq * 16 + e) = uint2{pk(kv[e], kv[e + 1]), pk(kv[e + 2], kv[e + 3])};
      *(float4*)(kf + tau * 64 + cq * 16 + e) = float4{kv[e], kv[e + 1], kv[e + 2], kv[e + 3]};
      *(float4*)(vf + tau * 64 + cq * 16 + e) = float4{vv[e], vv[e + 1], vv[e + 2], vv[e + 3]};
    }
  }
  __syncthreads();
#pragma unroll
  for (int d = 0; d < 2; ++d) {
    const int i = d ? 63 - tau : tau;
    const int cb = ((b * 4 + h) * 2 + d) * NCH + dn_step(c, d);
    bf16_t* base = (bf16_t*)(p.ws + OFF_DN + (size_t)cb * SZ_CB);
    const float eg = __expf(gc[d * 64 + i]);
    bf16_t* qd = base + 4096 + i * 64;
#pragma unroll
    for (int q4 = 0; q4 < 4; ++q4) {
      const int pos = (cq >> 1) * 32 + q4 * 8 + (cq & 1) * 4;
      *(uint2*)(qd + pos) = uint2{pk(qv[q4 * 4] * eg, qv[q4 * 4 + 1] * eg), pk(qv[q4 * 4 + 2] * eg, qv[q4 * 4 + 3] * eg)};
    }
  }
#pragma unroll
  for (int d = 0; d < 2; ++d) {
    const int cb = ((b * 4 + h) * 2 + d) * NCH + dn_step(c, d);
    bf16_t* kt = (bf16_t*)(p.ws + OFF_DN + (size_t)cb * SZ_CB) + 3 * 4096 + tau * 64 + cq * 16;
    const float gl63 = gc[d * 64 + 63];
    unsigned o[8];
#pragma unroll
    for (int e2 = 0; e2 < 8; ++e2) {
      float vals[2];
#pragma unroll
      for (int hq = 0; hq < 2; ++hq) {
        const int e = e2 * 2 + hq;
        const int i = (2 * (cq >> 1) + ((e >> 2) & 1)) * 16 + ((((cq & 1) << 1) | (e >> 3)) << 2) + (e & 3);
        const int ta = d ? 63 - i : i;
        vals[hq] = kf[ta * 64 + tau] * __expf(gl63 - gc[d * 64 + i]);
      }
      o[e2] = pk(vals[0], vals[1]);
    }
    *(uint4*)kt = uint4{o[0], o[1], o[2], o[3]};
    *(uint4*)(kt + 8) = uint4{o[4], o[5], o[6], o[7]};
  }
  if (tid < 128) {
    const int d = tid >> 6;
    const int cb = ((b * 4 + h) * 2 + d) * NCH + dn_step(c, d);
    ((float*)(p.ws + OFF_GEND))[(size_t)cb * 64 + (tid & 63)] = __expf(gc[d * 64 + 63]);
  }
  f32x4 KK[4], QK[4];
  {
    bf16x8 ak[2], aq[2];
#pragma unroll
    for (int ks = 0; ks < 2; ++ks) {
      ak[ks] = *(const bf16x8*)(kb + (w * 16 + lr) * 72 + ks * 32 + lq * 8);
      aq[ks] = *(const bf16x8*)(qb + (w * 16 + lr) * 72 + ks * 32 + lq * 8);
    }
#pragma unroll
    for (int nt = 0; nt < 4; ++nt) {
      KK[nt] = f32x4{0.f, 0.f, 0.f, 0.f};
      QK[nt] = f32x4{0.f, 0.f, 0.f, 0.f};
#pragma unroll
      for (int ks = 0; ks < 2; ++ks) {
        const bf16x8 bk = *(const bf16x8*)(kb + (nt * 16 + lr) * 72 + ks * 32 + lq * 8);
        KK[nt] = MFMA16(ak[ks], bk, KK[nt]);
        QK[nt] = MFMA16(aq[ks], bk, QK[nt]);
      }
    }
  }
  const int sd = w >> 1, half = w & 1;
  float xs[64];
#pragma unroll
  for (int i = 0; i < 64; ++i) {
    const int ta = sd ? 63 - i : i;
    const float bt = bd[sd * 64 + i];
    xs[i] = half ? kf[ta * 64 + lane] * bt * __expf(gc[sd * 64 + i]) : vf[ta * 64 + lane] * bt;
    if ((i & 7) == 7) asm volatile("" ::: "memory");
  }
  __syncthreads();
#pragma unroll
  for (int d = 0; d < 2; ++d) {
    const int cb = ((b * 4 + h) * 2 + d) * NCH + dn_step(c, d);
    bf16_t* inb = (bf16_t*)(p.ws + OFF_DN + (size_t)cb * SZ_CB) + 2 * 4096;
#pragma unroll
    for (int nt = 0; nt < 4; ++nt)
#pragma unroll
      for (int r = 0; r < 4; ++r) {
        const int ti = w * 16 + lq * 4 + r, tj = nt * 16 + lr;
        const int i = d ? 63 - ti : ti, j = d ? 63 - tj : tj;
        const float dec = (i >= j) ? __expf(gc[d * 64 + i] - gc[d * 64 + j]) : 0.f;
        Am[d * 4096 + i * 64 + j] = (i > j) ? bd[d * 64 + i] * KK[nt][r] * dec : 0.f;
        inb[i * 64 + permk(j)] = f2bf(QK[nt][r] * dec);
        if (r == 3) asm volatile("" ::: "memory");
      }
  }
  __syncthreads();
  {
    const float* Ad = Am + sd * 4096;
#pragma unroll
    for (int i = 1; i < 64; ++i) {
      float s = xs[i];
#pragma unroll
      for (int j4 = 0; j4 <= (i - 1) / 4; ++j4) {
        const float4 a = *(const float4*)(Ad + i * 64 + j4 * 4);
        s -= a.x * xs[j4 * 4];
        s -= a.y * xs[j4 * 4 + 1];
        s -= a.z * xs[j4 * 4 + 2];
        s -= a.w * xs[j4 * 4 + 3];
      }
      xs[i] = s;
      asm volatile("" ::: "memory");
    }
    const int cb = ((b * 4 + h) * 2 + sd) * NCH + dn_step(c, sd);
    bf16_t* base = (bf16_t*)(p.ws + OFF_DN + (size_t)cb * SZ_CB);
    if (half == 0) {
      bf16_t* U = base + 4 * 4096;
#pragma unroll
      for (int i4 = 0; i4 < 16; ++i4) {
        const int mt = i4 >> 2, q4 = i4 & 3;
        *(uint2*)(U + ((((mt * 4 + (lane >> 4)) * 4 + q4) * 16 + (lane & 15)) << 2)) = uint2{pk(xs[i4 * 4], xs[i4 * 4 + 1]), pk(xs[i4 * 4 + 2], xs[i4 * 4 + 3])};
      }
    } else {
      bf16_t* Wn = base;
      const int pc = permk(lane);
#pragma unroll
      for (int i = 0; i < 64; ++i) Wn[i * 64 + pc] = f2bf(-xs[i]);
    }
  }
}

DI bf16x8 pack8(const f32x4& a, const f32x4& b) {
  uint4 u = {pk(a[0], a[1]), pk(a[2], a[3]), pk(b[0], b[1]), pk(b[2], b[3])};
  return __builtin_bit_cast(bf16x8, u);
}

DI void dnscan_item(const Params& p, int item, LAS char* lb) {
  const int b = item >> 3, h = (item >> 1) & 3, d = item & 1;
  int tid_ = ltid();
  const int lane = tid_ & 63, w = tid_ >> 6, lr = lane & 15, lq = lane >> 4;
  f32x4 S[4];
#pragma unroll
  for (int mt = 0; mt < 4; ++mt) S[mt] = f32x4{0.f, 0.f, 0.f, 0.f};
  const int cb0 = ((b * 4 + h) * 2 + d) * NCH;
  unsigned pfacc = 0u;
  int soff[8];
#pragma unroll
  for (int i = 0; i < 8; ++i) {
    const int j = w * 512 + i * 64 + lane, jj = j & 511, row = jj >> 3, ch = jj & 7;
    soff[i] = (j >> 9) * 4096 + row * 64 + ((ch ^ (row & 7)) << 3);
  }
#define SC_STAGE(buf, step)                                                                                                                   \
  do {                                                                                                                                        \
    const bf16_t* gb_ = (const bf16_t*)(p.ws + OFF_DN + (size_t)(cb0 + (step)) * SZ_CB);                                                       \
    _Pragma("unroll") for (int i = 0; i < 8; ++i)                                                                                             \
      __builtin_amdgcn_global_load_lds((const unsigned*)(gb_ + soff[i]), (LAS unsigned*)(lb + (buf) * 32768 + (w * 512 + i * 64) * 16), 16, 0, 0); \
  } while (0)
  int foff[4][2];
#pragma unroll
  for (int mt = 0; mt < 4; ++mt)
#pragma unroll
    for (int ks = 0; ks < 2; ++ks) { const int row = mt * 16 + lr; foff[mt][ks] = row * 128 + (((ks * 4 + lq) ^ (row & 7)) << 4); }
  SC_STAGE(0, 0);
  uint2 uu[4];
  float ge;
  {
    const bf16_t* base = (const bf16_t*)(p.ws + OFF_DN + (size_t)cb0 * SZ_CB);
#pragma unroll
    for (int mt = 0; mt < 4; ++mt) uu[mt] = *(const uint2*)(base + 4 * 4096 + ((((mt * 4 + w) * 4 + lq) * 16 + lr) << 2));
    ge = ((const float*)(p.ws + OFF_GEND))[(size_t)cb0 * 64 + lane];
  }
  WAIT_V(0);
#pragma unroll 1
  for (int s = 0; s < NCH; ++s) {
    WAIT_V(8);
    __syncthreads();
    if (s + 1 < NCH) SC_STAGE((s + 1) & 1, s + 1);
    uint2 un[4] = {uu[0], uu[1], uu[2], uu[3]};
    float gn = ge;
    if (s + 1 < NCH) {
      const bf16_t* nb = (const bf16_t*)(p.ws + OFF_DN + (size_t)(cb0 + s + 1) * SZ_CB);
#pragma unroll
      for (int mt = 0; mt < 4; ++mt) un[mt] = *(const uint2*)(nb + 4 * 4096 + ((((mt * 4 + w) * 4 + lq) * 16 + lr) << 2));
      gn = ((const float*)(p.ws + OFF_GEND))[(size_t)(cb0 + s + 1) * 64 + lane];
    }
    unsigned pf0 = 0u, pf1 = 0u;
    if (s + 2 < NCH) {
      const unsigned* nb = (const unsigned*)(p.ws + OFF_DN + (size_t)(cb0 + s + 2) * SZ_CB);
      pf0 = nb[(w * 80 + lane) * 32];
      if (lane < 16) pf1 = nb[(w * 80 + 64 + lane) * 32];
    }
    const LAS char* sb = lb + (s & 1) * 32768;
    bf16x8 sB[2];
    sB[0] = pack8(S[0], S[1]);
    sB[1] = pack8(S[2], S[3]);
    f32x4 vn[4], o[4];
#pragma unroll
    for (int mt = 0; mt < 4; ++mt) {
      vn[mt] = f32x4{bflo(uu[mt].x), bfhi(uu[mt].x), bflo(uu[mt].y), bfhi(uu[mt].y)};
      o[mt] = f32x4{0.f, 0.f, 0.f, 0.f};
#pragma unroll
      for (int ks = 0; ks < 2; ++ks) {
        const bf16x8 aw = *(const LAS bf16x8*)(sb + foff[mt][ks]);
        const bf16x8 aq = *(const LAS bf16x8*)(sb + 8192 + foff[mt][ks]);
        vn[mt] = MFMA16(aw, sB[ks], vn[mt]);
        o[mt] = MFMA16(aq, sB[ks], o[mt]);
      }
    }
    bf16x8 vB[2];
    vB[0] = pack8(vn[0], vn[1]);
    vB[1] = pack8(vn[2], vn[3]);
#pragma unroll
    for (int mt = 0; mt < 4; ++mt) {
#pragma unroll
      for (int r = 0; r < 4; ++r) S[mt][r] *= ge;
#pragma unroll
      for (int ks = 0; ks < 2; ++ks) {
        const bf16x8 ai = *(const LAS bf16x8*)(sb + 16384 + foff[mt][ks]);
        const bf16x8 ak = *(const LAS bf16x8*)(sb + 24576 + foff[mt][ks]);
        o[mt] = MFMA16(ai, vB[ks], o[mt]);
        S[mt] = MFMA16(ak, vB[ks], S[mt]);
      }
    }
    pfacc ^= pf0 ^ pf1;
#pragma unroll
    for (int mt = 0; mt < 4; ++mt) uu[mt] = un[mt];
    ge = gn;
    int dl = d;
    asm volatile("" : "+v"(dl));
    float* Od = (float*)(p.ws + OFF_ODN) + (size_t)dl * T * 256;
    const int c = s < 4 ? (d ? 3 - s : s) : 4 + (d ? 67 - s : s - 4);
#pragma unroll
    for (int mt = 0; mt < 4; ++mt)
#pragma unroll
      for (int r = 0; r < 4; ++r) {
        const int i = mt * 16 + lq * 4 + r;
        const int ta = d ? 63 - i : i;
        Od[((size_t)(b * TB + c * 64 + ta)) * 256 + h * 64 + w * 16 + lr] = o[mt][r];
      }
  }
#undef SC_STAGE
  __syncthreads();
  if (pfacc == 0x9e3779b9u && ((const float*)(p.ws + OFF_GEND))[0] == 123.456f) ((float*)(p.ws + OFF_ODN))[0] = 0.f;
}

DI void attn_item(const Params& p, int l, int type, int b, int kvh, int qb, char* smem) {
  constexpr int KB = 64 * 64 * 2, VB = 64 * 72 * 2, SB = KB + VB;
  int tid_ = ltid();
  const int tid = tid_, lane = tid & 63, w = tid >> 6, lr = lane & 15, lq = lane >> 4;
  const int g = w >> 1, qh = kvh * 2 + g;
  const int qloc0 = qb * 64 + (w & 1) * 32;
  const bool isctx = qb < 4;
  const bf16_t* Qa = (const bf16_t*)(p.ws + OFF_QA) + ((size_t)type * T + (size_t)b * TB) * 256 + qh * 64;
  const bf16_t* Kg = (const bf16_t*)(p.ws + OFF_KA) + ((size_t)type * T + (size_t)b * TB) * 128 + kvh * 64;
  const bf16_t* Vg = (const bf16_t*)(p.ws + OFF_VT) + ((size_t)(type * NB + b) * 128 + kvh * 64) * TB;
  bf16x8 qf[2][2];
#pragma unroll
  for (int nt = 0; nt < 2; ++nt)
#pragma unroll
    for (int ks = 0; ks < 2; ++ks) qf[nt][ks] = *(const bf16x8*)(Qa + (size_t)(qloc0 + nt * 16 + lr) * 256 + ks * 32 + lq * 8);
  float neg_big;
  asm volatile("v_mov_b32 %0, 0xf149f2ca" : "=v"(neg_big));
  float mrun[2];
  f32x4 O[4][2], Ls[2];
  const bf16x8 ones8 = {(short)0x3F80, (short)0x3F80, (short)0x3F80, (short)0x3F80, (short)0x3F80, (short)0x3F80, (short)0x3F80, (short)0x3F80};
#pragma unroll
  for (int nt = 0; nt < 2; ++nt) {
    if (type == 1) { mrun[nt] = p.wa_sink[l * 4 + qh] * LOG2E; Ls[nt] = f32x4{1.f, 1.f, 1.f, 1.f}; }
    else { mrun[nt] = neg_big; Ls[nt] = f32x4{0.f, 0.f, 0.f, 0.f}; }
#pragma unroll
    for (int mt = 0; mt < 4; ++mt) O[mt][nt] = f32x4{0.f, 0.f, 0.f, 0.f};
  }
  const int n_lat_lo = (!isctx && type == 1) ? qb - 2 : 4;
  const int ntiles = isctx ? 4 : (type == 0 ? NCH : 9);
  const int lrow = tid >> 3, lch = tid & 7;
  u32x4 rk[2], rv[2];
#pragma unroll
  for (int i = 0; i < 2; ++i) {
    rk[i] = *(const u32x4*)(Kg + (size_t)(lrow + i * 32) * 128 + lch * 8);
    rv[i] = *(const u32x4*)(Vg + (size_t)(lrow + i * 32) * TB + lch * 8);
  }
#pragma unroll
  for (int i = 0; i < 2; ++i) {
    const int r = lrow + i * 32;
    *(u32x4*)(smem + r * 128 + ((lch ^ (r & 7)) << 4)) = rk[i];
    *(u32x4*)(smem + KB + r * 144 + lch * 16) = rv[i];
  }
  __syncthreads();
  for (int ti = 0; ti < ntiles; ++ti) {
    const int jraw = ti < 4 ? ti : n_lat_lo + (ti - 4);
    const bool tvalid = ti < 4 || (jraw >= 4 && jraw < NCH);
    const int jt = ti < 4 ? ti : (jraw < 4 ? 4 : (jraw > NCH - 1 ? NCH - 1 : jraw));
    const char* sK = smem + (ti & 1) * SB;
    const char* sV = sK + KB;
    if (ti + 1 < ntiles) {
      const int jn0 = (ti + 1) < 4 ? ti + 1 : n_lat_lo + (ti + 1 - 4);
      const int jn = (ti + 1) < 4 ? jn0 : (jn0 < 4 ? 4 : (jn0 > NCH - 1 ? NCH - 1 : jn0));
#pragma unroll
      for (int i = 0; i < 2; ++i) {
        rk[i] = *(const u32x4*)(Kg + (size_t)(jn * 64 + lrow + i * 32) * 128 + lch * 8);
        rv[i] = *(const u32x4*)(Vg + (size_t)(lrow + i * 32) * TB + jn * 64 + lch * 8);
      }
    }
    f32x4 sc[4][2];
#pragma unroll
    for (int mt = 0; mt < 4; ++mt) {
      const int r = mt * 16 + lr;
      const bf16x8 kf0 = *(const bf16x8*)(sK + r * 128 + ((lq ^ (r & 7)) << 4));
      const bf16x8 kf1 = *(const bf16x8*)(sK + r * 128 + (((4 + lq) ^ (r & 7)) << 4));
#pragma unroll
      for (int nt = 0; nt < 2; ++nt) {
        f32x4 a = {0.f, 0.f, 0.f, 0.f};
        a = MFMA16(kf0, qf[nt][0], a);
        a = MFMA16(kf1, qf[nt][1], a);
        sc[mt][nt] = a;
      }
    }
    const bool domask = (type == 1) && !isctx && (jt >= 4);
#pragma unroll
    for (int nt = 0; nt < 2; ++nt) {
      if (domask) {
#pragma unroll
        for (int mt = 0; mt < 4; ++mt)
#pragma unroll
          for (int r = 0; r < 4; ++r) {
            const int kpos = jt * 64 + mt * 16 + lq * 4 + r, qpos = qloc0 + nt * 16 + lr;
            const int df = qpos - kpos;
            if (df > 128 || df < -128 || !tvalid) sc[mt][nt][r] = neg_big;
          }
      }
      float mx = __builtin_fmaxf(__builtin_fmaxf(sc[0][nt][0], sc[0][nt][1]), sc[0][nt][2]);
      mx = __builtin_fmaxf(__builtin_fmaxf(mx, sc[0][nt][3]), sc[1][nt][0]);
      mx = __builtin_fmaxf(__builtin_fmaxf(mx, sc[1][nt][1]), sc[1][nt][2]);
      mx = __builtin_fmaxf(__builtin_fmaxf(mx, sc[1][nt][3]), sc[2][nt][0]);
      mx = __builtin_fmaxf(__builtin_fmaxf(mx, sc[2][nt][1]), sc[2][nt][2]);
      mx = __builtin_fmaxf(__builtin_fmaxf(mx, sc[2][nt][3]), sc[3][nt][0]);
      mx = __builtin_fmaxf(__builtin_fmaxf(mx, sc[3][nt][1]), sc[3][nt][2]);
      mx = __builtin_fmaxf(mx, sc[3][nt][3]);
      mx = fmaxf(mx, __shfl_xor(mx, 16));
      mx = fmaxf(mx, __shfl_xor(mx, 32));
      if (__builtin_amdgcn_ballot_w64(mx > mrun[nt] + 8.f) != 0ull) {
        const float mnew = fmaxf(mrun[nt], mx);
        const float alpha = __builtin_amdgcn_exp2f(mrun[nt] - mnew);
        mrun[nt] = mnew;
#pragma unroll
        for (int r = 0; r < 4; ++r) Ls[nt][r] *= alpha;
#pragma unroll
        for (int mt = 0; mt < 4; ++mt)
#pragma unroll
          for (int r = 0; r < 4; ++r) O[mt][nt][r] *= alpha;
      }
      const float mref = mrun[nt];
      typedef float f32x2v __attribute__((ext_vector_type(2)));
      const f32x2v mref2 = {mref, mref};
#pragma unroll
      for (int mt = 0; mt < 4; ++mt)
#pragma unroll
        for (int r = 0; r < 4; r += 2) {
          f32x2v t2 = {sc[mt][nt][r], sc[mt][nt][r + 1]};
          t2 = t2 - mref2;
          sc[mt][nt][r] = __builtin_amdgcn_exp2f(t2[0]);
          sc[mt][nt][r + 1] = __builtin_amdgcn_exp2f(t2[1]);
        }
    }
    bf16x8 pB[2][2];
#pragma unroll
    for (int nt = 0; nt < 2; ++nt) {
      pB[nt][0] = pack8(sc[0][nt], sc[1][nt]);
      pB[nt][1] = pack8(sc[2][nt], sc[3][nt]);
      Ls[nt] = MFMA16(ones8, pB[nt][0], Ls[nt]);
      Ls[nt] = MFMA16(ones8, pB[nt][1], Ls[nt]);
    }
#pragma unroll
    for (int mt = 0; mt < 4; ++mt)
#pragma unroll
      for (int ks = 0; ks < 2; ++ks) {
        const bf16x4 v0 = *(const bf16x4*)(sV + (mt * 16 + lr) * 144 + ((2 * ks) * 16 + lq * 4) * 2);
        const bf16x4 v1 = *(const bf16x4*)(sV + (mt * 16 + lr) * 144 + ((2 * ks + 1) * 16 + lq * 4) * 2);
        const bf16x8 vfr = __builtin_shufflevector(v0, v1, 0, 1, 2, 3, 4, 5, 6, 7);
#pragma unroll
        for (int nt = 0; nt < 2; ++nt) O[mt][nt] = MFMA16(vfr, pB[nt][ks], O[mt][nt]);
      }
    if (ti + 1 < ntiles) {
      char* dK = smem + ((ti + 1) & 1) * SB;
#pragma unroll
      for (int i = 0; i < 2; ++i) {
        const int r = lrow + i * 32;
        *(u32x4*)(dK + r * 128 + ((lch ^ (r & 7)) << 4)) = rk[i];
        *(u32x4*)(dK + KB + r * 144 + lch * 16) = rv[i];
      }
    }
    __syncthreads();
  }
  bf16_t* Y = (bf16_t*)(p.ws + OFF_YMIX);
#pragma unroll
  for (int nt = 0; nt < 2; ++nt) {
    const float inv = 1.f / Ls[nt][0];
    const size_t row = (size_t)b * TB + qloc0 + nt * 16 + lr;
#pragma unroll
    for (int mt = 0; mt < 4; ++mt) {
      uint2 v = {pk(O[mt][nt][0] * inv, O[mt][nt][1] * inv), pk(O[mt][nt][2] * inv, O[mt][nt][3] * inv)};
      *(uint2*)(Y + row * 1024 + (type ? 512 : 256) + qh * 64 + mt * 16 + lq * 4) = v;
    }
  }
}

DI void dnmerge_item(const Params& p, int l, int item) {
  const int tid = ltid();
  const int w = tid >> 6, lane = tid & 63;
  const int t = item * 4 + w;
  const float* o0 = (const float*)(p.ws + OFF_ODN) + (size_t)t * 256 + lane * 4;
  const float* o1 = o0 + (size_t)T * 256;
  const float4 a = *(const float4*)o0, bq = *(const float4*)o1;
  float v[4] = {a.x + bq.x, a.y + bq.y, a.z + bq.z, a.w + bq.w};
  float ss = v[0] * v[0] + v[1] * v[1] + v[2] * v[2] + v[3] * v[3];
  ss += __shfl_xor(ss, 1); ss += __shfl_xor(ss, 2); ss += __shfl_xor(ss, 4); ss += __shfl_xor(ss, 8);
  const float rs = rsqrtf(ss * (1.f / 64.f) + EPS);
  const int dim = (lane & 15) * 4;
  const float4 gn = *(const float4*)(p.dn_norm_g + l * 64 + dim);
  const uint2 zz = *(const uint2*)((const bf16_t*)(p.ws + OFF_Z) + (size_t)t * 256 + lane * 4);
  const float z0 = bflo(zz.x), z1 = bfhi(zz.x), z2 = bflo(zz.y), z3 = bfhi(zz.y);
  const float y0 = v[0] * rs * gn.x * silu_f(z0), y1 = v[1] * rs * gn.y * silu_f(z1), y2 = v[2] * rs * gn.z * silu_f(z2), y3 = v[3] * rs * gn.w * silu_f(z3);
  *(uint2*)((bf16_t*)(p.ws + OFF_YMIX) + (size_t)t * 1024 + lane * 4) = uint2{pk(y0, y1), pk(y2, y3)};
  if (lane == 0) { ((float*)(p.ws + OFF_RSS1))[t] = 0.f; ((float*)(p.ws + OFF_RSS2))[t] = 0.f; }
}


#define XB_TMO      128
#define XB_XCNT(j)  (256  + 64 * (j))
#define XB_XSUB(j)  (1280 + 64 * (j))
#define XB_XGEN(j)  (2304 + 64 * (j))
#define XB_TOP      3328
#define XB_TOPGEN   3392
#define XCD_BAR_WORDS 3456
#define XB_SPIN_CAP (1u << 18)
DI unsigned xb_ld(unsigned* p) { return __hip_atomic_load(p, __ATOMIC_RELAXED, __HIP_MEMORY_SCOPE_AGENT); }
DI unsigned xb_add(unsigned* p, unsigned v) { return __hip_atomic_fetch_add(p, v, __ATOMIC_RELAXED, __HIP_MEMORY_SCOPE_AGENT); }
DI unsigned xb_xcc_id() { return (unsigned)__builtin_amdgcn_s_getreg((3 << 11) | 20) & 0xFu; }
#define XB_SPIN(cond, bar) do { unsigned _sp = 0; while (cond) { __builtin_amdgcn_s_sleep(1); \
    if ((++_sp & 255u) == 0u) { if (xb_ld(&(bar)[XB_TMO])) break; if (_sp > XB_SPIN_CAP) { atomicAdd(&(bar)[XB_TMO], 1u); break; } } } } while (0)
struct XcdBarrier { unsigned* bar; unsigned x; volatile LAS unsigned* st; };
DI XcdBarrier xcd_barrier_post(unsigned* bar, volatile LAS unsigned* st) {
  XcdBarrier b; b.bar = bar; b.x = xb_xcc_id(); b.st = st;
  if (threadIdx.x == 0) (void)xb_add(&bar[XB_XCNT(b.x)], 1u);
  return b;
}
DI void xcd_barrier_complete(unsigned* bar, unsigned x, unsigned& nloc, unsigned& nx) {
  const unsigned G = gridDim.x * gridDim.y * gridDim.z;
  unsigned sum, cnt, mine, sp = 0u;
  for (;;) {
    sum = 0u; cnt = 0u; mine = 0u;
#pragma unroll
    for (unsigned j = 0; j < 16; ++j) { const unsigned c = xb_ld(&bar[XB_XCNT(j)]); sum += c; cnt += (c > 0u) ? 1u : 0u; mine = (j == x) ? c : mine; }
    if (sum == G) break;
    __builtin_amdgcn_s_sleep(1);
    if ((++sp & 255u) == 0u) { if (xb_ld(&bar[XB_TMO])) break; if (sp > XB_SPIN_CAP) { atomicAdd(&bar[XB_TMO], 1u); break; } }
  }
  nloc = mine > 0u ? mine : 1u; nx = cnt > 0u ? cnt : 1u;
}
DI void xcd_barrier(const XcdBarrier& b) {
  asm volatile("s_waitcnt vmcnt(0)" ::: "memory");
  __syncthreads();
  if (ltid_full() == 0) {
    unsigned* bar = b.bar;
    asm volatile("" : "+s"(bar));
    __builtin_amdgcn_s_waitcnt(0);
    unsigned nloc = b.st[0], nx = b.st[1];
    if (nloc == 0u) { xcd_barrier_complete(bar, b.x, nloc, nx); b.st[0] = nloc; b.st[1] = nx; }
    const unsigned old = xb_add(&bar[XB_XSUB(b.x)], 1u);
    const unsigned gen = old / nloc;
    if (old + 1u == (gen + 1u) * nloc) {
      __builtin_amdgcn_fence(__ATOMIC_RELEASE, "agent");
      asm volatile("s_waitcnt vmcnt(0)" ::: "memory");
      const unsigned og = xb_add(&bar[XB_TOP], 1u);
      const unsigned tg = og / nx;
      if (og + 1u == (tg + 1u) * nx) xb_add(&bar[XB_TOPGEN], 1u);
      else XB_SPIN(xb_ld(&bar[XB_TOPGEN]) == tg, bar);
      __builtin_amdgcn_fence(__ATOMIC_ACQUIRE, "agent");
      xb_add(&bar[XB_XGEN(b.x)], 1u);
      asm volatile("s_waitcnt vmcnt(0)" ::: "memory");
    } else {
      XB_SPIN(xb_ld(&bar[XB_XGEN(b.x)]) == gen, bar);
      __builtin_amdgcn_fence(__ATOMIC_ACQUIRE, "agent");
      asm volatile("s_waitcnt vmcnt(0)" ::: "memory");
    }
  }
  __syncthreads();
}


DI Params load_params(const volatile LAS unsigned* sp) {
  Params q;
  unsigned long long* dst = (unsigned long long*)&q;
#pragma unroll
  for (int i = 0; i < (int)(sizeof(Params) / 8); ++i) {
    const unsigned lo = (unsigned)__builtin_amdgcn_readfirstlane((int)sp[2 * i]), hi = (unsigned)__builtin_amdgcn_readfirstlane((int)sp[2 * i + 1]);
    dst[i] = ((unsigned long long)hi << 32) | lo;
  }
  return q;
}
#define GSYNC() do { XcdBarrier xb_; xb_.bar = (unsigned*)(q.ws + OFF_BAR); xb_.x = xb_xcc_id(); xb_.st = (volatile LAS unsigned*)&xb_words; xcd_barrier(xb_); } while (0)
__global__ void __launch_bounds__(512, 2) mega(Params p) {
  extern __shared__ __attribute__((aligned(1024))) char dsm[];
  __shared__ uint4 xb_words;
  __shared__ int s_item;
  cg::grid_group grid = cg::this_grid();
  __shared__ unsigned sparams[sizeof(Params) / 4];
  if (threadIdx.x == 0) xb_words = make_uint4(0u, 0u, 0u, 0u);
  if (threadIdx.x < sizeof(Params) / 4) sparams[threadIdx.x] = ((const unsigned*)&p)[threadIdx.x];
  __syncthreads();
  (void)xcd_barrier_post((unsigned*)(p.ws + OFF_BAR), (volatile LAS unsigned*)&xb_words);
  const int nblk = gridDim.x, bid = blockIdx.x;
  LAS char* lds = (LAS char*)dsm;
  phase0(p, dsm);
#if EXP == 6
  __syncthreads();
  phase0(p, dsm);
#endif
  grid.sync();
  for (int l = 0; l < 4; ++l) {
    Params q = load_params((const volatile LAS unsigned*)sparams);
#define RELAUNDER() q = load_params((const volatile LAS unsigned*)sparams)
#define Hb ((const bf16_t*)(q.ws + OFF_HB))
    RELAUNDER();
    if (l == 0) {
      { const int hf = ltid_full() >> 8; char* smem = dsm + hf * HALF_SMEM; (void)smem;
      for (int pi = bid; pi < (T / 4 + 16 * 40) / 2; pi += nblk) {
        const int it = pi * 2 + hf;
        if (it < T / 4) norm_item(q, it);
        else { const int j = it - T / 4; wconv_tile<true>(q.w_in, nullptr, 2320, 1024, (bf16_t*)(q.ws + OFF_WIN), 0, j % 16, j / 16, smem, (const float*)(q.ws + OFF_MOD), (float*)(q.ws + OFF_BIAS1), 2560); }
      }
      }
      GSYNC();
    }
    RELAUNDER();
    gemm_phase8<EP_P>(q, l, Hb, (const bf16_t*)(q.ws + OFF_WIN), 1024, 136, 10, lds, false);
#if EXP == 1
    gemm_phase<EP_P>(q, l, Hb, 1024, (const bf16_t*)(q.ws + OFF_WIN), 1024, 1024, 136, 10, lds);
#endif
    GSYNC();
    RELAUNDER();
    { const int hf = ltid_full() >> 8; char* smem = dsm + hf * HALF_SMEM; (void)smem;
#if EXP == 3
    for (int rep = 0; rep < 2; ++rep)
#endif
    for (int pi = bid; pi < (NB * 4 * NCH + NB * NCH) / 2; pi += nblk) {
      const int it = pi * 2 + hf;
      if (it < NB * 4 * NCH) dnprep_item(q, l, it, smem, dsm);
      else aprep_item(q, l, it - NB * 4 * NCH, smem);
    }
    }
    GSYNC();
    RELAUNDER();
    {
    {
#if EXP == 2
      for (int rep = 0; rep < 2; ++rep) {
      int* ctr = (int*)(q.ws + OFF_CTR) + l + rep * 8;
#else
      {
      int* ctr = (int*)(q.ws + OFF_CTR) + l;
#endif
      constexpr int N_SCAN = 32, N_FT = 128, N_FTC = 8, N_GA = 512, N_WA = 512, N_CTXA = 64;
      constexpr int N_WO = 16 * 16 / 2, N_GU = 16 * 88 / 2, N_WD = 44 * 16 / 2, N_WI = 16 * 40 / 2;
      const int n_ctxa = l < 3 ? N_CTXA : 0;
      const int TOT = N_SCAN + N_FT + N_FTC + N_GA + N_WA + n_ctxa + N_WO + N_GU + N_WD + (l < 3 ? N_WI : 0);
      while (true) {
        __syncthreads();
        if (ltid_full() == 0) s_item = atomicAdd(ctr, 1);
        __syncthreads();
        int it = s_item;
        if (it >= TOT) break;
        const int hf = ltid_full() >> 8; char* smem = dsm + hf * HALF_SMEM;
        if (it < N_SCAN) { dnscan_item(q, it * 2 + hf, lds + hf * 65536); continue; }
        it -= N_SCAN;
        if (it < N_FT) { gemm8<EP_FT>(q, l, (const bf16_t*)(q.ws + OFF_ADFT), 4160, (const bf16_t*)(q.ws + OFF_BTFT), 4160, 4160, (it >> 3) * 256, (it & 7) * 256, lds); continue; }
        it -= N_FT;
        if (it < N_FTC) { gemm8<EP_FTC>(q, l, (const bf16_t*)(q.ws + OFF_ADFTC), 512, (const bf16_t*)(q.ws + OFF_BTFTC), 512, 512, 0, it * 256, lds); continue; }
        it -= N_FTC;
        if (it < N_GA) { const int j = it * 2 + hf; attn_item(q, l, 0, j >> 7, (j >> 6) & 1, 4 + (j & 63), smem); continue; }
        it -= N_GA;
        if (it < N_WA) { const int j = it * 2 + hf; attn_item(q, l, 1, j >> 7, (j >> 6) & 1, 4 + (j & 63), smem); continue; }
        it -= N_WA;
        if (it < n_ctxa) { const int j = it * 2 + hf; const int type = j >> 6, r = j & 63; attn_item(q, l, type, r >> 3, (r >> 2) & 1, r & 3, smem); continue; }
        it -= n_ctxa;
        {
          int j = it * 2 + hf;
          if (j < 2 * N_WO) { wconv_tile<false>(q.w_out + (size_t)l * 1024 * 1024, nullptr, 1024, 1024, (bf16_t*)(q.ws + OFF_WOUT), 0, j % 16, j / 16, smem); continue; }
          j -= 2 * N_WO;
          if (j < 2 * N_GU) { wconv_tile<true>(q.w_gate + (size_t)l * 1024 * HID, q.w_up + (size_t)l * 1024 * HID, HID, 1024, (bf16_t*)(q.ws + OFF_WGU), 1, j % 16, j / 16, smem,
                                     (const float*)(q.ws + OFF_MOD) + (size_t)l * 9 * 6144 + 3072, (float*)(q.ws + OFF_BIAS2) + (size_t)l * 9 * 5632, 5632); continue; }
          j -= 2 * N_GU;
          if (j < 2 * N_WD) { wconv_tile<false>(q.w_down + (size_t)l * HID * 1024, nullptr, 1024, HID, (bf16_t*)(q.ws + OFF_WD), 0, j % 44, j / 44, smem); continue; }
          j -= 2 * N_WD;
          wconv_tile<true>(q.w_in + (size_t)(l + 1) * 1024 * 2320, nullptr, 2320, 1024, (bf16_t*)(q.ws + OFF_WIN), 0, j % 16, j / 16, smem,
                           (const float*)(q.ws + OFF_MOD) + (size_t)(l + 1) * 9 * 6144, (float*)(q.ws + OFF_BIAS1) + (size_t)(l + 1) * 9 * 2560, 2560);
        }
      }
      }
    }
    }
    GSYNC();
    RELAUNDER();
    { const int hf = ltid_full() >> 8; char* smem = dsm + hf * HALF_SMEM; (void)smem;
    {
      for (int pi = bid; pi < T / 8; pi += nblk) dnmerge_item(q, l, pi * 2 + hf);
    }
    }
    GSYNC();
    RELAUNDER();
#if EXP == 1
    gemm_phase<EP_DUMMY>(q, l, (const bf16_t*)(q.ws + OFF_YMIX), 1024, (const bf16_t*)(q.ws + OFF_WOUT), 1024, 1024, 136, 4, lds);
#endif
    gemm_phase8<EP_RES1>(q, l, (const bf16_t*)(q.ws + OFF_YMIX), (const bf16_t*)(q.ws + OFF_WOUT), 1024, l == 3 ? 128 : 136, 4, lds, l == 3);
    GSYNC();
    RELAUNDER();
    gemm_phase8<EP_GU>(q, l, Hb, (const bf16_t*)(q.ws + OFF_WGU), 1024, l == 3 ? 128 : 136, 22, lds, l == 3);
#if EXP == 1
    gemm_phase<EP_GU>(q, l, Hb, 1024, (const bf16_t*)(q.ws + OFF_WGU), 1024, 1024, l == 3 ? 128 : 136, 22, lds, l == 3);
#endif
    GSYNC();
    RELAUNDER();
#if EXP == 1
    gemm_phase<EP_DUMMY>(q, l, (const bf16_t*)(q.ws + OFF_HM), HID, (const bf16_t*)(q.ws + OFF_WD), HID, HID, 136, 4, lds);
#endif
    gemm_phase8<EP_RES2>(q, l, (const bf16_t*)(q.ws + OFF_HM), (const bf16_t*)(q.ws + OFF_WD), HID, l == 3 ? 128 : 136, 4, lds, l == 3);
    GSYNC();
  }
}

#undef Hb
extern "C" void kernel_launch(void* const* d_in, const int* in_sizes, int n_in, void* d_out, int out_size, void* d_ws, size_t ws_size,
                              hipStream_t stream) {
  if (ws_size < WS_NEED) { fprintf(stderr, "workspace too small: %zu < %zu\n", ws_size, (size_t)WS_NEED); return; }
  static int grid_blocks = 0;
  if (!grid_blocks) {
    int dev = 0, cus = 0, per_cu = 0;
    (void)hipGetDevice(&dev);
    (void)hipDeviceGetAttribute(&cus, hipDeviceAttributeMultiprocessorCount, dev);
    if (hipFuncSetAttribute((const void*)mega, hipFuncAttributeMaxDynamicSharedMemorySize, LDS_BYTES) != hipSuccess) fprintf(stderr, "hipFuncSetAttribute failed\n");
    (void)hipOccupancyMaxActiveBlocksPerMultiprocessor(&per_cu, mega, 512, LDS_BYTES);
    if (per_cu < 1) { fprintf(stderr, "occupancy query returned %d\n", per_cu); per_cu = 1; }
    grid_blocks = (cus / 8) * 8;
  }
  Params p{};
  const float** pf = (const float**)&p;
  for (int i = 0; i < 22; ++i) pf[i] = (const float*)d_in[i];
  p.out = (float*)d_out;
  p.ws = (char*)d_ws;
  (void)hipMemsetAsync((char*)d_ws + OFF_BAR, 0, XCD_BAR_WORDS * 4, stream);
  void* args[] = {&p};
  hipError_t e = hipLaunchCooperativeKernel((void*)mega, dim3(grid_blocks), dim3(512), args, LDS_BYTES, stream);
  if (e != hipSuccess) fprintf(stderr, "cooperative launch failed: %s (grid %d)\n", hipGetErrorString(e), grid_blocks);
}
```

```cpp
#include <hip/hip_runtime.h>
#include <hip/hip_cooperative_groups.h>
#include <stdint.h>
#include <stdio.h>
namespace cg = cooperative_groups;

typedef unsigned short bf16_t;
typedef short bf16x8 __attribute__((ext_vector_type(8)));
typedef short bf16x4 __attribute__((ext_vector_type(4)));
typedef float f32x4 __attribute__((ext_vector_type(4)));
typedef unsigned u32x4 __attribute__((ext_vector_type(4)));
#define DI __device__ __forceinline__
#define MFMA16(a, b, c) __builtin_amdgcn_mfma_f32_16x16x32_bf16((a), (b), (c), 0, 0, 0)

constexpr int NB = 8, SEQ = 4096, LC = 256, TB = 4352, T = NB * TB, DM = 1024, PW = 2064, HID = 2816, NCH = 68;
constexpr int NIN_PAD = 2560;
constexpr float EPS = 1e-6f;
constexpr float LOG2E = 1.4426950408889634f;

constexpr size_t OFF_MOD = 0;
constexpr size_t OFF_ROPEC = 1u << 20;
constexpr size_t OFF_ROPES = OFF_ROPEC + 524288;
constexpr size_t OFF_CS64 = OFF_ROPES + 524288;
constexpr size_t OFF_ADFTC = OFF_CS64 + 16384;
constexpr size_t OFF_CTR = OFF_ADFTC + 262144;
constexpr size_t OFF_BAR = OFF_CTR + 4096;
constexpr size_t OFF_XC = 2621440;
constexpr size_t OFF_HB = OFF_XC + 8388608;
constexpr size_t SZ_HB = (size_t)T * 1024 * 2;
constexpr size_t OFF_QA = OFF_HB;
constexpr size_t OFF_KA = OFF_QA + (size_t)2 * T * 256 * 2;
constexpr size_t OFF_VT = OFF_KA + (size_t)2 * T * 128 * 2;
constexpr size_t OFF_P = OFF_HB + SZ_HB;
constexpr size_t SZ_P = (size_t)T * PW * 2;
constexpr size_t OFF_YMIX = OFF_P;
constexpr size_t OFF_ODN = OFF_P + SZ_HB;
constexpr size_t OFF_Z = OFF_P + SZ_P;
constexpr size_t OFF_BTFT = OFF_Z + (size_t)T * 256 * 2;
constexpr size_t OFF_BTFTC = OFF_BTFT + (size_t)2048 * 8192 * 2;
constexpr size_t OFF_HM = OFF_P;
constexpr size_t OFF_ADFT = OFF_BTFTC + (size_t)2048 * 512 * 2;
constexpr size_t OFF_RSS1 = OFF_ADFT + (size_t)4096 * 4160 * 2;
constexpr size_t OFF_RSS2 = OFF_RSS1 + (size_t)T * 4;
constexpr size_t OFF_BIAS1 = OFF_RSS2 + (size_t)T * 4;
constexpr size_t OFF_BIAS2 = OFF_BIAS1 + (size_t)4 * 9 * 2560 * 4;
constexpr size_t OFF_DN = OFF_ADFT + (size_t)4096 * 8192 * 2;
constexpr size_t SZ_CB = 40960;
constexpr int NCB = NB * 4 * 2 * NCH;
constexpr size_t OFF_GEND = OFF_DN + (size_t)NCB * SZ_CB;
constexpr size_t WS_NEED = OFF_GEND + (size_t)NCB * 64 * 4;
constexpr size_t OFF_WIN = OFF_BIAS2 + (size_t)4 * 9 * 5632 * 4;
constexpr size_t OFF_WOUT = OFF_WIN + (size_t)NIN_PAD * 1024 * 2;
constexpr size_t OFF_WGU = OFF_WOUT + (size_t)1024 * 1024 * 2;
constexpr size_t OFF_WD = OFF_WGU + (size_t)5632 * 1024 * 2;
static_assert(OFF_WD + (size_t)1024 * 2816 * 2 <= OFF_ADFT + (size_t)4096 * 8192 * 2, "weights overflow the ADFT region tail");
static_assert((size_t)T * HID * 2 <= OFF_ADFT - OFF_P, "Hm alias overflow");

struct Params {
  const float *x, *c, *ctx, *c_ctx, *norm1_g, *norm2_g, *w_ada, *b_ada, *w_in, *conv_w, *A_log, *dt_bias, *dn_norm_g,
      *ga_qn, *ga_kn, *wa_qn, *wa_kn, *wa_sink, *w_out, *w_gate, *w_up, *w_down;
  float* out;
  char* ws;
};

constexpr int HALF_SMEM = 53248;
constexpr int LDS_BYTES = 131072 + 8192;
#define LAS __attribute__((address_space(3)))
#define WAIT_V(n) asm volatile("s_waitcnt vmcnt(%0)" ::"n"(n) : "memory")

DI unsigned pk(float a, float b) {
  typedef __bf16 bf2 __attribute__((ext_vector_type(2)));
  typedef float f2 __attribute__((ext_vector_type(2)));
  f2 v = {a, b};
  bf2 r = __builtin_convertvector(v, bf2);
  return __builtin_bit_cast(unsigned, r);
}
DI bf16_t f2bf(float a) { return (bf16_t)(pk(a, 0.f) & 0xffffu); }
DI float bf2f(bf16_t h) { return __uint_as_float(((unsigned)h) << 16); }
DI float bflo(unsigned u) { return __uint_as_float(u << 16); }
DI float bfhi(unsigned u) { return __uint_as_float(u & 0xffff0000u); }
DI int ltid_full() { int t = threadIdx.x; asm volatile("" : "+v"(t)); return t; }
DI int ltid() { return ltid_full() & 255; }
DI float silu_f(float x) { return x * __builtin_amdgcn_rcpf(1.f + __expf(-x)); }
DI int permk(int x) { return ((x >> 5) << 5) + (((x >> 2) & 3) << 3) + (((x >> 4) & 1) << 2) + (x & 3); }

DI float* xrow(const Params& p, int t) {
  int b = t / TB, tb = t - b * TB;
  return tb < LC ? (float*)(p.ws + OFF_XC) + ((size_t)(b * LC + tb)) * DM : p.out + ((size_t)(b * SEQ + tb - LC)) * DM;
}
DI const float* xrow_in(const Params& p, int t) {
  int b = t / TB, tb = t - b * TB;
  return tb < LC ? p.ctx + ((size_t)(b * LC + tb)) * DM : p.x + ((size_t)(b * SEQ + tb - LC)) * DM;
}
DI int bidx_of(int t) { const int b = t / TB, tb = t - b * TB; return tb < LC ? 8 : b; }
DI const float* modrow(const Params& p, int l, int t) {
  int b = t / TB, tb = t - b * TB;
  int bi = tb < LC ? 8 : b;
  return (const float*)(p.ws + OFF_MOD) + ((size_t)(l * 9 + bi)) * 6144;
}

enum { EP_P = 0, EP_RES1 = 1, EP_GU = 2, EP_RES2 = 3, EP_FT = 4, EP_FTC = 5, EP_DUMMY = 6 };
#ifndef EXP
#define EXP 0
#endif

DI int lds_byte(int r, int c) {
  const int st = (r >> 4) * 2 + (c >> 5), ob = (r & 15) * 64 + (c & 31) * 2;
  return st * 1024 + (ob ^ (((ob >> 9) & 1) << 5));
}
DI void stage_rc(int b, int& R, int& C) {
  const int st = b >> 10, sb = b & 1023, swz = sb ^ (((sb >> 9) & 1) << 5);
  R = (st >> 1) * 16 + swz / 64;
  C = (st & 1) * 32 + (swz % 64) / 2;
}

template <int MODE>
DI void gemm_epilogue(const Params& p, int l, const f32x4 (&acc)[8][4], int m0, int n0, int wr, int wc, int fr, int fq, const LAS float* cst) {
#pragma unroll
  for (int i = 0; i < 8; ++i) {
    const int m = m0 + wr * 128 + i * 16 + fr;
    if (MODE == EP_P) {
      bf16_t* Pp = (bf16_t*)(p.ws + OFF_P) + (size_t)m * PW;
      bf16_t* Zp = (bf16_t*)(p.ws + OFF_Z) + (size_t)m * 256;
      const float rs = rsqrtf(cst[wr * 128 + i * 16 + fr] * (1.f / 1024.f) + EPS);
#pragma unroll
      for (int j = 0; j < 4; ++j) {
        const int n = n0 + wc * 64 + j * 16 + fq * 4;
        const f32x4 bq = *(const LAS f32x4*)(cst + 256 + wc * 64 + j * 16 + fq * 4);
        uint2 v = {pk(acc[i][j][0] * rs + bq[0], acc[i][j][1] * rs + bq[1]), pk(acc[i][j][2] * rs + bq[2], acc[i][j][3] * rs + bq[3])};
        if (n < 768) *(uint2*)(Pp + n) = v;
        else if (n < 1024) *(uint2*)(Zp + (n - 768)) = v;
        else if (n < 2320) *(uint2*)(Pp + (n - 256)) = v;
      }
    } else if (MODE == EP_RES1 || MODE == EP_RES2) {
      float* xo = xrow(p, m);
      const bool emit = (MODE == EP_RES1) || (l < 3);
      bf16_t* hb = (bf16_t*)(p.ws + OFF_HB) + (size_t)m * 1024;
      float4 xv[4];
#pragma unroll
      for (int j = 0; j < 4; ++j) xv[j] = *(const float4*)(xo + n0 + wc * 64 + j * 16 + fq * 4);
      float ssq = 0.f;
#pragma unroll
      for (int j = 0; j < 4; ++j) {
        const int n = n0 + wc * 64 + j * 16 + fq * 4;
        const f32x4 gq = *(const LAS f32x4*)(cst + 256 + wc * 64 + j * 16 + fq * 4), mq = *(const LAS f32x4*)(cst + 512 + wc * 64 + j * 16 + fq * 4);
        const float4 gv = {gq[0], gq[1], gq[2], gq[3]}, mv = {mq[0], mq[1], mq[2], mq[3]};
        xv[j].x += gv.x * acc[i][j][0]; xv[j].y += gv.y * acc[i][j][1]; xv[j].z += gv.z * acc[i][j][2]; xv[j].w += gv.w * acc[i][j][3];
        *(float4*)(xo + n) = xv[j];
        if (emit) {
          ssq += xv[j].x * xv[j].x + xv[j].y * xv[j].y + xv[j].z * xv[j].z + xv[j].w * xv[j].w;
          *(uint2*)(hb + n) = uint2{pk(xv[j].x * mv.x, xv[j].y * mv.y), pk(xv[j].z * mv.z, xv[j].w * mv.w)};
        }
      }
      if (emit) {
        ssq += __shfl_xor(ssq, 16);
        ssq += __shfl_xor(ssq, 32);
        if (fq == 0) unsafeAtomicAdd((float*)(p.ws + (MODE == EP_RES1 ? OFF_RSS2 : OFF_RSS1)) + m, ssq);
      }
    } else if (MODE == EP_GU) {
      bf16_t* hp = (bf16_t*)(p.ws + OFF_HM) + (size_t)m * HID;
      const float rs = rsqrtf(cst[wr * 128 + i * 16 + fr] * (1.f / 1024.f) + EPS);
#pragma unroll
      for (int jj = 0; jj < 2; ++jj) {
        const int hcol = ((n0 + wc * 64) >> 1) + jj * 16 + fq * 4;
        const f32x4 bg = *(const LAS f32x4*)(cst + 256 + wc * 64 + (2 * jj) * 16 + fq * 4), bu = *(const LAS f32x4*)(cst + 256 + wc * 64 + (2 * jj + 1) * 16 + fq * 4);
        const float bgv[4] = {bg[0], bg[1], bg[2], bg[3]}, buv[4] = {bu[0], bu[1], bu[2], bu[3]};
        float o[4];
#pragma unroll
        for (int r = 0; r < 4; ++r) o[r] = silu_f(acc[i][2 * jj][r] * rs + bgv[r]) * (acc[i][2 * jj + 1][r] * rs + buv[r]);
        uint2 v = {pk(o[0], o[1]), pk(o[2], o[3])};
        *(uint2*)(hp + hcol) = v;
      }
    } else if (MODE == EP_DUMMY) {
      bf16_t* dp = (bf16_t*)(p.ws + OFF_DN + (size_t)40 * 1024 * 1024) + (size_t)m * 1024;
#pragma unroll
      for (int j = 0; j < 4; ++j) {
        const int n = n0 + wc * 64 + j * 16 + fq * 4;
        *(uint2*)(dp + n) = uint2{pk(acc[i][j][0], acc[i][j][1]), pk(acc[i][j][2], acc[i][j][3])};
      }
    } else {
      bf16_t* Y = (bf16_t*)(p.ws + OFF_YMIX);
      const float scale = (MODE == EP_FT) ? (1.f / 512.f) : (1.f / 128.f);
#pragma unroll
      for (int j = 0; j < 4; ++j) {
        const int n = n0 + wc * 64 + j * 16 + fq * 4;
        const int b = n >> 8;
        const size_t row = (size_t)b * TB + (MODE == EP_FT ? LC : 0) + m;
        uint2 v = {pk(acc[i][j][0] * scale, acc[i][j][1] * scale), pk(acc[i][j][2] * scale, acc[i][j][3] * scale)};
        *(uint2*)(Y + row * 1024 + 768 + (n & 255)) = v;
      }
    }
  }
}

constexpr int G8_TILE_B = 256 * 64 * 2, G8_STAGE_B = 2 * G8_TILE_B;
#define G8_STAGE(Ab_, Bb_, buf, kt)                                                                                                            \
  do {                                                                                                                                        \
    _Pragma("unroll") for (int i = 0; i < 4; ++i) {                                                                                           \
      __builtin_amdgcn_global_load_lds((const unsigned*)((Ab_) + offA[i] + (kt) * 64), (LAS unsigned*)(lds + (buf) * G8_STAGE_B + wid * 1024 + i * 8192), 16, 0, 0);               \
      __builtin_amdgcn_global_load_lds((const unsigned*)((Bb_) + offB[i] + (kt) * 64), (LAS unsigned*)(lds + (buf) * G8_STAGE_B + G8_TILE_B + wid * 1024 + i * 8192), 16, 0, 0);   \
    }                                                                                                                                         \
  } while (0)
#define G8_COMPUTE(buf)                                                                                                                       \
  do {                                                                                                                                        \
    const LAS char* sa = lds + (buf) * G8_STAGE_B;                                                                                            \
    const LAS char* sb = sa + G8_TILE_B;                                                                                                      \
    _Pragma("unroll") for (int ks = 0; ks < 2; ++ks) {                                                                                        \
      bf16x8 bfr[4];                                                                                                                          \
      _Pragma("unroll") for (int j = 0; j < 4; ++j) bfr[j] = *(const LAS bf16x8*)(sb + lds_byte(wc * 64 + j * 16 + fr, ks * 32 + fq * 8));    \
      bf16x8 a_cur = *(const LAS bf16x8*)(sa + lds_byte(wr * 128 + fr, ks * 32 + fq * 8));                                                    \
      _Pragma("unroll") for (int i = 0; i < 8; ++i) {                                                                                         \
        bf16x8 a_nxt = a_cur;                                                                                                                 \
        if (i < 7) a_nxt = *(const LAS bf16x8*)(sa + lds_byte(wr * 128 + (i + 1) * 16 + fr, ks * 32 + fq * 8));          \
        _Pragma("unroll") for (int j = 0; j < 4; ++j) acc[i][j] = MFMA16(bfr[j], a_cur, acc[i][j]);                                           \
        __builtin_amdgcn_sched_group_barrier(0x100, 1, 0);                                                                                    \
        __builtin_amdgcn_sched_group_barrier(0x008, 4, 0);                                                                                    \
        a_cur = a_nxt;                                                                                                                        \
      }                                                                                                                                       \
    }                                                                                                                                         \
  } while (0)
#define G8_SETUP()                                                                                                                            \
  const int tid = ltid_full(), wid = tid >> 6, lane = tid & 63;                                                                               \
  const int wr = wid >> 2, wc = wid & 3, fr = lane & 15, fq = lane >> 4;                                                                      \
  int offA[4], offB[4];                                                                                                                       \
  _Pragma("unroll") for (int i = 0; i < 4; ++i) {                                                                                             \
    int R, C;                                                                                                                                 \
    stage_rc(wid * 1024 + i * 8192 + lane * 16, R, C);                                                                                        \
    offA[i] = R * lda + C;                                                                                                                    \
    offB[i] = R * ldb + C;                                                                                                                    \
  }

template <int MODE>
DI void gemm8(const Params& p, int l, const bf16_t* A, int lda, const bf16_t* Bt, int ldb, int K, int m0, int n0, LAS char* lds) {
  G8_SETUP();
  f32x4 acc[8][4];
#pragma unroll
  for (int i = 0; i < 8; ++i)
#pragma unroll
    for (int j = 0; j < 4; ++j) acc[i][j] = f32x4{0.f, 0.f, 0.f, 0.f};
  const bf16_t* Ab = A + (size_t)m0 * lda;
  const bf16_t* Bb = Bt + (size_t)n0 * ldb;
  const int nt = K >> 6;
  G8_STAGE(Ab, Bb, 0, 0);
  WAIT_V(0);
  __syncthreads();
  for (int t = 0; t < nt; ++t) {
    const int cur = t & 1;
    if (t + 1 < nt) G8_STAGE(Ab, Bb, cur ^ 1, t + 1);
    G8_COMPUTE(cur);
    WAIT_V(0);
    __syncthreads();
  }
  gemm_epilogue<MODE>(p, l, acc, m0, n0, wr, wc, fr, fq, (const LAS float*)(lds + 131072));
}

struct GTile { int m0, n0, kb, nk, atomic; };
template <int MODE>
DI bool gemm_next_tile(int k, int nM, int nN, int Kit, GTile& g, bool skipctx = false) {
  const int ntl = nM * nN, per = ntl >> 3;
  const int nb8 = gridDim.x >> 3, xcd = blockIdx.x & 7, j = blockIdx.x >> 3;
  const int R = per / nb8, rem = per - R * nb8;
  int loc;
  g.kb = 0; g.nk = Kit; g.atomic = 0;
  if (k < R) loc = k * nb8 + j;
  else if (k == R && rem > 0) {
    int S = 1;
    if (false) { S = nb8 / rem; while (S > 1 && (Kit % S)) --S; }
    if (j >= rem * S) return false;
    loc = R * nb8 + j / S;
    if (S > 1) { g.nk = Kit / S; g.kb = (j % S) * g.nk; g.atomic = 1; }
  } else return false;
  const int L = xcd * per + loc;
  const int nig = 8 * nN, gid = L / nig, fm = gid * 8, gsz = (nM - fm) < 8 ? (nM - fm) : 8;
  int pm = fm + ((L % nig) % gsz);
  if (skipctx) pm += pm / 16 + 1;
  g.m0 = pm * 256;
  g.n0 = ((L % nig) / gsz) * 256;
  return true;
}

template <int MODE>
DI void gemm_phase(const Params& p, int l, const bf16_t* A, int lda, const bf16_t* Bt, int ldb, int K, int nM, int nN, LAS char* lds, bool skipctx = false) {
  G8_SETUP();
  const int Kit = K >> 6;
  GTile cur, nxt;
  bool have = gemm_next_tile<MODE>(0, nM, nN, Kit, cur, skipctx);
  if (have) G8_STAGE(A + (size_t)cur.m0 * lda, Bt + (size_t)cur.n0 * ldb, 0, cur.kb);
  for (int k = 0; have; ++k) {
    const bool hn = gemm_next_tile<MODE>(k + 1, nM, nN, Kit, nxt, skipctx);
    f32x4 acc[8][4];
#pragma unroll
    for (int i = 0; i < 8; ++i)
#pragma unroll
      for (int j = 0; j < 4; ++j) acc[i][j] = f32x4{0.f, 0.f, 0.f, 0.f};
    const bf16_t* Ab = A + (size_t)cur.m0 * lda;
    const bf16_t* Bb = Bt + (size_t)cur.n0 * ldb;
    LAS float* cst = (LAS float*)(lds + 131072 + (k & 1) * 4096);
    if (MODE == EP_P || MODE == EP_GU) {
      const float* rss = (const float*)(p.ws + (MODE == EP_P ? OFF_RSS1 : OFF_RSS2));
      const float* bias = (const float*)(p.ws + (MODE == EP_P ? OFF_BIAS1 : OFF_BIAS2)) + ((size_t)(l * 9 + bidx_of(cur.m0))) * (MODE == EP_P ? 2560 : 5632);
      cst[tid] = tid < 256 ? rss[cur.m0 + tid] : bias[cur.n0 + tid - 256];
    }
    if (MODE == EP_RES1 || MODE == EP_RES2) {
      const float* mrow = modrow(p, l, cur.m0);
      const int c = cur.n0 + (tid & 255);
      if (tid < 256) cst[256 + tid] = mrow[(MODE == EP_RES1 ? 2048 : 5120) + c];
      else {
        const float* ng = (MODE == EP_RES1) ? p.norm2_g + l * 1024 : p.norm1_g + (l < 3 ? l + 1 : 0) * 1024;
        const float* nsc = (MODE == EP_RES1) ? mrow + 4096 : modrow(p, l < 3 ? l + 1 : 0, cur.m0) + 1024;
        cst[256 + tid] = ng[c] * (1.f + nsc[c]);
      }
    }
    WAIT_V(0);
    __syncthreads();
    for (int t = 0; t < cur.nk; ++t) {
      const int cb = t & 1;
      if (t + 1 < cur.nk) G8_STAGE(Ab, Bb, cb ^ 1, cur.kb + t + 1);
      G8_COMPUTE(cb);
      WAIT_V(0);
      __syncthreads();
    }
    if (hn) G8_STAGE(A + (size_t)nxt.m0 * lda, Bt + (size_t)nxt.n0 * ldb, 0, nxt.kb);
    gemm_epilogue<MODE>(p, l, acc, cur.m0, cur.n0, wr, wc, fr, fq, cst);
    cur = nxt;
    have = hn;
  }
}

template <int MODE>
DI void gemm_epilogue8(const Params& p, int l, const f32x4 (&acc)[2][2][4][2], int m0, int n0, int wr, int wc, int fr, int fq, const LAS float* cst) {
#pragma unroll
  for (int ai = 0; ai < 2; ++ai)
#pragma unroll
    for (int mm = 0; mm < 4; ++mm) {
      const int rl = ai * 128 + wr * 64 + mm * 16 + fr;
      const int m = m0 + rl;
      if (MODE == EP_P) {
        bf16_t* Pp = (bf16_t*)(p.ws + OFF_P) + (size_t)m * PW;
        bf16_t* Zp = (bf16_t*)(p.ws + OFF_Z) + (size_t)m * 256;
        const float rs = rsqrtf(cst[rl] * (1.f / 1024.f) + EPS);
#pragma unroll
        for (int bj = 0; bj < 2; ++bj)
#pragma unroll
          for (int nn = 0; nn < 2; ++nn) {
            const int cl = bj * 128 + wc * 32 + nn * 16 + fq * 4, n = n0 + cl;
            const f32x4 bq = *(const LAS f32x4*)(cst + 256 + cl);
            const f32x4& a = acc[ai][bj][mm][nn];
            uint2 v = {pk(a[0] * rs + bq[0], a[1] * rs + bq[1]), pk(a[2] * rs + bq[2], a[3] * rs + bq[3])};
            if (n < 768) *(uint2*)(Pp + n) = v;
            else if (n < 1024) *(uint2*)(Zp + (n - 768)) = v;
            else if (n < 2320) *(uint2*)(Pp + (n - 256)) = v;
          }
      } else if (MODE == EP_RES1 || MODE == EP_RES2) {
        float* xo = xrow(p, m);
        const bool emit = (MODE == EP_RES1) || (l < 3);
        bf16_t* hb = (bf16_t*)(p.ws + OFF_HB) + (size_t)m * 1024;
        float4 xv[4];
#pragma unroll
        for (int q4 = 0; q4 < 4; ++q4) xv[q4] = *(const float4*)(xo + n0 + (q4 >> 1) * 128 + wc * 32 + (q4 & 1) * 16 + fq * 4);
        float ssq = 0.f;
#pragma unroll
        for (int q4 = 0; q4 < 4; ++q4) {
          const int cl = (q4 >> 1) * 128 + wc * 32 + (q4 & 1) * 16 + fq * 4, n = n0 + cl;
          const f32x4 gq = *(const LAS f32x4*)(cst + 256 + cl), mq = *(const LAS f32x4*)(cst + 512 + cl);
          const f32x4& a = acc[ai][q4 >> 1][mm][q4 & 1];
          xv[q4].x += gq[0] * a[0]; xv[q4].y += gq[1] * a[1]; xv[q4].z += gq[2] * a[2]; xv[q4].w += gq[3] * a[3];
          *(float4*)(xo + n) = xv[q4];
          if (emit) {
            ssq += xv[q4].x * xv[q4].x + xv[q4].y * xv[q4].y + xv[q4].z * xv[q4].z + xv[q4].w * xv[q4].w;
            *(uint2*)(hb + n) = uint2{pk(xv[q4].x * mq[0], xv[q4].y * mq[1]), pk(xv[q4].z * mq[2], xv[q4].w * mq[3])};
          }
        }
        if (emit) {
          ssq += __shfl_xor(ssq, 16);
          ssq += __shfl_xor(ssq, 32);
          if (fq == 0) unsafeAtomicAdd((float*)(p.ws + (MODE == EP_RES1 ? OFF_RSS2 : OFF_RSS1)) + m, ssq);
        }
      } else if (MODE == EP_GU) {
        bf16_t* hp = (bf16_t*)(p.ws + OFF_HM) + (size_t)m * HID;
        const float rs = rsqrtf(cst[rl] * (1.f / 1024.f) + EPS);
#pragma unroll
        for (int bj = 0; bj < 2; ++bj) {
          const int cl = bj * 128 + wc * 32 + fq * 4;
          const int hcol = ((n0 + bj * 128 + wc * 32) >> 1) + fq * 4;
          const f32x4 bg = *(const LAS f32x4*)(cst + 256 + cl), bu = *(const LAS f32x4*)(cst + 256 + cl + 16);
          const f32x4& ag = acc[ai][bj][mm][0];
          const f32x4& au = acc[ai][bj][mm][1];
          float o[4];
#pragma unroll
          for (int r = 0; r < 4; ++r) o[r] = silu_f(ag[r] * rs + bg[r]) * (au[r] * rs + bu[r]);
          *(uint2*)(hp + hcol) = uint2{pk(o[0], o[1]), pk(o[2], o[3])};
        }
      } else {
        bf16_t* dp = (bf16_t*)(p.ws + OFF_DN + (size_t)40 * 1024 * 1024) + (size_t)m * 1024;
#pragma unroll
        for (int q4 = 0; q4 < 4; ++q4) {
          const f32x4& a = acc[ai][q4 >> 1][mm][q4 & 1];
          *(uint2*)(dp + n0 + (q4 >> 1) * 128 + wc * 32 + (q4 & 1) * 16 + fq * 4) = uint2{pk(a[0], a[1]), pk(a[2], a[3])};
        }
      }
    }
}

template <int MODE>
DI void gemm_phase8(const Params& p, int l, const bf16_t* A, const bf16_t* Bt, int K, int nM, int nN, LAS char* lds, bool skipctx) {
  constexpr int HT = 128 * 64;
  const int tid = ltid_full(), wid = tid >> 6, lane = tid & 63;
  const int wr = wid >> 2, wc = wid & 3, fr = lane & 15, fq = lane >> 4;
  unsigned soff[2];
#pragma unroll
  for (int i = 0; i < 2; ++i) { int R, C; stage_rc(tid * 16 + i * 8192, R, C); soff[i] = (unsigned)(R * K + C) * 2u; }
#define P8_SA(b, h) (lds + (((b) * 2 + (h)) * HT) * 2)
#define P8_SB(b, h) (lds + ((4 + (b) * 2 + (h)) * HT) * 2)
#define P8_STAGE(P_, BASE_, br_, kt_)                                                                                                          \
  do {                                                                                                                                        \
    const unsigned long long _gi = (unsigned long long)((BASE_) + (size_t)(br_) * K + (size_t)(kt_) * 64);                                       \
    const char* _g = (const char*)(((unsigned long long)(unsigned)__builtin_amdgcn_readfirstlane((int)(_gi >> 32)) << 32) |                    \
                                   (unsigned)__builtin_amdgcn_readfirstlane((int)(unsigned)_gi));     \
    _Pragma("unroll") for (int _i = 0; _i < 2; ++_i)                                                                                          \
      __builtin_amdgcn_global_load_lds((const unsigned*)(_g + soff[_i]), (LAS unsigned*)((P_) + wid * 1024 + _i * 8192), 16, 0, 0);            \
  } while (0)
#define P8_LDA(dst, b, h)                                                                                                                     \
  _Pragma("unroll") for (int m_ = 0; m_ < 4; ++m_) _Pragma("unroll") for (int k_ = 0; k_ < 2; ++k_)                                           \
    dst[m_][k_] = *(const LAS bf16x8*)(P8_SA(b, h) + lds_byte(wr * 64 + m_ * 16 + fr, k_ * 32 + fq * 8))
#define P8_LDB(dst, b, h)                                                                                                                     \
  _Pragma("unroll") for (int n_ = 0; n_ < 2; ++n_) _Pragma("unroll") for (int k_ = 0; k_ < 2; ++k_)                                           \
    dst[n_][k_] = *(const LAS bf16x8*)(P8_SB(b, h) + lds_byte(wc * 32 + n_ * 16 + fr, k_ * 32 + fq * 8))
#define P8_MMA(ai, bj, At_, Bt_)                                                                                                              \
  do {                                                                                                                                        \
    __builtin_amdgcn_s_setprio(1);                                                                                                            \
    _Pragma("unroll") for (int m_ = 0; m_ < 4; ++m_) _Pragma("unroll") for (int n_ = 0; n_ < 2; ++n_) _Pragma("unroll") for (int k_ = 0; k_ < 2; ++k_) \
      acc[ai][bj][m_][n_] = MFMA16(Bt_[n_][k_], At_[m_][k_], acc[ai][bj][m_][n_]);                                                            \
    __builtin_amdgcn_s_setprio(0);                                                                                                            \
  } while (0)
#define P8_MMA_B1(ai, bj, At_, Bt_) do { if (!skipb1) P8_MMA(ai, bj, At_, Bt_); } while (0)
#define P8_WAIT_L(n) asm volatile("s_waitcnt lgkmcnt(%0)" ::"n"(n) : "memory")
#define P8_BAR __builtin_amdgcn_s_barrier()
#define P8_SCHED __builtin_amdgcn_sched_barrier(0)
  const int nt = K >> 6;
  GTile cur;
  for (int k = 0; gemm_next_tile<EP_P>(k, nM, nN, nt, cur, skipctx); ++k) {
    const int brow = cur.m0, bcol = cur.n0;
    const bool skipb1 = (MODE == EP_P) && (bcol + 128 >= 2320);
    LAS float* cst = (LAS float*)(lds + 131072 + (k & 1) * 4096);
    if (MODE == EP_P || MODE == EP_GU) {
      const float* rss = (const float*)(p.ws + (MODE == EP_P ? OFF_RSS1 : OFF_RSS2));
      const float* bias = (const float*)(p.ws + (MODE == EP_P ? OFF_BIAS1 : OFF_BIAS2)) + ((size_t)(l * 9 + bidx_of(brow))) * (MODE == EP_P ? 2560 : 5632);
      cst[tid] = tid < 256 ? rss[brow + tid] : bias[bcol + tid - 256];
    }
    if (MODE == EP_RES1 || MODE == EP_RES2) {
      const float* mrow = modrow(p, l, brow);
      const int c = bcol + (tid & 255);
      if (tid < 256) cst[256 + tid] = mrow[(MODE == EP_RES1 ? 2048 : 5120) + c];
      else {
        const float* ng = (MODE == EP_RES1) ? p.norm2_g + l * 1024 : p.norm1_g + (l < 3 ? l + 1 : 0) * 1024;
        const float* nsc = (MODE == EP_RES1) ? mrow + 4096 : modrow(p, l < 3 ? l + 1 : 0, brow) + 1024;
        cst[256 + tid] = ng[c] * (1.f + nsc[c]);
      }
    }
    f32x4 acc[2][2][4][2];
#pragma unroll
    for (int a_ = 0; a_ < 2; ++a_)
#pragma unroll
      for (int b_ = 0; b_ < 2; ++b_)
#pragma unroll
        for (int m_ = 0; m_ < 4; ++m_)
#pragma unroll
          for (int n_ = 0; n_ < 2; ++n_) acc[a_][b_][m_][n_] = f32x4{0.f, 0.f, 0.f, 0.f};
    bf16x8 At[4][2], B0[2][2], B1[2][2];
    __syncthreads();
    P8_STAGE(P8_SB(0, 0), Bt, bcol, 0); P8_STAGE(P8_SA(0, 0), A, brow, 0);
    P8_STAGE(P8_SB(0, 1), Bt, bcol + 128, 0); P8_STAGE(P8_SA(0, 1), A, brow + 128, 0);
    if (wr == 1) P8_BAR;
    WAIT_V(4); P8_BAR;
    P8_STAGE(P8_SB(1, 0), Bt, bcol, 1); P8_STAGE(P8_SA(1, 0), A, brow, 1); P8_STAGE(P8_SB(1, 1), Bt, bcol + 128, 1);
    WAIT_V(6); P8_BAR;
    for (int t = 0; t < nt - 2; t += 2) {
      P8_LDB(B0, 0, 0); P8_SCHED; P8_LDA(At, 0, 0); P8_STAGE(P8_SA(1, 1), A, brow + 128, t + 1);
      P8_WAIT_L(8); P8_BAR; P8_WAIT_L(0); P8_MMA(0, 0, At, B0); P8_BAR; P8_SCHED;
      P8_LDB(B1, 0, 1); P8_STAGE(P8_SB(0, 0), Bt, bcol, t + 2);
      P8_BAR; P8_WAIT_L(0); P8_MMA_B1(0, 1, At, B1); P8_BAR;
      P8_LDA(At, 0, 1); P8_STAGE(P8_SA(0, 0), A, brow, t + 2);
      P8_BAR; P8_WAIT_L(0); P8_MMA(1, 0, At, B0); P8_BAR; P8_SCHED;
      P8_STAGE(P8_SB(0, 1), Bt, bcol + 128, t + 2);
      WAIT_V(6); P8_BAR; P8_MMA_B1(1, 1, At, B1); P8_BAR;
      P8_LDB(B0, 1, 0); P8_SCHED; P8_LDA(At, 1, 0); P8_STAGE(P8_SA(0, 1), A, brow + 128, t + 2);
      P8_WAIT_L(8); P8_BAR; P8_WAIT_L(0); P8_MMA(0, 0, At, B0); P8_BAR; P8_SCHED;
      P8_LDB(B1, 1, 1); P8_STAGE(P8_SB(1, 0), Bt, bcol, t + 3);
      P8_BAR; P8_WAIT_L(0); P8_MMA_B1(0, 1, At, B1); P8_BAR;
      P8_LDA(At, 1, 1); P8_STAGE(P8_SA(1, 0), A, brow, t + 3);
      P8_BAR; P8_WAIT_L(0); P8_MMA(1, 0, At, B0); P8_BAR; P8_SCHED;
      P8_STAGE(P8_SB(1, 1), Bt, bcol + 128, t + 3);
      WAIT_V(6); P8_BAR; P8_MMA_B1(1, 1, At, B1); P8_BAR;
    }
    { P8_LDB(B0, 0, 0); P8_LDA(At, 0, 0); P8_STAGE(P8_SA(1, 1), A, brow + 128, nt - 1);
      P8_BAR; P8_WAIT_L(0); P8_MMA(0, 0, At, B0); P8_BAR;
      P8_LDB(B1, 0, 1); P8_BAR; P8_WAIT_L(0); P8_MMA_B1(0, 1, At, B1); P8_BAR;
      P8_LDA(At, 0, 1); WAIT_V(4); P8_BAR; P8_WAIT_L(0); P8_MMA(1, 0, At, B0); P8_MMA_B1(1, 1, At, B1); P8_BAR; }
    { P8_LDB(B0, 1, 0); P8_LDA(At, 1, 0); WAIT_V(2); P8_BAR; P8_WAIT_L(0); P8_MMA(0, 0, At, B0); P8_BAR;
      P8_LDB(B1, 1, 1); WAIT_V(0); P8_BAR; P8_WAIT_L(0); P8_MMA_B1(0, 1, At, B1); P8_BAR;
      P8_LDA(At, 1, 1); P8_BAR; P8_WAIT_L(0); P8_MMA(1, 0, At, B0); P8_MMA_B1(1, 1, At, B1); P8_BAR; }
    if (wr == 0) P8_BAR;
    gemm_epilogue8<MODE>(p, l, acc, brow, bcol, wr, wc, fr, fq, cst);
  }
}

template <bool BIAS>
DI void wconv_tile(const float* src0, const float* src1, int N, int K, bf16_t* dst, int kind, int kt, int nt, char* smem, const float* shvec = nullptr, float* bias = nullptr, int npad = 0) {
  float* tile = (float*)smem;
  const int tid = ltid();
  __syncthreads();
  {
    const int nn = tid & 63, kk0 = tid >> 6;
    const int R = nt * 64 + nn;
    const float* src = src0;
    int col = R;
    bool ok = true;
    if (kind == 1) {
      const int grp = R >> 5, up = (R >> 4) & 1;
      col = grp * 16 + (R & 15);
      src = up ? src1 : src0;
    } else ok = R < N;
    float wv[16];
#pragma unroll
    for (int i = 0; i < 16; ++i) wv[i] = ok ? src[(size_t)(kt * 64 + kk0 + i * 4) * N + col] : 0.f;
#pragma unroll
    for (int i = 0; i < 16; ++i) tile[(kk0 + i * 4) * 65 + nn] = wv[i];
    if (BIAS) {
      float* svs = tile + 64 * 65;
      for (int o = tid; o < 9 * 64; o += 256) svs[o] = shvec[(size_t)(o >> 6) * 6144 + kt * 64 + (o & 63)];
    }
  }
  __syncthreads();
  {
    const int rr = tid >> 2, kc = (tid & 3) * 16;
    unsigned o[8];
#pragma unroll
    for (int e = 0; e < 8; ++e) o[e] = pk(tile[(kc + 2 * e) * 65 + rr], tile[(kc + 2 * e + 1) * 65 + rr]);
    bf16_t* d = dst + (size_t)(nt * 64 + rr) * K + kt * 64 + kc;
    *(uint4*)d = uint4{o[0], o[1], o[2], o[3]};
    *(uint4*)(d + 8) = uint4{o[4], o[5], o[6], o[7]};
  }
  if (BIAS) {
    for (int o = tid; o < 9 * 64; o += 256) {
      const int bq = o >> 6, nn = o & 63;
      const float* sv = tile + 64 * 65 + bq * 64;
      float a = 0.f;
#pragma unroll 8
      for (int kk = 0; kk < 64; ++kk) a += sv[kk] * tile[kk * 65 + nn];
      unsafeAtomicAdd(bias + (size_t)bq * npad + nt * 64 + nn, a);
    }
  }
}

DI void mod_item(const Params& p, int item, char* smem) {
  const int l = item / 96, cgp = item % 96;
  float* sc = (float*)smem;
  float* red = sc + 9 * 1024;
  const int tid = ltid();
  __syncthreads();
  for (int i = tid; i < 9 * 1024; i += 256) {
    const int r = i >> 10, k = i & 1023;
    const float v = r < 8 ? p.c[r * 1024 + k] : p.c_ctx[k];
    sc[i] = silu_f(v);
  }
  __syncthreads();
  const int kq = tid >> 6, cc = tid & 63, col = cgp * 64 + cc;
  float acc[9];
#pragma unroll
  for (int r = 0; r < 9; ++r) acc[r] = 0.f;
  const float* wp = p.w_ada + (size_t)l * 1024 * 6144 + col;
#pragma unroll 8
  for (int k = kq * 256; k < kq * 256 + 256; ++k) {
    const float wv = wp[(size_t)k * 6144];
#pragma unroll
    for (int r = 0; r < 9; ++r) acc[r] += sc[r * 1024 + k] * wv;
  }
#pragma unroll
  for (int r = 0; r < 9; ++r) red[(kq * 9 + r) * 64 + cc] = acc[r];
  __syncthreads();
  for (int i = tid; i < 9 * 64; i += 256) {
    const int r = i >> 6, c2 = i & 63;
    const float s = red[(0 * 9 + r) * 64 + c2] + red[(1 * 9 + r) * 64 + c2] + red[(2 * 9 + r) * 64 + c2] + red[(3 * 9 + r) * 64 + c2];
    ((float*)(p.ws + OFF_MOD))[((size_t)(l * 9 + r)) * 6144 + cgp * 64 + c2] = s + p.b_ada[l * 6144 + cgp * 64 + c2];
  }
}

DI void phase0(const Params& p, char* smem) {
  const int tid = ltid(), hf = ltid_full() >> 8;
  constexpr int N_MOD_IT = 384, N_ROPE = 512, N_CS = 32, N_ADC = 512, N_AD = 4160;
  constexpr int TOT = N_MOD_IT + N_ROPE + N_CS + N_ADC + N_AD;
  if (blockIdx.x == 0 && hf == 0 && tid < 64) ((int*)(p.ws + OFF_CTR))[tid] = 0;
  for (int i = blockIdx.x * 512 + ltid_full(); i < 4 * 9 * (2560 + 5632); i += gridDim.x * 512) ((float*)(p.ws + OFF_BIAS1))[i] = 0.f;
  for (int pi = blockIdx.x; pi < TOT / 2; pi += gridDim.x) {
    int i = pi * 2 + hf;
    if (i < N_MOD_IT) { mod_item(p, i, smem + hf * HALF_SMEM); continue; }
    i -= N_MOD_IT;
    if (i < N_ROPE) {
      const int e = i * 256 + tid;
      const int pos = e >> 5, f = e & 31;
      const float pv = (f < 16) ? (float)(pos >> 6) : (float)(pos & 63);
      const float invf = powf(10000.f, -(float)(f & 15) / 16.f);
      const float ang = pv * invf;
      float s, c;
      sincosf(ang, &s, &c);
      ((float*)(p.ws + OFF_ROPEC))[e] = c;
      ((float*)(p.ws + OFF_ROPES))[e] = s;
      continue;
    }
    i -= N_ROPE;
    if (i < N_CS) {
      const int e = i * 256 + tid;
      const int r = e >> 6, n2 = e & 63;
      const int idx = ((r & 63) * n2) & 63;
      float s, c;
      sincospif((float)idx / 32.f, &s, &c);
      ((bf16_t*)(p.ws + OFF_CS64))[e] = f2bf(r < 64 ? c : s);
      continue;
    }
    i -= N_CS;
    if (i < N_ADC) {
      const int e = i * 256 + tid;
      const int k1 = e >> 9, cc = e & 511, n1 = cc & 255;
      const int idx = (k1 * n1) & 255;
      float s, c;
      sincospif((float)idx / 128.f, &s, &c);
      ((bf16_t*)(p.ws + OFF_ADFTC))[e] = f2bf(cc < 256 ? c : -s);
      continue;
    }
    i -= N_ADC;
    if (i < N_AD) {
      const size_t e0 = (size_t)i * 4096 + (size_t)tid * 16;
      const int k1 = (int)(e0 / 4160), c0 = (int)(e0 % 4160);
      unsigned o[8];
#pragma unroll
      for (int e = 0; e < 8; ++e) {
        float v[2];
#pragma unroll
        for (int h = 0; h < 2; ++h) {
          const int cc = c0 + 2 * e + h;
          const int n1 = cc < 2112 ? cc : cc - 2112;
          const int idx = (k1 * n1) & 4095;
          float sn, cs;
          sincospif((float)idx / 2048.f, &sn, &cs);
          v[h] = cc < 2112 ? (cc <= 2048 ? cs : 0.f) : -sn;
        }
        o[e] = pk(v[0], v[1]);
      }
      bf16_t* dd = (bf16_t*)(p.ws + OFF_ADFT) + e0;
      *(uint4*)dd = uint4{o[0], o[1], o[2], o[3]};
      *(uint4*)(dd + 8) = uint4{o[4], o[5], o[6], o[7]};
      continue;
    }
  }
}

DI void norm_item(const Params& p, int item) {
  const int tid = ltid();
  const int w = tid >> 6, lane = tid & 63;
  const int t = item * 4 + w;
  const float* xr = xrow_in(p, t);
  const float* md = modrow(p, 0, t);
  const float* g = p.norm1_g;
  float4 v[4];
  float ss = 0.f;
#pragma unroll
  for (int j = 0; j < 4; ++j) {
    v[j] = *(const float4*)(xr + j * 256 + lane * 4);
    ss += v[j].x * v[j].x + v[j].y * v[j].y + v[j].z * v[j].z + v[j].w * v[j].w;
  }
#pragma unroll
  for (int off = 32; off >= 1; off >>= 1) ss += __shfl_xor(ss, off);
  if (lane == 0) ((float*)(p.ws + OFF_RSS1))[t] = ss;
  float* xo = xrow(p, t);
  bf16_t* hb = (bf16_t*)(p.ws + OFF_HB) + (size_t)t * 1024;
#pragma unroll
  for (int j = 0; j < 4; ++j) {
    const int c = j * 256 + lane * 4;
    *(float4*)(xo + c) = v[j];
    const float4 gg = *(const float4*)(g + c), sc = *(const float4*)(md + 1024 + c);
    *(uint2*)(hb + c) = uint2{pk(v[j].x * gg.x * (1.f + sc.x), v[j].y * gg.y * (1.f + sc.y)), pk(v[j].z * gg.z * (1.f + sc.z), v[j].w * gg.w * (1.f + sc.w))};
  }
}

DI void aprep_item(const Params& p, int l, int item, char* smem) {
  const int b = item / NCH, c = item % NCH;
  const int tok0 = b * TB + c * 64;
  const bool isctx = c < 4;
  int tid_ = ltid();
  const int tid = tid_, lane = tid & 63, w = tid >> 6;
  const bf16_t* P = (const bf16_t*)(p.ws + OFF_P);
  for (int it = 0; it < 12; ++it) {
    const int task = it * 64 + (tid >> 2);
    const int cq = tid & 3;
    const int type = task / 384, rem = task % 384, hr = rem >> 6, tk = rem & 63;
    const int t = tok0 + tk;
    const int pcol = (type ? 1296 : 784) + hr * 64;
    const bf16_t* src = P + (size_t)t * PW + pcol;
    const uint4 u1 = *(const uint4*)(src + cq * 8), u2 = *(const uint4*)(src + 32 + cq * 8);
    float a[8], bb[8];
    a[0] = bflo(u1.x); a[1] = bfhi(u1.x); a[2] = bflo(u1.y); a[3] = bfhi(u1.y); a[4] = bflo(u1.z); a[5] = bfhi(u1.z); a[6] = bflo(u1.w); a[7] = bfhi(u1.w);
    bb[0] = bflo(u2.x); bb[1] = bfhi(u2.x); bb[2] = bflo(u2.y); bb[3] = bfhi(u2.y); bb[4] = bflo(u2.z); bb[5] = bfhi(u2.z); bb[6] = bflo(u2.w); bb[7] = bfhi(u2.w);
    float ss = 0.f;
#pragma unroll
    for (int e = 0; e < 8; ++e) ss += a[e] * a[e] + bb[e] * bb[e];
    ss += __shfl_xor(ss, 1);
    ss += __shfl_xor(ss, 2);
    const float rs = rsqrtf(ss * (1.f / 64.f) + EPS);
    const float* gn = (type ? (hr < 4 ? p.wa_qn : p.wa_kn) : (hr < 4 ? p.ga_qn : p.ga_kn)) + l * 64;
    const float qs = hr < 4 ? 0.125f * LOG2E : 1.f;
    float o1[8], o2[8];
#pragma unroll
    for (int e = 0; e < 8; ++e) {
      a[e] = a[e] * rs * gn[cq * 8 + e];
      bb[e] = bb[e] * rs * gn[32 + cq * 8 + e];
    }
    if (!isctx) {
      const int pos = c * 64 + tk - LC;
      const float* rc = (const float*)(p.ws + OFF_ROPEC) + pos * 32 + cq * 8;
      const float* rsn = (const float*)(p.ws + OFF_ROPES) + pos * 32 + cq * 8;
#pragma unroll
      for (int e = 0; e < 8; ++e) {
        const float cs = rc[e], sn = rsn[e];
        o1[e] = (a[e] * cs - bb[e] * sn) * qs;
        o2[e] = (a[e] * sn + bb[e] * cs) * qs;
      }
    } else {
#pragma unroll
      for (int e = 0; e < 8; ++e) { o1[e] = a[e] * qs; o2[e] = bb[e] * qs; }
    }
    bf16_t* dst = hr < 4 ? (bf16_t*)(p.ws + OFF_QA) + ((size_t)type * T + t) * 256 + hr * 64
                         : (bf16_t*)(p.ws + OFF_KA) + ((size_t)type * T + t) * 128 + (hr - 4) * 64;
    *(uint4*)(dst + cq * 8) = uint4{pk(o1[0], o1[1]), pk(o1[2], o1[3]), pk(o1[4], o1[5]), pk(o1[6], o1[7])};
    *(uint4*)(dst + 32 + cq * 8) = uint4{pk(o2[0], o2[1]), pk(o2[2], o2[3]), pk(o2[4], o2[5]), pk(o2[6], o2[7])};
  }
  {
    bf16_t* sT = (bf16_t*)smem;
#pragma unroll 1
    for (int type = 0; type < 2; ++type) {
      const int vcol = (type ? 1296 : 784) + 384;
      __syncthreads();
#pragma unroll
      for (int i = 0; i < 4; ++i) {
        const int q = tid + i * 256, tk = q >> 4, ch = q & 15;
        *(uint4*)(sT + tk * 136 + ch * 8) = *(const uint4*)(P + (size_t)(tok0 + tk) * PW + vcol + ch * 8);
      }
      __syncthreads();
      const int kd = tid & 127, th = tid >> 7;
      bf16_t* dst = (bf16_t*)(p.ws + OFF_VT) + (((size_t)(type * NB + b) * 128 + kd)) * TB + c * 64 + th * 32;
#pragma unroll
      for (int j0 = 0; j0 < 32; j0 += 8) {
        unsigned o[4];
#pragma unroll
        for (int e = 0; e < 4; ++e) {
          const unsigned lo = sT[(th * 32 + j0 + 2 * e) * 136 + kd], hi = sT[(th * 32 + j0 + 2 * e + 1) * 136 + kd];
          o[e] = lo | (hi << 16);
        }
        *(uint4*)(dst + j0) = uint4{o[0], o[1], o[2], o[3]};
      }
    }
  }
  {
    const int g = w, lr = lane & 15, lq = lane >> 4;
    const bf16_t* CS = (const bf16_t*)(p.ws + OFF_CS64);
    const int cl = c - 4;
    if (isctx || cl <= 32) {
#pragma unroll 1
      for (int nh = 0; nh < 2; ++nh) {
      bf16x8 bs[2][2], bd[2][2];
#pragma unroll
      for (int ntl = 0; ntl < 2; ++ntl) {
        const int nt = nh * 2 + ntl;
        const int n1 = cl * 64 + nt * 16 + lr;
        const bool mir = !isctx && n1 >= 1 && n1 <= 2047;
        const bool zero = !isctx && n1 > 2048;
#pragma unroll
        for (int ks = 0; ks < 2; ++ks) {
          const int coff = 1808 + g * 64 + ks * 32 + lq * 8;
          uint4 a = *(const uint4*)(P + (size_t)(tok0 + nt * 16 + lr) * PW + coff);
          uint4 m = {0u, 0u, 0u, 0u};
          if (mir) m = *(const uint4*)(P + (size_t)(b * TB + LC + 4096 - n1) * PW + coff);
          if (zero) a = uint4{0u, 0u, 0u, 0u};
          const unsigned ua[4] = {a.x, a.y, a.z, a.w}, um[4] = {m.x, m.y, m.z, m.w};
          unsigned os[4], od[4];
#pragma unroll
          for (int e = 0; e < 4; ++e) {
            const float a0 = bflo(ua[e]), a1 = bfhi(ua[e]), m0 = bflo(um[e]), m1 = bfhi(um[e]);
            os[e] = pk(a0 + m0, a1 + m1);
            od[e] = pk(a0 - m0, a1 - m1);
          }
          bs[ntl][ks] = __builtin_bit_cast(bf16x8, uint4{os[0], os[1], os[2], os[3]});
          bd[ntl][ks] = __builtin_bit_cast(bf16x8, uint4{od[0], od[1], od[2], od[3]});
        }
      }
#pragma unroll 1
      for (int mt = 0; mt < 8; ++mt) {
        bf16x8 af[2];
#pragma unroll
        for (int ks = 0; ks < 2; ++ks) af[ks] = *(const bf16x8*)(CS + (mt * 16 + lr) * 64 + ks * 32 + lq * 8);
#pragma unroll
        for (int ntl = 0; ntl < 2; ++ntl) {
          const int nt = nh * 2 + ntl;
          f32x4 acc = {0.f, 0.f, 0.f, 0.f};
          const bool sinpart = mt >= 4;
          acc = MFMA16(af[0], (sinpart && !isctx) ? bd[ntl][0] : bs[ntl][0], acc);
          acc = MFMA16(af[1], (sinpart && !isctx) ? bd[ntl][1] : bs[ntl][1], acc);
#pragma unroll
          for (int r = 0; r < 4; ++r) {
            const int k2row = mt * 16 + lq * 4 + r, k2 = k2row & 63, part = k2row >> 6;
            const int tk = c * 64 + nt * 16 + lr;
            if (isctx) ((bf16_t*)(p.ws + OFF_BTFTC))[((size_t)(b * 256 + g * 64 + k2)) * 512 + part * 256 + tk] = f2bf(acc[r]);
            else {
              const int n1 = tk - LC;
              if (part == 0 || n1 < 2048) ((bf16_t*)(p.ws + OFF_BTFT))[((size_t)(b * 256 + g * 64 + k2)) * 4160 + part * 2112 + n1] = f2bf(acc[r]);
            }
          }
        }
      }
      }
    }
  }
}

DI int dn_step(int c, int d) { return c < 4 ? (d ? 3 - c : c) : 4 + (d ? 67 - c : c - 4); }

DI void dnprep_item(const Params& p, int l, int item, char* smem, char* dsm0) {
  const int b = item / (4 * NCH), h = (item / NCH) & 3, c = item % NCH;
  bf16_t* qb = (bf16_t*)smem;
  bf16_t* kb = qb + 64 * 72;
  float* kf = (float*)(smem + 18432);
  float* vf = kf + 4096;
  float* Am = kf;
  int tid_ = ltid();
  const int tid = tid_, lane = tid & 63, w = tid >> 6, lr = lane & 15, lq = lane >> 4;
  const int tok0 = b * TB + c * 64;
  const bool isctx = c < 4;
  const int sbeg = isctx ? b * TB : b * TB + LC, send = isctx ? b * TB + LC : (b + 1) * TB;
  const bf16_t* P = (const bf16_t*)(p.ws + OFF_P);
  const int tau = tid >> 2, cq = tid & 3;
  const int t = tok0 + tau;
  float qv[16], kv[16], vv[16];
  __syncthreads();
#pragma unroll
  for (int part = 0; part < 3; ++part) {
    const int col = part * 256 + h * 64 + cq * 16;
    const float* cw = p.conv_w + (size_t)l * 3 * 768 + col;
    const bool hasp = t - 1 >= sbeg, hasn = t + 1 < send;
    const u32x4 z4 = {0u, 0u, 0u, 0u};
    const u32x4 a1l = *(const u32x4*)(P + (size_t)t * PW + col), a1h = *(const u32x4*)(P + (size_t)t * PW + col + 8);
    u32x4 a0l = z4, a0h = z4, a2l = z4, a2h = z4;
    if (hasp) { a0l = *(const u32x4*)(P + (size_t)(t - 1) * PW + col); a0h = *(const u32x4*)(P + (size_t)(t - 1) * PW + col + 8); }
    if (hasn) { a2l = *(const u32x4*)(P + (size_t)(t + 1) * PW + col); a2h = *(const u32x4*)(P + (size_t)(t + 1) * PW + col + 8); }
#pragma unroll
    for (int e = 0; e < 16; ++e) {
      const unsigned w0 = e < 8 ? a0l[(e & 7) >> 1] : a0h[(e & 7) >> 1];
      const unsigned w1 = e < 8 ? a1l[(e & 7) >> 1] : a1h[(e & 7) >> 1];
      const unsigned w2 = e < 8 ? a2l[(e & 7) >> 1] : a2h[(e & 7) >> 1];
      const float x0 = (e & 1) ? bfhi(w0) : bflo(w0);
      const float x1 = (e & 1) ? bfhi(w1) : bflo(w1);
      const float x2 = (e & 1) ? bfhi(w2) : bflo(w2);
      const float y = x0 * cw[e] + x1 * cw[768 + e] + x2 * cw[1536 + e];
      const float sv = silu_f(y);
      if (part == 0) qv[e] = sv; else if (part == 1) kv[e] = sv; else vv[e] = sv;
    }
    asm volatile("" ::: "memory");
  }
  {
    float sq = 0.f, sk = 0.f;
#pragma unroll
    for (int e = 0; e < 16; ++e) { sq += qv[e] * qv[e]; sk += kv[e] * kv[e]; }
    sq += __shfl_xor(sq, 1); sq += __shfl_xor(sq, 2);
    sk += __shfl_xor(sk, 1); sk += __shfl_xor(sk, 2);
    const float rq = rsqrtf(sq + EPS) * 0.125f, rk = rsqrtf(sk + EPS);
#pragma unroll
    for (int e = 0; e < 16; ++e) { qv[e] *= rq; kv[e] *= rk; }
  }
  float* gl = (float*)(dsm0 + (ltid_full() >> 8) * HALF_SMEM + 18432 + 32768);
  float* bl = gl + 128;
  float* gc = bl + 128;
  float* bd = gc + 128;
  if (tid < 128) {
    const int d = tid >> 6, i = tid & 63, ta = d ? 63 - i : i;
    const bf16_t* pr = P + (size_t)(tok0 + ta) * PW + 768;
    const float a = bf2f(pr[d * 4 + h]), bb = bf2f(pr[8 + d * 4 + h]);
    const float xx = a + p.dt_bias[l * 8 + d * 4 + h];
    const float ex = __expf(xx);
    const float sp = xx > 20.f ? xx : (ex < 0.03f ? ex * (1.f - ex * (0.5f - ex * (1.f / 3.f - 0.25f * ex))) : __logf(1.f + ex));
    float v = -__expf(p.A_log[l * 8 + d * 4 + h]) * sp;
#pragma unroll
    for (int off = 1; off < 64; off <<= 1) {
      const float tq = __shfl_up(v, off);
      if (i >= off) v += tq;
    }
    gc[d * 64 + i] = v;
    bd[d * 64 + i] = 1.f / (1.f + __expf(-bb));
  }
  {
#pragma unroll
    for (int e = 0; e < 16; e += 4) {
      *(uint2*)(qb + tau * 72 + cq * 16 + e) = uint2{pk(qv[e], qv[e + 1]), pk(qv[e + 2], qv[e + 3])};
      *(uint2*)(kb + tau * 72 + cq * 16 + e) = uint2{pk(kv[e], kv[e + 1]), pk(kv[e + 2], kv[e + 3])};
      *(float4*)(kf + tau * 64 + cq * 16 + e) = float4{kv[e], kv[e + 1], kv[e + 2], kv[e + 3]};
      *(float4*)(vf + tau * 64 + cq * 16 + e) = float4{vv[e], vv[e + 1], vv[e + 2], vv[e + 3]};
    }
  }
  __syncthreads();
#pragma unroll
  for (int d = 0; d < 2; ++d) {
    const int i = d ? 63 - tau : tau;
    const int cb = ((b * 4 + h) * 2 + d) * NCH + dn_step(c, d);
    bf16_t* base = (bf16_t*)(p.ws + OFF_DN + (size_t)cb * SZ_CB);
    const float eg = __expf(gc[d * 64 + i]);
    bf16_t* qd = base + 4096 + i * 64;
#pragma unroll
    for (int q4 = 0; q4 < 4; ++q4) {
      const int pos = (cq >> 1) * 32 + q4 * 8 + (cq & 1) * 4;
      *(uint2*)(qd + pos) = uint2{pk(qv[q4 * 4] * eg, qv[q4 * 4 + 1] * eg), pk(qv[q4 * 4 + 2] * eg, qv[q4 * 4 + 3] * eg)};
    }
  }
#pragma unroll
  for (int d = 0; d < 2; ++d) {
    const int cb = ((b * 4 + h) * 2 + d) * NCH + dn_step(c, d);
    bf16_t* kt = (bf16_t*)(p.ws + OFF_DN + (size_t)cb * SZ_CB) + 3 * 4096 + tau * 64 + cq * 16;
    const float gl63 = gc[d * 64 + 63];
    unsigned o[8];
#pragma unroll
    for (int e2 = 0; e2 < 8; ++e2) {
      float vals[2];
#pragma unroll
      for (int hq = 0; hq < 2; ++hq) {
        const int e = e2 * 2 + hq;
        const int i = (2 * (cq >> 1) + ((e >> 2) & 1)) * 16 + ((((cq & 1) << 1) | (e >> 3)) << 2) + (e & 3);
        const int ta = d ? 63 - i : i;
        vals[hq] = kf[ta * 64 + tau] * __expf(gl63 - gc[d * 64 + i]);
      }
      o[e2] = pk(vals[0], vals[1]);
    }
    *(uint4*)kt = uint4{o[0], o[1], o[2], o[3]};
    *(uint4*)(kt + 8) = uint4{o[4], o[5], o[6], o[7]};
  }
  if (tid < 128) {
    const int d = tid >> 6;
    const int cb = ((b * 4 + h) * 2 + d) * NCH + dn_step(c, d);
    ((float*)(p.ws + OFF_GEND))[(size_t)cb * 64 + (tid & 63)] = __expf(gc[d * 64 + 63]);
  }
  f32x4 KK[4], QK[4];
  {
    bf16x8 ak[2], aq[2];
#pragma unroll
    for (int ks = 0; ks < 2; ++ks) {
      ak[ks] = *(const bf16x8*)(kb + (w * 16 + lr) * 72 + ks * 32 + lq * 8);
      aq[ks] = *(const bf16x8*)(qb + (w * 16 + lr) * 72 + ks * 32 + lq * 8);
    }
#pragma unroll
    for (int nt = 0; nt < 4; ++nt) {
      KK[nt] = f32x4{0.f, 0.f, 0.f, 0.f};
      QK[nt] = f32x4{0.f, 0.f, 0.f, 0.f};
#pragma unroll
      for (int ks = 0; ks < 2; ++ks) {
        const bf16x8 bk = *(const bf16x8*)(kb + (nt * 16 + lr) * 72 + ks * 32 + lq * 8);
        KK[nt] = MFMA16(ak[ks], bk, KK[nt]);
        QK[nt] = MFMA16(aq[ks], bk, QK[nt]);
      }
    }
  }
  const int sd = w >> 1, half = w & 1;
  float xs[64];
#pragma unroll
  for (int i = 0; i < 64; ++i) {
    const int ta = sd ? 63 - i : i;
    const float bt = bd[sd * 64 + i];
    xs[i] = half ? kf[ta * 64 + lane] * bt * __expf(gc[sd * 64 + i]) : vf[ta * 64 + lane] * bt;
    if ((i & 7) == 7) asm volatile("" ::: "memory");
  }
  __syncthreads();
#pragma unroll
  for (int d = 0; d < 2; ++d) {
    const int cb = ((b * 4 + h) * 2 + d) * NCH + dn_step(c, d);
    bf16_t* inb = (bf16_t*)(p.ws + OFF_DN + (size_t)cb * SZ_CB) + 2 * 4096;
#pragma unroll
    for (int nt = 0; nt < 4; ++nt)
#pragma unroll
      for (int r = 0; r < 4; ++r) {
        const int ti = w * 16 + lq * 4 + r, tj = nt * 16 + lr;
        const int i = d ? 63 - ti : ti, j = d ? 63 - tj : tj;
        const float dec = (i >= j) ? __expf(gc[d * 64 + i] - gc[d * 64 + j]) : 0.f;
        Am[d * 4096 + i * 64 + j] = (i > j) ? bd[d * 64 + i] * KK[nt][r] * dec : 0.f;
        inb[i * 64 + permk(j)] = f2bf(QK[nt][r] * dec);
        if (r == 3) asm volatile("" ::: "memory");
      }
  }
  __syncthreads();
  {
    const float* Ad = Am + sd * 4096;
#pragma unroll
    for (int i = 1; i < 64; ++i) {
      float s = xs[i];
#pragma unroll
      for (int j4 = 0; j4 <= (i - 1) / 4; ++j4) {
        const float4 a = *(const float4*)(Ad + i * 64 + j4 * 4);
        s -= a.x * xs[j4 * 4];
        s -= a.y * xs[j4 * 4 + 1];
        s -= a.z * xs[j4 * 4 + 2];
        s -= a.w * xs[j4 * 4 + 3];
      }
      xs[i] = s;
      asm volatile("" ::: "memory");
    }
    const int cb = ((b * 4 + h) * 2 + sd) * NCH + dn_step(c, sd);
    bf16_t* base = (bf16_t*)(p.ws + OFF_DN + (size_t)cb * SZ_CB);
    if (half == 0) {
      bf16_t* U = base + 4 * 4096;
#pragma unroll
      for (int i4 = 0; i4 < 16; ++i4) {
        const int mt = i4 >> 2, q4 = i4 & 3;
        *(uint2*)(U + ((((mt * 4 + (lane >> 4)) * 4 + q4) * 16 + (lane & 15)) << 2)) = uint2{pk(xs[i4 * 4], xs[i4 * 4 + 1]), pk(xs[i4 * 4 + 2], xs[i4 * 4 + 3])};
      }
    } else {
      bf16_t* Wn = base;
      const int pc = permk(lane);
#pragma unroll
      for (int i = 0; i < 64; ++i) Wn[i * 64 + pc] = f2bf(-xs[i]);
    }
  }
}

DI bf16x8 pack8(const f32x4& a, const f32x4& b) {
  uint4 u = {pk(a[0], a[1]), pk(a[2], a[3]), pk(b[0], b[1]), pk(b[2], b[3])};
  return __builtin_bit_cast(bf16x8, u);
}

DI void dnscan_item(const Params& p, int item, LAS char* lb) {
  const int b = item >> 3, h = (item >> 1) & 3, d = item & 1;
  int tid_ = ltid();
  const int lane = tid_ & 63, w = tid_ >> 6, lr = lane & 15, lq = lane >> 4;
  f32x4 S[4];
#pragma unroll
  for (int mt = 0; mt < 4; ++mt) S[mt] = f32x4{0.f, 0.f, 0.f, 0.f};
  const int cb0 = ((b * 4 + h) * 2 + d) * NCH;
  unsigned pfacc = 0u;
  int soff[8];
#pragma unroll
  for (int i = 0; i < 8; ++i) {
    const int j = w * 512 + i * 64 + lane, jj = j & 511, row = jj >> 3, ch = jj & 7;
    soff[i] = (j >> 9) * 4096 + row * 64 + ((ch ^ (row & 7)) << 3);
  }
#define SC_STAGE(buf, step)                                                                                                                   \
  do {                                                                                                                                        \
    const bf16_t* gb_ = (const bf16_t*)(p.ws + OFF_DN + (size_t)(cb0 + (step)) * SZ_CB);                                                       \
    _Pragma("unroll") for (int i = 0; i < 8; ++i)                                                                                             \
      __builtin_amdgcn_global_load_lds((const unsigned*)(gb_ + soff[i]), (LAS unsigned*)(lb + (buf) * 32768 + (w * 512 + i * 64) * 16), 16, 0, 0); \
  } while (0)
  int foff[4][2];
#pragma unroll
  for (int mt = 0; mt < 4; ++mt)
#pragma unroll
    for (int ks = 0; ks < 2; ++ks) { const int row = mt * 16 + lr; foff[mt][ks] = row * 128 + (((ks * 4 + lq) ^ (row & 7)) << 4); }
  SC_STAGE(0, 0);
  uint2 uu[4];
  float ge;
  {
    const bf16_t* base = (const bf16_t*)(p.ws + OFF_DN + (size_t)cb0 * SZ_CB);
#pragma unroll
    for (int mt = 0; mt < 4; ++mt) uu[mt] = *(const uint2*)(base + 4 * 4096 + ((((mt * 4 + w) * 4 + lq) * 16 + lr) << 2));
    ge = ((const float*)(p.ws + OFF_GEND))[(size_t)cb0 * 64 + lane];
  }
  WAIT_V(0);
#pragma unroll 1
  for (int s = 0; s < NCH; ++s) {
    WAIT_V(8);
    __syncthreads();
    if (s + 1 < NCH) SC_STAGE((s + 1) & 1, s + 1);
    uint2 un[4] = {uu[0], uu[1], uu[2], uu[3]};
    float gn = ge;
    if (s + 1 < NCH) {
      const bf16_t* nb = (const bf16_t*)(p.ws + OFF_DN + (size_t)(cb0 + s + 1) * SZ_CB);
#pragma unroll
      for (int mt = 0; mt < 4; ++mt) un[mt] = *(const uint2*)(nb + 4 * 4096 + ((((mt * 4 + w) * 4 + lq) * 16 + lr) << 2));
      gn = ((const float*)(p.ws + OFF_GEND))[(size_t)(cb0 + s + 1) * 64 + lane];
    }
    unsigned pf0 = 0u, pf1 = 0u;
    if (s + 2 < NCH) {
      const unsigned* nb = (const unsigned*)(p.ws + OFF_DN + (size_t)(cb0 + s + 2) * SZ_CB);
      pf0 = nb[(w * 80 + lane) * 32];
      if (lane < 16) pf1 = nb[(w * 80 + 64 + lane) * 32];
    }
    const LAS char* sb = lb + (s & 1) * 32768;
    bf16x8 sB[2];
    sB[0] = pack8(S[0], S[1]);
    sB[1] = pack8(S[2], S[3]);
    f32x4 vn[4], o[4];
#pragma unroll
    for (int mt = 0; mt < 4; ++mt) {
      vn[mt] = f32x4{bflo(uu[mt].x), bfhi(uu[mt].x), bflo(uu[mt].y), bfhi(uu[mt].y)};
      o[mt] = f32x4{0.f, 0.f, 0.f, 0.f};
#pragma unroll
      for (int ks = 0; ks < 2; ++ks) {
        const bf16x8 aw = *(const LAS bf16x8*)(sb + foff[mt][ks]);
        const bf16x8 aq = *(const LAS bf16x8*)(sb + 8192 + foff[mt][ks]);
        vn[mt] = MFMA16(aw, sB[ks], vn[mt]);
        o[mt] = MFMA16(aq, sB[ks], o[mt]);
      }
    }
    bf16x8 vB[2];
    vB[0] = pack8(vn[0], vn[1]);
    vB[1] = pack8(vn[2], vn[3]);
#pragma unroll
    for (int mt = 0; mt < 4; ++mt) {
#pragma unroll
      for (int r = 0; r < 4; ++r) S[mt][r] *= ge;
#pragma unroll
      for (int ks = 0; ks < 2; ++ks) {
        const bf16x8 ai = *(const LAS bf16x8*)(sb + 16384 + foff[mt][ks]);
        const bf16x8 ak = *(const LAS bf16x8*)(sb + 24576 + foff[mt][ks]);
        o[mt] = MFMA16(ai, vB[ks], o[mt]);
        S[mt] = MFMA16(ak, vB[ks], S[mt]);
      }
    }
    pfacc ^= pf0 ^ pf1;
#pragma unroll
    for (int mt = 0; mt < 4; ++mt) uu[mt] = un[mt];
    ge = gn;
    int dl = d;
    asm volatile("" : "+v"(dl));
    float* Od = (float*)(p.ws + OFF_ODN) + (size_t)dl * T * 256;
    const int c = s < 4 ? (d ? 3 - s : s) : 4 + (d ? 67 - s : s - 4);
#pragma unroll
    for (int mt = 0; mt < 4; ++mt)
#pragma unroll
      for (int r = 0; r < 4; ++r) {
        const int i = mt * 16 + lq * 4 + r;
        const int ta = d ? 63 - i : i;
        Od[((size_t)(b * TB + c * 64 + ta)) * 256 + h * 64 + w * 16 + lr] = o[mt][r];
      }
  }
#undef SC_STAGE
  __syncthreads();
  if (pfacc == 0x9e3779b9u && ((const float*)(p.ws + OFF_GEND))[0] == 123.456f) ((float*)(p.ws + OFF_ODN))[0] = 0.f;
}

DI void attn_item(const Params& p, int l, int type, int b, int kvh, int qb, char* smem) {
  constexpr int KB = 64 * 64 * 2, VB = 64 * 72 * 2, SB = KB + VB;
  int tid_ = ltid();
  const int tid = tid_, lane = tid & 63, w = tid >> 6, lr = lane & 15, lq = lane >> 4;
  const int g = w >> 1, qh = kvh * 2 + g;
  const int qloc0 = qb * 64 + (w & 1) * 32;
  const bool isctx = qb < 4;
  const bf16_t* Qa = (const bf16_t*)(p.ws + OFF_QA) + ((size_t)type * T + (size_t)b * TB) * 256 + qh * 64;
  const bf16_t* Kg = (const bf16_t*)(p.ws + OFF_KA) + ((size_t)type * T + (size_t)b * TB) * 128 + kvh * 64;
  const bf16_t* Vg = (const bf16_t*)(p.ws + OFF_VT) + ((size_t)(type * NB + b) * 128 + kvh * 64) * TB;
  bf16x8 qf[2][2];
#pragma unroll
  for (int nt = 0; nt < 2; ++nt)
#pragma unroll
    for (int ks = 0; ks < 2; ++ks) qf[nt][ks] = *(const bf16x8*)(Qa + (size_t)(qloc0 + nt * 16 + lr) * 256 + ks * 32 + lq * 8);
  float neg_big;
  asm volatile("v_mov_b32 %0, 0xf149f2ca" : "=v"(neg_big));
  float mrun[2];
  f32x4 O[4][2], Ls[2];
  const bf16x8 ones8 = {(short)0x3F80, (short)0x3F80, (short)0x3F80, (short)0x3F80, (short)0x3F80, (short)0x3F80, (short)0x3F80, (short)0x3F80};
#pragma unroll
  for (int nt = 0; nt < 2; ++nt) {
    if (type == 1) { mrun[nt] = p.wa_sink[l * 4 + qh] * LOG2E; Ls[nt] = f32x4{1.f, 1.f, 1.f, 1.f}; }
    else { mrun[nt] = neg_big; Ls[nt] = f32x4{0.f, 0.f, 0.f, 0.f}; }
#pragma unroll
    for (int mt = 0; mt < 4; ++mt) O[mt][nt] = f32x4{0.f, 0.f, 0.f, 0.f};
  }
  const int n_lat_lo = (!isctx && type == 1) ? qb - 2 : 4;
  const int ntiles = isctx ? 4 : (type == 0 ? NCH : 9);
  const int lrow = tid >> 3, lch = tid & 7;
  u32x4 rk[2], rv[2];
#pragma unroll
  for (int i = 0; i < 2; ++i) {
    rk[i] = *(const u32x4*)(Kg + (size_t)(lrow + i * 32) * 128 + lch * 8);
    rv[i] = *(const u32x4*)(Vg + (size_t)(lrow + i * 32) * TB + lch * 8);
  }
#pragma unroll
  for (int i = 0; i < 2; ++i) {
    const int r = lrow + i * 32;
    *(u32x4*)(smem + r * 128 + ((lch ^ (r & 7)) << 4)) = rk[i];
    *(u32x4*)(smem + KB + r * 144 + lch * 16) = rv[i];
  }
  __syncthreads();
  for (int ti = 0; ti < ntiles; ++ti) {
    const int jraw = ti < 4 ? ti : n_lat_lo + (ti - 4);
    const bool tvalid = ti < 4 || (jraw >= 4 && jraw < NCH);
    const int jt = ti < 4 ? ti : (jraw < 4 ? 4 : (jraw > NCH - 1 ? NCH - 1 : jraw));
    const char* sK = smem + (ti & 1) * SB;
    const char* sV = sK + KB;
    if (ti + 1 < ntiles) {
      const int jn0 = (ti + 1) < 4 ? ti + 1 : n_lat_lo + (ti + 1 - 4);
      const int jn = (ti + 1) < 4 ? jn0 : (jn0 < 4 ? 4 : (jn0 > NCH - 1 ? NCH - 1 : jn0));
#pragma unroll
      for (int i = 0; i < 2; ++i) {
        rk[i] = *(const u32x4*)(Kg + (size_t)(jn * 64 + lrow + i * 32) * 128 + lch * 8);
        rv[i] = *(const u32x4*)(Vg + (size_t)(lrow + i * 32) * TB + jn * 64 + lch * 8);
      }
    }
    f32x4 sc[4][2];
#pragma unroll
    for (int mt = 0; mt < 4; ++mt) {
      const int r = mt * 16 + lr;
      const bf16x8 kf0 = *(const bf16x8*)(sK + r * 128 + ((lq ^ (r & 7)) << 4));
      const bf16x8 kf1 = *(const bf16x8*)(sK + r * 128 + (((4 + lq) ^ (r & 7)) << 4));
#pragma unroll
      for (int nt = 0; nt < 2; ++nt) {
        f32x4 a = {0.f, 0.f, 0.f, 0.f};
        a = MFMA16(kf0, qf[nt][0], a);
        a = MFMA16(kf1, qf[nt][1], a);
        sc[mt][nt] = a;
      }
    }
    const bool domask = (type == 1) && !isctx && (jt >= 4);
#pragma unroll
    for (int nt = 0; nt < 2; ++nt) {
      if (domask) {
#pragma unroll
        for (int mt = 0; mt < 4; ++mt)
#pragma unroll
          for (int r = 0; r < 4; ++r) {
            const int kpos = jt * 64 + mt * 16 + lq * 4 + r, qpos = qloc0 + nt * 16 + lr;
            const int df = qpos - kpos;
            if (df > 128 || df < -128 || !tvalid) sc[mt][nt][r] = neg_big;
          }
      }
      float mx = fmaxf(fmaxf(sc[0][nt][0], sc[0][nt][1]), fmaxf(sc[0][nt][2], sc[0][nt][3]));
#pragma unroll
      for (int mt = 1; mt < 4; ++mt) mx = fmaxf(mx, fmaxf(fmaxf(sc[mt][nt][0], sc[mt][nt][1]), fmaxf(sc[mt][nt][2], sc[mt][nt][3])));
      mx = fmaxf(mx, __shfl_xor(mx, 16));
      mx = fmaxf(mx, __shfl_xor(mx, 32));
      if (__builtin_amdgcn_ballot_w64(mx > mrun[nt] + 8.f) != 0ull) {
        const float mnew = fmaxf(mrun[nt], mx);
        const float alpha = __builtin_amdgcn_exp2f(mrun[nt] - mnew);
        mrun[nt] = mnew;
#pragma unroll
        for (int r = 0; r < 4; ++r) Ls[nt][r] *= alpha;
#pragma unroll
        for (int mt = 0; mt < 4; ++mt)
#pragma unroll
          for (int r = 0; r < 4; ++r) O[mt][nt][r] *= alpha;
      }
      const float mref = mrun[nt];
#pragma unroll
      for (int mt = 0; mt < 4; ++mt)
#pragma unroll
        for (int r = 0; r < 4; ++r) sc[mt][nt][r] = __builtin_amdgcn_exp2f(sc[mt][nt][r] - mref);
    }
    bf16x8 pB[2][2];
#pragma unroll
    for (int nt = 0; nt < 2; ++nt) {
      pB[nt][0] = pack8(sc[0][nt], sc[1][nt]);
      pB[nt][1] = pack8(sc[2][nt], sc[3][nt]);
      Ls[nt] = MFMA16(ones8, pB[nt][0], Ls[nt]);
      Ls[nt] = MFMA16(ones8, pB[nt][1], Ls[nt]);
    }
#pragma unroll
    for (int mt = 0; mt < 4; ++mt)
#pragma unroll
      for (int ks = 0; ks < 2; ++ks) {
        const bf16x4 v0 = *(const bf16x4*)(sV + (mt * 16 + lr) * 144 + ((2 * ks) * 16 + lq * 4) * 2);
        const bf16x4 v1 = *(const bf16x4*)(sV + (mt * 16 + lr) * 144 + ((2 * ks + 1) * 16 + lq * 4) * 2);
        const bf16x8 vfr = __builtin_shufflevector(v0, v1, 0, 1, 2, 3, 4, 5, 6, 7);
#pragma unroll
        for (int nt = 0; nt < 2; ++nt) O[mt][nt] = MFMA16(vfr, pB[nt][ks], O[mt][nt]);
      }
    if (ti + 1 < ntiles) {
      char* dK = smem + ((ti + 1) & 1) * SB;
#pragma unroll
      for (int i = 0; i < 2; ++i) {
        const int r = lrow + i * 32;
        *(u32x4*)(dK + r * 128 + ((lch ^ (r & 7)) << 4)) = rk[i];
        *(u32x4*)(dK + KB + r * 144 + lch * 16) = rv[i];
      }
    }
    __syncthreads();
  }
  bf16_t* Y = (bf16_t*)(p.ws + OFF_YMIX);
#pragma unroll
  for (int nt = 0; nt < 2; ++nt) {
    const float inv = 1.f / Ls[nt][0];
    const size_t row = (size_t)b * TB + qloc0 + nt * 16 + lr;
#pragma unroll
    for (int mt = 0; mt < 4; ++mt) {
      uint2 v = {pk(O[mt][nt][0] * inv, O[mt][nt][1] * inv), pk(O[mt][nt][2] * inv, O[mt][nt][3] * inv)};
      *(uint2*)(Y + row * 1024 + (type ? 512 : 256) + qh * 64 + mt * 16 + lq * 4) = v;
    }
  }
}

DI void dnmerge_item(const Params& p, int l, int item) {
  const int tid = ltid();
  const int w = tid >> 6, lane = tid & 63;
  const int t = item * 4 + w;
  const float* o0 = (const float*)(p.ws + OFF_ODN) + (size_t)t * 256 + lane * 4;
  const float* o1 = o0 + (size_t)T * 256;
  const float4 a = *(const float4*)o0, bq = *(const float4*)o1;
  float v[4] = {a.x + bq.x, a.y + bq.y, a.z + bq.z, a.w + bq.w};
  float ss = v[0] * v[0] + v[1] * v[1] + v[2] * v[2] + v[3] * v[3];
  ss += __shfl_xor(ss, 1); ss += __shfl_xor(ss, 2); ss += __shfl_xor(ss, 4); ss += __shfl_xor(ss, 8);
  const float rs = rsqrtf(ss * (1.f / 64.f) + EPS);
  const int dim = (lane & 15) * 4;
  const float4 gn = *(const float4*)(p.dn_norm_g + l * 64 + dim);
  const uint2 zz = *(const uint2*)((const bf16_t*)(p.ws + OFF_Z) + (size_t)t * 256 + lane * 4);
  const float z0 = bflo(zz.x), z1 = bfhi(zz.x), z2 = bflo(zz.y), z3 = bfhi(zz.y);
  const float y0 = v[0] * rs * gn.x * silu_f(z0), y1 = v[1] * rs * gn.y * silu_f(z1), y2 = v[2] * rs * gn.z * silu_f(z2), y3 = v[3] * rs * gn.w * silu_f(z3);
  *(uint2*)((bf16_t*)(p.ws + OFF_YMIX) + (size_t)t * 1024 + lane * 4) = uint2{pk(y0, y1), pk(y2, y3)};
  if (lane == 0) { ((float*)(p.ws + OFF_RSS1))[t] = 0.f; ((float*)(p.ws + OFF_RSS2))[t] = 0.f; }
}


#define XB_TMO      128
#define XB_XCNT(j)  (256  + 64 * (j))
#define XB_XSUB(j)  (1280 + 64 * (j))
#define XB_XGEN(j)  (2304 + 64 * (j))
#define XB_TOP      3328
#define XB_TOPGEN   3392
#define XCD_BAR_WORDS 3456
#define XB_SPIN_CAP (1u << 18)
DI unsigned xb_ld(unsigned* p) { return __hip_atomic_load(p, __ATOMIC_RELAXED, __HIP_MEMORY_SCOPE_AGENT); }
DI unsigned xb_add(unsigned* p, unsigned v) { return __hip_atomic_fetch_add(p, v, __ATOMIC_RELAXED, __HIP_MEMORY_SCOPE_AGENT); }
DI unsigned xb_xcc_id() { return (unsigned)__builtin_amdgcn_s_getreg((3 << 11) | 20) & 0xFu; }
#define XB_SPIN(cond, bar) do { unsigned _sp = 0; while (cond) { __builtin_amdgcn_s_sleep(1); \
    if ((++_sp & 255u) == 0u) { if (xb_ld(&(bar)[XB_TMO])) break; if (_sp > XB_SPIN_CAP) { atomicAdd(&(bar)[XB_TMO], 1u); break; } } } } while (0)
struct XcdBarrier { unsigned* bar; unsigned x; volatile LAS unsigned* st; };
DI XcdBarrier xcd_barrier_post(unsigned* bar, volatile LAS unsigned* st) {
  XcdBarrier b; b.bar = bar; b.x = xb_xcc_id(); b.st = st;
  if (threadIdx.x == 0) (void)xb_add(&bar[XB_XCNT(b.x)], 1u);
  return b;
}
DI void xcd_barrier_complete(unsigned* bar, unsigned x, unsigned& nloc, unsigned& nx) {
  const unsigned G = gridDim.x * gridDim.y * gridDim.z;
  unsigned sum, cnt, mine, sp = 0u;
  for (;;) {
    sum = 0u; cnt = 0u; mine = 0u;
#pragma unroll
    for (unsigned j = 0; j < 16; ++j) { const unsigned c = xb_ld(&bar[XB_XCNT(j)]); sum += c; cnt += (c > 0u) ? 1u : 0u; mine = (j == x) ? c : mine; }
    if (sum == G) break;
    __builtin_amdgcn_s_sleep(1);
    if ((++sp & 255u) == 0u) { if (xb_ld(&bar[XB_TMO])) break; if (sp > XB_SPIN_CAP) { atomicAdd(&bar[XB_TMO], 1u); break; } }
  }
  nloc = mine > 0u ? mine : 1u; nx = cnt > 0u ? cnt : 1u;
}
DI void xcd_barrier(const XcdBarrier& b) {
  asm volatile("s_waitcnt vmcnt(0)" ::: "memory");
  __syncthreads();
  if (ltid_full() == 0) {
    unsigned* bar = b.bar;
    asm volatile("" : "+s"(bar));
    __builtin_amdgcn_s_waitcnt(0);
    unsigned nloc = b.st[0], nx = b.st[1];
    if (nloc == 0u) { xcd_barrier_complete(bar, b.x, nloc, nx); b.st[0] = nloc; b.st[1] = nx; }
    const unsigned old = xb_add(&bar[XB_XSUB(b.x)], 1u);
    const unsigned gen = old / nloc;
    if (old + 1u == (gen + 1u) * nloc) {
      __builtin_amdgcn_fence(__ATOMIC_RELEASE, "agent");
      asm volatile("s_waitcnt vmcnt(0)" ::: "memory");
      const unsigned og = xb_add(&bar[XB_TOP], 1u);
      const unsigned tg = og / nx;
      if (og + 1u == (tg + 1u) * nx) xb_add(&bar[XB_TOPGEN], 1u);
      else XB_SPIN(xb_ld(&bar[XB_TOPGEN]) == tg, bar);
      __builtin_amdgcn_fence(__ATOMIC_ACQUIRE, "agent");
      xb_add(&bar[XB_XGEN(b.x)], 1u);
      asm volatile("s_waitcnt vmcnt(0)" ::: "memory");
    } else {
      XB_SPIN(xb_ld(&bar[XB_XGEN(b.x)]) == gen, bar);
      __builtin_amdgcn_fence(__ATOMIC_ACQUIRE, "agent");
      asm volatile("s_waitcnt vmcnt(0)" ::: "memory");
    }
  }
  __syncthreads();
}


DI Params load_params(const volatile LAS unsigned* sp) {
  Params q;
  unsigned long long* dst = (unsigned long long*)&q;
#pragma unroll
  for (int i = 0; i < (int)(sizeof(Params) / 8); ++i) {
    const unsigned lo = (unsigned)__builtin_amdgcn_readfirstlane((int)sp[2 * i]), hi = (unsigned)__builtin_amdgcn_readfirstlane((int)sp[2 * i + 1]);
    dst[i] = ((unsigned long long)hi << 32) | lo;
  }
  return q;
}
#define GSYNC() do { XcdBarrier xb_; xb_.bar = (unsigned*)(q.ws + OFF_BAR); xb_.x = xb_xcc_id(); xb_.st = (volatile LAS unsigned*)&xb_words; xcd_barrier(xb_); } while (0)
__global__ void __launch_bounds__(512, 2) mega(Params p) {
  extern __shared__ __attribute__((aligned(1024))) char dsm[];
  __shared__ uint4 xb_words;
  __shared__ int s_item;
  cg::grid_group grid = cg::this_grid();
  __shared__ unsigned sparams[sizeof(Params) / 4];
  if (threadIdx.x == 0) xb_words = make_uint4(0u, 0u, 0u, 0u);
  if (threadIdx.x < sizeof(Params) / 4) sparams[threadIdx.x] = ((const unsigned*)&p)[threadIdx.x];
  __syncthreads();
  (void)xcd_barrier_post((unsigned*)(p.ws + OFF_BAR), (volatile LAS unsigned*)&xb_words);
  const int nblk = gridDim.x, bid = blockIdx.x;
  LAS char* lds = (LAS char*)dsm;
  phase0(p, dsm);
#if EXP == 6
  __syncthreads();
  phase0(p, dsm);
#endif
  grid.sync();
  for (int l = 0; l < 4; ++l) {
    Params q = load_params((const volatile LAS unsigned*)sparams);
#define RELAUNDER() q = load_params((const volatile LAS unsigned*)sparams)
#define Hb ((const bf16_t*)(q.ws + OFF_HB))
    RELAUNDER();
    if (l == 0) {
      { const int hf = ltid_full() >> 8; char* smem = dsm + hf * HALF_SMEM; (void)smem;
      for (int pi = bid; pi < (T / 4 + 16 * 40) / 2; pi += nblk) {
        const int it = pi * 2 + hf;
        if (it < T / 4) norm_item(q, it);
        else { const int j = it - T / 4; wconv_tile<true>(q.w_in, nullptr, 2320, 1024, (bf16_t*)(q.ws + OFF_WIN), 0, j % 16, j / 16, smem, (const float*)(q.ws + OFF_MOD), (float*)(q.ws + OFF_BIAS1), 2560); }
      }
      }
      GSYNC();
    }
    RELAUNDER();
    gemm_phase8<EP_P>(q, l, Hb, (const bf16_t*)(q.ws + OFF_WIN), 1024, 136, 10, lds, false);
#if EXP == 1
    gemm_phase<EP_P>(q, l, Hb, 1024, (const bf16_t*)(q.ws + OFF_WIN), 1024, 1024, 136, 10, lds);
#endif
    GSYNC();
    RELAUNDER();
    { const int hf = ltid_full() >> 8; char* smem = dsm + hf * HALF_SMEM; (void)smem;
#if EXP == 3
    for (int rep = 0; rep < 2; ++rep)
#endif
    for (int pi = bid; pi < (NB * 4 * NCH + NB * NCH) / 2; pi += nblk) {
      const int it = pi * 2 + hf;
      if (it < NB * 4 * NCH) dnprep_item(q, l, it, smem, dsm);
      else aprep_item(q, l, it - NB * 4 * NCH, smem);
    }
    }
    GSYNC();
    RELAUNDER();
    {
    {
#if EXP == 2
      for (int rep = 0; rep < 2; ++rep) {
      int* ctr = (int*)(q.ws + OFF_CTR) + l + rep * 8;
#else
      {
      int* ctr = (int*)(q.ws + OFF_CTR) + l;
#endif
      constexpr int N_SCAN = 32, N_FT = 128, N_FTC = 8, N_GA = 512, N_WA = 512, N_CTXA = 64;
      constexpr int N_WO = 16 * 16 / 2, N_GU = 16 * 88 / 2, N_WD = 44 * 16 / 2, N_WI = 16 * 40 / 2;
      const int n_ctxa = l < 3 ? N_CTXA : 0;
      const int TOT = N_SCAN + N_FT + N_FTC + N_GA + N_WA + n_ctxa + N_WO + N_GU + N_WD + (l < 3 ? N_WI : 0);
      while (true) {
        __syncthreads();
        if (ltid_full() == 0) s_item = atomicAdd(ctr, 1);
        __syncthreads();
        int it = s_item;
        if (it >= TOT) break;
        const int hf = ltid_full() >> 8; char* smem = dsm + hf * HALF_SMEM;
        if (it < N_SCAN) { dnscan_item(q, it * 2 + hf, lds + hf * 65536); continue; }
        it -= N_SCAN;
        if (it < N_FT) { gemm8<EP_FT>(q, l, (const bf16_t*)(q.ws + OFF_ADFT), 4160, (const bf16_t*)(q.ws + OFF_BTFT), 4160, 4160, (it >> 3) * 256, (it & 7) * 256, lds); continue; }
        it -= N_FT;
        if (it < N_FTC) { gemm8<EP_FTC>(q, l, (const bf16_t*)(q.ws + OFF_ADFTC), 512, (const bf16_t*)(q.ws + OFF_BTFTC), 512, 512, 0, it * 256, lds); continue; }
        it -= N_FTC;
        if (it < N_GA) { const int j = it * 2 + hf; attn_item(q, l, 0, j >> 7, (j >> 6) & 1, 4 + (j & 63), smem); continue; }
        it -= N_GA;
        if (it < N_WA) { const int j = it * 2 + hf; attn_item(q, l, 1, j >> 7, (j >> 6) & 1, 4 + (j & 63), smem); continue; }
        it -= N_WA;
        if (it < n_ctxa) { const int j = it * 2 + hf; const int type = j >> 6, r = j & 63; attn_item(q, l, type, r >> 3, (r >> 2) & 1, r & 3, smem); continue; }
        it -= n_ctxa;
        {
          int j = it * 2 + hf;
          if (j < 2 * N_WO) { wconv_tile<false>(q.w_out + (size_t)l * 1024 * 1024, nullptr, 1024, 1024, (bf16_t*)(q.ws + OFF_WOUT), 0, j % 16, j / 16, smem); continue; }
          j -= 2 * N_WO;
          if (j < 2 * N_GU) { wconv_tile<true>(q.w_gate + (size_t)l * 1024 * HID, q.w_up + (size_t)l * 1024 * HID, HID, 1024, (bf16_t*)(q.ws + OFF_WGU), 1, j % 16, j / 16, smem,
                                     (const float*)(q.ws + OFF_MOD) + (size_t)l * 9 * 6144 + 3072, (float*)(q.ws + OFF_BIAS2) + (size_t)l * 9 * 5632, 5632); continue; }
          j -= 2 * N_GU;
          if (j < 2 * N_WD) { wconv_tile<false>(q.w_down + (size_t)l * HID * 1024, nullptr, 1024, HID, (bf16_t*)(q.ws + OFF_WD), 0, j % 44, j / 44, smem); continue; }
          j -= 2 * N_WD;
          wconv_tile<true>(q.w_in + (size_t)(l + 1) * 1024 * 2320, nullptr, 2320, 1024, (bf16_t*)(q.ws + OFF_WIN), 0, j % 16, j / 16, smem,
                           (const float*)(q.ws + OFF_MOD) + (size_t)(l + 1) * 9 * 6144, (float*)(q.ws + OFF_BIAS1) + (size_t)(l + 1) * 9 * 2560, 2560);
        }
      }
      }
    }
    }
    GSYNC();
    RELAUNDER();
    { const int hf = ltid_full() >> 8; char* smem = dsm + hf * HALF_SMEM; (void)smem;
    {
      for (int pi = bid; pi < T / 8; pi += nblk) dnmerge_item(q, l, pi * 2 + hf);
    }
    }
    GSYNC();
    RELAUNDER();
#if EXP == 1
    gemm_phase<EP_DUMMY>(q, l, (const bf16_t*)(q.ws + OFF_YMIX), 1024, (const bf16_t*)(q.ws + OFF_WOUT), 1024, 1024, 136, 4, lds);
#endif
    gemm_phase8<EP_RES1>(q, l, (const bf16_t*)(q.ws + OFF_YMIX), (const bf16_t*)(q.ws + OFF_WOUT), 1024, l == 3 ? 128 : 136, 4, lds, l == 3);
    GSYNC();
    RELAUNDER();
    gemm_phase8<EP_GU>(q, l, Hb, (const bf16_t*)(q.ws + OFF_WGU), 1024, l == 3 ? 128 : 136, 22, lds, l == 3);
#if EXP == 1
    gemm_phase<EP_GU>(q, l, Hb, 1024, (const bf16_t*)(q.ws + OFF_WGU), 1024, 1024, l == 3 ? 128 : 136, 22, lds, l == 3);
#endif
    GSYNC();
    RELAUNDER();
#if EXP == 1
    gemm_phase<EP_DUMMY>(q, l, (const bf16_t*)(q.ws + OFF_HM), HID, (const bf16_t*)(q.ws + OFF_WD), HID, HID, 136, 4, lds);
#endif
    gemm_phase8<EP_RES2>(q, l, (const bf16_t*)(q.ws + OFF_HM), (const bf16_t*)(q.ws + OFF_WD), HID, l == 3 ? 128 : 136, 4, lds, l == 3);
    GSYNC();
  }
}

#undef Hb
extern "C" void kernel_launch(void* const* d_in, const int* in_sizes, int n_in, void* d_out, int out_size, void* d_ws, size_t ws_size,
                              hipStream_t stream) {
  if (ws_size < WS_NEED) { fprintf(stderr, "workspace too small: %zu < %zu\n", ws_size, (size_t)WS_NEED); return; }
  static int grid_blocks = 0;
  if (!grid_blocks) {
    int dev = 0, cus = 0, per_cu = 0;
    (void)hipGetDevice(&dev);
    (void)hipDeviceGetAttribute(&cus, hipDeviceAttributeMultiprocessorCount, dev);
    if (hipFuncSetAttribute((const void*)mega, hipFuncAttributeMaxDynamicSharedMemorySize, LDS_BYTES) != hipSuccess) fprintf(stderr, "hipFuncSetAttribute failed\n");
    (void)hipOccupancyMaxActiveBlocksPerMultiprocessor(&per_cu, mega, 512, LDS_BYTES);
    if (per_cu < 1) { fprintf(stderr, "occupancy query returned %d\n", per_cu); per_cu = 1; }
    grid_blocks = (cus / 8) * 8;
  }
  Params p{};
  const float** pf = (const float**)&p;
  for (int i = 0; i < 22; ++i) pf[i] = (const float*)d_in[i];
  p.out = (float*)d_out;
  p.ws = (char*)d_ws;
  (void)hipMemsetAsync((char*)d_ws + OFF_BAR, 0, XCD_BAR_WORDS * 4, stream);
  void* args[] = {&p};
  hipError_t e = hipLaunchCooperativeKernel((void*)mega, dim3(grid_blocks), dim3(512), args, LDS_BYTES, stream);
  if (e != hipSuccess) fprintf(stderr, "cooperative launch failed: %s (grid %d)\n", hipGetErrorString(e), grid_blocks);
}
```

```cpp
#include <hip/hip_runtime.h>
#include <hip/hip_cooperative_groups.h>
#include <stdint.h>
#include <stdio.h>
namespace cg = cooperative_groups;

typedef unsigned short bf16_t;
typedef short bf16x8 __attribute__((ext_vector_type(8)));
typedef short bf16x4 __attribute__((ext_vector_type(4)));
typedef float f32x4 __attribute__((ext_vector_type(4)));
typedef unsigned u32x4 __attribute__((ext_vector_type(4)));
#define DI __device__ __forceinline__
#define MFMA16(a, b, c) __builtin_amdgcn_mfma_f32_16x16x32_bf16((a), (b), (c), 0, 0, 0)

constexpr int NB = 8, SEQ = 4096, LC = 256, TB = 4352, T = NB * TB, DM = 1024, PW = 2064, HID = 2816, NCH = 68;
constexpr int NIN_PAD = 2560;
constexpr float EPS = 1e-6f;
constexpr float LOG2E = 1.4426950408889634f;

constexpr size_t OFF_MOD = 0;
constexpr size_t OFF_ROPEC = 1u << 20;
constexpr size_t OFF_ROPES = OFF_ROPEC + 524288;
constexpr size_t OFF_CS64 = OFF_ROPES + 524288;
constexpr size_t OFF_ADFTC = OFF_CS64 + 16384;
constexpr size_t OFF_CTR = OFF_ADFTC + 262144;
constexpr size_t OFF_BAR = OFF_CTR + 4096;
constexpr size_t OFF_XC = 2621440;
constexpr size_t OFF_HB = OFF_XC + 8388608;
constexpr size_t SZ_HB = (size_t)T * 1024 * 2;
constexpr size_t OFF_QA = OFF_HB;
constexpr size_t OFF_KA = OFF_QA + (size_t)2 * T * 256 * 2;
constexpr size_t OFF_VT = OFF_KA + (size_t)2 * T * 128 * 2;
constexpr size_t OFF_P = OFF_HB + SZ_HB;
constexpr size_t SZ_P = (size_t)T * PW * 2;
constexpr size_t OFF_YMIX = OFF_P;
constexpr size_t OFF_ODN = OFF_P + SZ_HB;
constexpr size_t OFF_Z = OFF_P + SZ_P;
constexpr size_t OFF_BTFT = OFF_Z + (size_t)T * 256 * 2;
constexpr size_t OFF_BTFTC = OFF_BTFT + (size_t)2048 * 8192 * 2;
constexpr size_t OFF_HM = OFF_P;
constexpr size_t OFF_ADFT = OFF_BTFTC + (size_t)2048 * 512 * 2;
constexpr size_t OFF_RSS1 = OFF_ADFT + (size_t)4096 * 4160 * 2;
constexpr size_t OFF_RSS2 = OFF_RSS1 + (size_t)T * 4;
constexpr size_t OFF_BIAS1 = OFF_RSS2 + (size_t)T * 4;
constexpr size_t OFF_BIAS2 = OFF_BIAS1 + (size_t)4 * 9 * 2560 * 4;
constexpr size_t OFF_DN = OFF_ADFT + (size_t)4096 * 8192 * 2;
constexpr size_t SZ_CB = 40960;
constexpr int NCB = NB * 4 * 2 * NCH;
constexpr size_t OFF_GEND = OFF_DN + (size_t)NCB * SZ_CB;
constexpr size_t WS_NEED = OFF_GEND + (size_t)NCB * 64 * 4;
constexpr size_t OFF_WIN = OFF_BIAS2 + (size_t)4 * 9 * 5632 * 4;
constexpr size_t OFF_WOUT = OFF_WIN + (size_t)NIN_PAD * 1024 * 2;
constexpr size_t OFF_WGU = OFF_WOUT + (size_t)1024 * 1024 * 2;
constexpr size_t OFF_WD = OFF_WGU + (size_t)5632 * 1024 * 2;
static_assert(OFF_WD + (size_t)1024 * 2816 * 2 <= OFF_ADFT + (size_t)4096 * 8192 * 2, "weights overflow the ADFT region tail");
static_assert((size_t)T * HID * 2 <= OFF_ADFT - OFF_P, "Hm alias overflow");

struct Params {
  const float *x, *c, *ctx, *c_ctx, *norm1_g, *norm2_g, *w_ada, *b_ada, *w_in, *conv_w, *A_log, *dt_bias, *dn_norm_g,
      *ga_qn, *ga_kn, *wa_qn, *wa_kn, *wa_sink, *w_out, *w_gate, *w_up, *w_down;
  float* out;
  char* ws;
};

constexpr int HALF_SMEM = 53248;
constexpr int LDS_BYTES = 131072 + 8192;
#define LAS __attribute__((address_space(3)))
#define WAIT_V(n) asm volatile("s_waitcnt vmcnt(%0)" ::"n"(n) : "memory")

DI unsigned pk(float a, float b) {
  typedef __bf16 bf2 __attribute__((ext_vector_type(2)));
  typedef float f2 __attribute__((ext_vector_type(2)));
  f2 v = {a, b};
  bf2 r = __builtin_convertvector(v, bf2);
  return __builtin_bit_cast(unsigned, r);
}
DI bf16_t f2bf(float a) { return (bf16_t)(pk(a, 0.f) & 0xffffu); }
DI float bf2f(bf16_t h) { return __uint_as_float(((unsigned)h) << 16); }
DI float bflo(unsigned u) { return __uint_as_float(u << 16); }
DI float bfhi(unsigned u) { return __uint_as_float(u & 0xffff0000u); }
DI int ltid_full() { int t = threadIdx.x; asm volatile("" : "+v"(t)); return t; }
DI int ltid() { return ltid_full() & 255; }
DI float silu_f(float x) { return x * __builtin_amdgcn_rcpf(1.f + __expf(-x)); }
DI int permk(int x) { return ((x >> 5) << 5) + (((x >> 2) & 3) << 3) + (((x >> 4) & 1) << 2) + (x & 3); }

DI float* xrow(const Params& p, int t) {
  int b = t / TB, tb = t - b * TB;
  return tb < LC ? (float*)(p.ws + OFF_XC) + ((size_t)(b * LC + tb)) * DM : p.out + ((size_t)(b * SEQ + tb - LC)) * DM;
}
DI const float* xrow_in(const Params& p, int t) {
  int b = t / TB, tb = t - b * TB;
  return tb < LC ? p.ctx + ((size_t)(b * LC + tb)) * DM : p.x + ((size_t)(b * SEQ + tb - LC)) * DM;
}
DI int bidx_of(int t) { const int b = t / TB, tb = t - b * TB; return tb < LC ? 8 : b; }
DI const float* modrow(const Params& p, int l, int t) {
  int b = t / TB, tb = t - b * TB;
  int bi = tb < LC ? 8 : b;
  return (const float*)(p.ws + OFF_MOD) + ((size_t)(l * 9 + bi)) * 6144;
}

enum { EP_P = 0, EP_RES1 = 1, EP_GU = 2, EP_RES2 = 3, EP_FT = 4, EP_FTC = 5, EP_DUMMY = 6 };
#ifndef EXP
#define EXP 0
#endif

DI int lds_byte(int r, int c) {
  const int st = (r >> 4) * 2 + (c >> 5), ob = (r & 15) * 64 + (c & 31) * 2;
  return st * 1024 + (ob ^ (((ob >> 9) & 1) << 5));
}
DI void stage_rc(int b, int& R, int& C) {
  const int st = b >> 10, sb = b & 1023, swz = sb ^ (((sb >> 9) & 1) << 5);
  R = (st >> 1) * 16 + swz / 64;
  C = (st & 1) * 32 + (swz % 64) / 2;
}

template <int MODE>
DI void gemm_epilogue(const Params& p, int l, const f32x4 (&acc)[8][4], int m0, int n0, int wr, int wc, int fr, int fq, const LAS float* cst) {
#pragma unroll
  for (int i = 0; i < 8; ++i) {
    const int m = m0 + wr * 128 + i * 16 + fr;
    if (MODE == EP_P) {
      bf16_t* Pp = (bf16_t*)(p.ws + OFF_P) + (size_t)m * PW;
      bf16_t* Zp = (bf16_t*)(p.ws + OFF_Z) + (size_t)m * 256;
      const float rs = rsqrtf(cst[wr * 128 + i * 16 + fr] * (1.f / 1024.f) + EPS);
#pragma unroll
      for (int j = 0; j < 4; ++j) {
        const int n = n0 + wc * 64 + j * 16 + fq * 4;
        const f32x4 bq = *(const LAS f32x4*)(cst + 256 + wc * 64 + j * 16 + fq * 4);
        uint2 v = {pk(acc[i][j][0] * rs + bq[0], acc[i][j][1] * rs + bq[1]), pk(acc[i][j][2] * rs + bq[2], acc[i][j][3] * rs + bq[3])};
        if (n < 768) *(uint2*)(Pp + n) = v;
        else if (n < 1024) *(uint2*)(Zp + (n - 768)) = v;
        else if (n < 2320) *(uint2*)(Pp + (n - 256)) = v;
      }
    } else if (MODE == EP_RES1 || MODE == EP_RES2) {
      float* xo = xrow(p, m);
      const bool emit = (MODE == EP_RES1) || (l < 3);
      bf16_t* hb = (bf16_t*)(p.ws + OFF_HB) + (size_t)m * 1024;
      float4 xv[4];
#pragma unroll
      for (int j = 0; j < 4; ++j) xv[j] = *(const float4*)(xo + n0 + wc * 64 + j * 16 + fq * 4);
      float ssq = 0.f;
#pragma unroll
      for (int j = 0; j < 4; ++j) {
        const int n = n0 + wc * 64 + j * 16 + fq * 4;
        const f32x4 gq = *(const LAS f32x4*)(cst + 256 + wc * 64 + j * 16 + fq * 4), mq = *(const LAS f32x4*)(cst + 512 + wc * 64 + j * 16 + fq * 4);
        const float4 gv = {gq[0], gq[1], gq[2], gq[3]}, mv = {mq[0], mq[1], mq[2], mq[3]};
        xv[j].x += gv.x * acc[i][j][0]; xv[j].y += gv.y * acc[i][j][1]; xv[j].z += gv.z * acc[i][j][2]; xv[j].w += gv.w * acc[i][j][3];
        *(float4*)(xo + n) = xv[j];
        if (emit) {
          ssq += xv[j].x * xv[j].x + xv[j].y * xv[j].y + xv[j].z * xv[j].z + xv[j].w * xv[j].w;
          *(uint2*)(hb + n) = uint2{pk(xv[j].x * mv.x, xv[j].y * mv.y), pk(xv[j].z * mv.z, xv[j].w * mv.w)};
        }
      }
      if (emit) {
        ssq += __shfl_xor(ssq, 16);
        ssq += __shfl_xor(ssq, 32);
        if (fq == 0) unsafeAtomicAdd((float*)(p.ws + (MODE == EP_RES1 ? OFF_RSS2 : OFF_RSS1)) + m, ssq);
      }
    } else if (MODE == EP_GU) {
      bf16_t* hp = (bf16_t*)(p.ws + OFF_HM) + (size_t)m * HID;
      const float rs = rsqrtf(cst[wr * 128 + i * 16 + fr] * (1.f / 1024.f) + EPS);
#pragma unroll
      for (int jj = 0; jj < 2; ++jj) {
        const int hcol = ((n0 + wc * 64) >> 1) + jj * 16 + fq * 4;
        const f32x4 bg = *(const LAS f32x4*)(cst + 256 + wc * 64 + (2 * jj) * 16 + fq * 4), bu = *(const LAS f32x4*)(cst + 256 + wc * 64 + (2 * jj + 1) * 16 + fq * 4);
        const float bgv[4] = {bg[0], bg[1], bg[2], bg[3]}, buv[4] = {bu[0], bu[1], bu[2], bu[3]};
        float o[4];
#pragma unroll
        for (int r = 0; r < 4; ++r) o[r] = silu_f(acc[i][2 * jj][r] * rs + bgv[r]) * (acc[i][2 * jj + 1][r] * rs + buv[r]);
        uint2 v = {pk(o[0], o[1]), pk(o[2], o[3])};
        *(uint2*)(hp + hcol) = v;
      }
    } else if (MODE == EP_DUMMY) {
      bf16_t* dp = (bf16_t*)(p.ws + OFF_DN + (size_t)40 * 1024 * 1024) + (size_t)m * 1024;
#pragma unroll
      for (int j = 0; j < 4; ++j) {
        const int n = n0 + wc * 64 + j * 16 + fq * 4;
        *(uint2*)(dp + n) = uint2{pk(acc[i][j][0], acc[i][j][1]), pk(acc[i][j][2], acc[i][j][3])};
      }
    } else {
      bf16_t* Y = (bf16_t*)(p.ws + OFF_YMIX);
      const float scale = (MODE == EP_FT) ? (1.f / 512.f) : (1.f / 128.f);
#pragma unroll
      for (int j = 0; j < 4; ++j) {
        const int n = n0 + wc * 64 + j * 16 + fq * 4;
        const int b = n >> 8;
        const size_t row = (size_t)b * TB + (MODE == EP_FT ? LC : 0) + m;
        uint2 v = {pk(acc[i][j][0] * scale, acc[i][j][1] * scale), pk(acc[i][j][2] * scale, acc[i][j][3] * scale)};
        *(uint2*)(Y + row * 1024 + 768 + (n & 255)) = v;
      }
    }
  }
}

constexpr int G8_TILE_B = 256 * 64 * 2, G8_STAGE_B = 2 * G8_TILE_B;
#define G8_STAGE(Ab_, Bb_, buf, kt)                                                                                                            \
  do {                                                                                                                                        \
    _Pragma("unroll") for (int i = 0; i < 4; ++i) {                                                                                           \
      __builtin_amdgcn_global_load_lds((const unsigned*)((Ab_) + offA[i] + (kt) * 64), (LAS unsigned*)(lds + (buf) * G8_STAGE_B + wid * 1024 + i * 8192), 16, 0, 0);               \
      __builtin_amdgcn_global_load_lds((const unsigned*)((Bb_) + offB[i] + (kt) * 64), (LAS unsigned*)(lds + (buf) * G8_STAGE_B + G8_TILE_B + wid * 1024 + i * 8192), 16, 0, 0);   \
    }                                                                                                                                         \
  } while (0)
#define G8_COMPUTE(buf)                                                                                                                       \
  do {                                                                                                                                        \
    const LAS char* sa = lds + (buf) * G8_STAGE_B;                                                                                            \
    const LAS char* sb = sa + G8_TILE_B;                                                                                                      \
    _Pragma("unroll") for (int ks = 0; ks < 2; ++ks) {                                                                                        \
      bf16x8 bfr[4];                                                                                                                          \
      _Pragma("unroll") for (int j = 0; j < 4; ++j) bfr[j] = *(const LAS bf16x8*)(sb + lds_byte(wc * 64 + j * 16 + fr, ks * 32 + fq * 8));    \
      bf16x8 a_cur = *(const LAS bf16x8*)(sa + lds_byte(wr * 128 + fr, ks * 32 + fq * 8));                                                    \
      _Pragma("unroll") for (int i = 0; i < 8; ++i) {                                                                                         \
        bf16x8 a_nxt = a_cur;                                                                                                                 \
        if (i < 7) a_nxt = *(const LAS bf16x8*)(sa + lds_byte(wr * 128 + (i + 1) * 16 + fr, ks * 32 + fq * 8));          \
        _Pragma("unroll") for (int j = 0; j < 4; ++j) acc[i][j] = MFMA16(bfr[j], a_cur, acc[i][j]);                                           \
        __builtin_amdgcn_sched_group_barrier(0x100, 1, 0);                                                                                    \
        __builtin_amdgcn_sched_group_barrier(0x008, 4, 0);                                                                                    \
        a_cur = a_nxt;                                                                                                                        \
      }                                                                                                                                       \
    }                                                                                                                                         \
  } while (0)
#define G8_SETUP()                                                                                                                            \
  const int tid = ltid_full(), wid = tid >> 6, lane = tid & 63;                                                                               \
  const int wr = wid >> 2, wc = wid & 3, fr = lane & 15, fq = lane >> 4;                                                                      \
  int offA[4], offB[4];                                                                                                                       \
  _Pragma("unroll") for (int i = 0; i < 4; ++i) {                                                                                             \
    int R, C;                                                                                                                                 \
    stage_rc(wid * 1024 + i * 8192 + lane * 16, R, C);                                                                                        \
    offA[i] = R * lda + C;                                                                                                                    \
    offB[i] = R * ldb + C;                                                                                                                    \
  }

template <int MODE>
DI void gemm8(const Params& p, int l, const bf16_t* A, int lda, const bf16_t* Bt, int ldb, int K, int m0, int n0, LAS char* lds) {
  G8_SETUP();
  f32x4 acc[8][4];
#pragma unroll
  for (int i = 0; i < 8; ++i)
#pragma unroll
    for (int j = 0; j < 4; ++j) acc[i][j] = f32x4{0.f, 0.f, 0.f, 0.f};
  const bf16_t* Ab = A + (size_t)m0 * lda;
  const bf16_t* Bb = Bt + (size_t)n0 * ldb;
  const int nt = K >> 6;
  G8_STAGE(Ab, Bb, 0, 0);
  WAIT_V(0);
  __syncthreads();
  for (int t = 0; t < nt; ++t) {
    const int cur = t & 1;
    if (t + 1 < nt) G8_STAGE(Ab, Bb, cur ^ 1, t + 1);
    G8_COMPUTE(cur);
    WAIT_V(0);
    __syncthreads();
  }
  gemm_epilogue<MODE>(p, l, acc, m0, n0, wr, wc, fr, fq, (const LAS float*)(lds + 131072));
}

struct GTile { int m0, n0, kb, nk, atomic; };
template <int MODE>
DI bool gemm_next_tile(int k, int nM, int nN, int Kit, GTile& g, bool skipctx = false) {
  const int ntl = nM * nN, per = ntl >> 3;
  const int nb8 = gridDim.x >> 3, xcd = blockIdx.x & 7, j = blockIdx.x >> 3;
  const int R = per / nb8, rem = per - R * nb8;
  int loc;
  g.kb = 0; g.nk = Kit; g.atomic = 0;
  if (k < R) loc = k * nb8 + j;
  else if (k == R && rem > 0) {
    int S = 1;
    if (false) { S = nb8 / rem; while (S > 1 && (Kit % S)) --S; }
    if (j >= rem * S) return false;
    loc = R * nb8 + j / S;
    if (S > 1) { g.nk = Kit / S; g.kb = (j % S) * g.nk; g.atomic = 1; }
  } else return false;
  const int L = xcd * per + loc;
  const int nig = 8 * nN, gid = L / nig, fm = gid * 8, gsz = (nM - fm) < 8 ? (nM - fm) : 8;
  int pm = fm + ((L % nig) % gsz);
  if (skipctx) pm += pm / 16 + 1;
  g.m0 = pm * 256;
  g.n0 = ((L % nig) / gsz) * 256;
  return true;
}

template <int MODE>
DI void gemm_phase(const Params& p, int l, const bf16_t* A, int lda, const bf16_t* Bt, int ldb, int K, int nM, int nN, LAS char* lds, bool skipctx = false) {
  G8_SETUP();
  const int Kit = K >> 6;
  GTile cur, nxt;
  bool have = gemm_next_tile<MODE>(0, nM, nN, Kit, cur, skipctx);
  if (have) G8_STAGE(A + (size_t)cur.m0 * lda, Bt + (size_t)cur.n0 * ldb, 0, cur.kb);
  for (int k = 0; have; ++k) {
    const bool hn = gemm_next_tile<MODE>(k + 1, nM, nN, Kit, nxt, skipctx);
    f32x4 acc[8][4];
#pragma unroll
    for (int i = 0; i < 8; ++i)
#pragma unroll
      for (int j = 0; j < 4; ++j) acc[i][j] = f32x4{0.f, 0.f, 0.f, 0.f};
    const bf16_t* Ab = A + (size_t)cur.m0 * lda;
    const bf16_t* Bb = Bt + (size_t)cur.n0 * ldb;
    LAS float* cst = (LAS float*)(lds + 131072 + (k & 1) * 4096);
    if (MODE == EP_P || MODE == EP_GU) {
      const float* rss = (const float*)(p.ws + (MODE == EP_P ? OFF_RSS1 : OFF_RSS2));
      const float* bias = (const float*)(p.ws + (MODE == EP_P ? OFF_BIAS1 : OFF_BIAS2)) + ((size_t)(l * 9 + bidx_of(cur.m0))) * (MODE == EP_P ? 2560 : 5632);
      cst[tid] = tid < 256 ? rss[cur.m0 + tid] : bias[cur.n0 + tid - 256];
    }
    if (MODE == EP_RES1 || MODE == EP_RES2) {
      const float* mrow = modrow(p, l, cur.m0);
      const int c = cur.n0 + (tid & 255);
      if (tid < 256) cst[256 + tid] = mrow[(MODE == EP_RES1 ? 2048 : 5120) + c];
      else {
        const float* ng = (MODE == EP_RES1) ? p.norm2_g + l * 1024 : p.norm1_g + (l < 3 ? l + 1 : 0) * 1024;
        const float* nsc = (MODE == EP_RES1) ? mrow + 4096 : modrow(p, l < 3 ? l + 1 : 0, cur.m0) + 1024;
        cst[256 + tid] = ng[c] * (1.f + nsc[c]);
      }
    }
    WAIT_V(0);
    __syncthreads();
    for (int t = 0; t < cur.nk; ++t) {
      const int cb = t & 1;
      if (t + 1 < cur.nk) G8_STAGE(Ab, Bb, cb ^ 1, cur.kb + t + 1);
      G8_COMPUTE(cb);
      WAIT_V(0);
      __syncthreads();
    }
    if (hn) G8_STAGE(A + (size_t)nxt.m0 * lda, Bt + (size_t)nxt.n0 * ldb, 0, nxt.kb);
    gemm_epilogue<MODE>(p, l, acc, cur.m0, cur.n0, wr, wc, fr, fq, cst);
    cur = nxt;
    have = hn;
  }
}

template <int MODE>
DI void gemm_epilogue8(const Params& p, int l, const f32x4 (&acc)[2][2][4][2], int m0, int n0, int wr, int wc, int fr, int fq, const LAS float* cst, bool half) {
#pragma unroll
  for (int ai = 0; ai < 2; ++ai)
#pragma unroll
    for (int mm = 0; mm < 4; ++mm) {
      if (ai == 1 && half) continue;
      const int rl = ai * 128 + wr * 64 + mm * 16 + fr;
      const int m = m0 + rl;
      if (MODE == EP_P) {
        bf16_t* Pp = (bf16_t*)(p.ws + OFF_P) + (size_t)m * PW;
        bf16_t* Zp = (bf16_t*)(p.ws + OFF_Z) + (size_t)m * 256;
        const float rs = rsqrtf(cst[rl] * (1.f / 1024.f) + EPS);
#pragma unroll
        for (int bj = 0; bj < 2; ++bj)
#pragma unroll
          for (int nn = 0; nn < 2; ++nn) {
            const int cl = bj * 128 + wc * 32 + nn * 16 + fq * 4, n = n0 + cl;
            const f32x4 bq = *(const LAS f32x4*)(cst + 256 + cl);
            const f32x4& a = acc[ai][bj][mm][nn];
            uint2 v = {pk(a[0] * rs + bq[0], a[1] * rs + bq[1]), pk(a[2] * rs + bq[2], a[3] * rs + bq[3])};
            if (n < 768) *(uint2*)(Pp + n) = v;
            else if (n < 1024) *(uint2*)(Zp + (n - 768)) = v;
            else if (n < 2320) *(uint2*)(Pp + (n - 256)) = v;
          }
      } else if (MODE == EP_RES1 || MODE == EP_RES2) {
        float* xo = xrow(p, m);
        const bool emit = (MODE == EP_RES1) || (l < 3);
        bf16_t* hb = (bf16_t*)(p.ws + OFF_HB) + (size_t)m * 1024;
        float4 xv[4];
#pragma unroll
        for (int q4 = 0; q4 < 4; ++q4) xv[q4] = *(const float4*)(xo + n0 + (q4 >> 1) * 128 + wc * 32 + (q4 & 1) * 16 + fq * 4);
        float ssq = 0.f;
#pragma unroll
        for (int q4 = 0; q4 < 4; ++q4) {
          const int cl = (q4 >> 1) * 128 + wc * 32 + (q4 & 1) * 16 + fq * 4, n = n0 + cl;
          const f32x4 gq = *(const LAS f32x4*)(cst + 256 + cl), mq = *(const LAS f32x4*)(cst + 512 + cl);
          const f32x4& a = acc[ai][q4 >> 1][mm][q4 & 1];
          xv[q4].x += gq[0] * a[0]; xv[q4].y += gq[1] * a[1]; xv[q4].z += gq[2] * a[2]; xv[q4].w += gq[3] * a[3];
          *(float4*)(xo + n) = xv[q4];
          if (emit) {
            ssq += xv[q4].x * xv[q4].x + xv[q4].y * xv[q4].y + xv[q4].z * xv[q4].z + xv[q4].w * xv[q4].w;
            *(uint2*)(hb + n) = uint2{pk(xv[q4].x * mq[0], xv[q4].y * mq[1]), pk(xv[q4].z * mq[2], xv[q4].w * mq[3])};
          }
        }
        if (emit) {
          ssq += __shfl_xor(ssq, 16);
          ssq += __shfl_xor(ssq, 32);
          if (fq == 0) unsafeAtomicAdd((float*)(p.ws + (MODE == EP_RES1 ? OFF_RSS2 : OFF_RSS1)) + m, ssq);
        }
      } else if (MODE == EP_GU) {
        bf16_t* hp = (bf16_t*)(p.ws + OFF_HM) + (size_t)m * HID;
        const float rs = rsqrtf(cst[rl] * (1.f / 1024.f) + EPS);
#pragma unroll
        for (int bj = 0; bj < 2; ++bj) {
          const int cl = bj * 128 + wc * 32 + fq * 4;
          const int hcol = ((n0 + bj * 128 + wc * 32) >> 1) + fq * 4;
          const f32x4 bg = *(const LAS f32x4*)(cst + 256 + cl), bu = *(const LAS f32x4*)(cst + 256 + cl + 16);
          const f32x4& ag = acc[ai][bj][mm][0];
          const f32x4& au = acc[ai][bj][mm][1];
          float o[4];
#pragma unroll
          for (int r = 0; r < 4; ++r) o[r] = silu_f(ag[r] * rs + bg[r]) * (au[r] * rs + bu[r]);
          *(uint2*)(hp + hcol) = uint2{pk(o[0], o[1]), pk(o[2], o[3])};
        }
      } else {
        bf16_t* dp = (bf16_t*)(p.ws + OFF_DN + (size_t)40 * 1024 * 1024) + (size_t)m * 1024;
#pragma unroll
        for (int q4 = 0; q4 < 4; ++q4) {
          const f32x4& a = acc[ai][q4 >> 1][mm][q4 & 1];
          *(uint2*)(dp + n0 + (q4 >> 1) * 128 + wc * 32 + (q4 & 1) * 16 + fq * 4) = uint2{pk(a[0], a[1]), pk(a[2], a[3])};
        }
      }
    }
}

DI bool next_tile8(int k, int nM, int nN, int Kit, GTile& g, int ctxmode) {
  if (ctxmode != 2) return gemm_next_tile<EP_P>(k, nM, nN, Kit, g, ctxmode == 1);
  if (gemm_next_tile<EP_P>(k, 128, nN, Kit, g, true)) return true;
  const int nb8 = gridDim.x >> 3, per = 16 * nN, R = per / nb8, kx = R + ((per - R * nb8) > 0 ? 1 : 0);
  const int j = blockIdx.x >> 3;
  if (k != kx || j >= 2 * nN) return false;
  const int u = (blockIdx.x & 7) * (2 * nN) + j;
  g.m0 = (blockIdx.x & 7) * 17 * 256 + ((j / nN) & 1) * 128;
  g.n0 = (j % nN) * 256;
  g.kb = 0; g.nk = Kit; g.atomic = 1;
  (void)u;
  return true;
}

template <int MODE>
DI void gemm_phase8(const Params& p, int l, const bf16_t* A, const bf16_t* Bt, int K, int nM, int nN, LAS char* lds, int ctxmode) {
  constexpr int HT = 128 * 64;
  const int tid = ltid_full(), wid = tid >> 6, lane = tid & 63;
  const int wr = wid >> 2, wc = wid & 3, fr = lane & 15, fq = lane >> 4;
  unsigned soff[2];
#pragma unroll
  for (int i = 0; i < 2; ++i) { int R, C; stage_rc(tid * 16 + i * 8192, R, C); soff[i] = (unsigned)(R * K + C) * 2u; }
#define P8_SA(b, h) (lds + (((b) * 2 + (h)) * HT) * 2)
#define P8_SB(b, h) (lds + ((4 + (b) * 2 + (h)) * HT) * 2)
#define P8_STAGE(P_, BASE_, br_, kt_)                                                                                                          \
  do {                                                                                                                                        \
    const unsigned long long _gi = (unsigned long long)((BASE_) + (size_t)(br_) * K + (size_t)(kt_) * 64);                                       \
    const char* _g = (const char*)(((unsigned long long)(unsigned)__builtin_amdgcn_readfirstlane((int)(_gi >> 32)) << 32) |                    \
                                   (unsigned)__builtin_amdgcn_readfirstlane((int)(unsigned)_gi));     \
    _Pragma("unroll") for (int _i = 0; _i < 2; ++_i)                                                                                          \
      __builtin_amdgcn_global_load_lds((const unsigned*)(_g + soff[_i]), (LAS unsigned*)((P_) + wid * 1024 + _i * 8192), 16, 0, 0);            \
  } while (0)
#define P8_LDA(dst, b, h)                                                                                                                     \
  _Pragma("unroll") for (int m_ = 0; m_ < 4; ++m_) _Pragma("unroll") for (int k_ = 0; k_ < 2; ++k_)                                           \
    dst[m_][k_] = *(const LAS bf16x8*)(P8_SA(b, h) + lds_byte(wr * 64 + m_ * 16 + fr, k_ * 32 + fq * 8))
#define P8_LDB(dst, b, h)                                                                                                                     \
  _Pragma("unroll") for (int n_ = 0; n_ < 2; ++n_) _Pragma("unroll") for (int k_ = 0; k_ < 2; ++k_)                                           \
    dst[n_][k_] = *(const LAS bf16x8*)(P8_SB(b, h) + lds_byte(wc * 32 + n_ * 16 + fr, k_ * 32 + fq * 8))
#define P8_MMA(ai, bj, At_, Bt_)                                                                                                              \
  do {                                                                                                                                        \
    __builtin_amdgcn_s_setprio(1);                                                                                                            \
    _Pragma("unroll") for (int m_ = 0; m_ < 4; ++m_) _Pragma("unroll") for (int n_ = 0; n_ < 2; ++n_) _Pragma("unroll") for (int k_ = 0; k_ < 2; ++k_) \
      acc[ai][bj][m_][n_] = MFMA16(Bt_[n_][k_], At_[m_][k_], acc[ai][bj][m_][n_]);                                                            \
    __builtin_amdgcn_s_setprio(0);                                                                                                            \
  } while (0)
#define P8_MMA_B1(ai, bj, At_, Bt_) do { if (!skipb1 && !((ai) == 1 && half)) P8_MMA(ai, bj, At_, Bt_); } while (0)
#define P8_MMA_A1(ai, bj, At_, Bt_) do { if (!half) P8_MMA(ai, bj, At_, Bt_); } while (0)
#define P8_WAIT_L(n) asm volatile("s_waitcnt lgkmcnt(%0)" ::"n"(n) : "memory")
#define P8_BAR __builtin_amdgcn_s_barrier()
#define P8_SCHED __builtin_amdgcn_sched_barrier(0)
  const int nt = K >> 6;
  GTile cur;
  for (int k = 0; next_tile8(k, nM, nN, nt, cur, ctxmode); ++k) {
    const int brow = cur.m0, bcol = cur.n0;
    const bool half = cur.atomic != 0;
    const bool skipb1 = (MODE == EP_P) && (bcol + 128 >= 2320);
    LAS float* cst = (LAS float*)(lds + 131072 + (k & 1) * 4096);
    if (MODE == EP_P || MODE == EP_GU) {
      const float* rss = (const float*)(p.ws + (MODE == EP_P ? OFF_RSS1 : OFF_RSS2));
      const float* bias = (const float*)(p.ws + (MODE == EP_P ? OFF_BIAS1 : OFF_BIAS2)) + ((size_t)(l * 9 + bidx_of(brow))) * (MODE == EP_P ? 2560 : 5632);
      cst[tid] = tid < 256 ? rss[brow + tid] : bias[bcol + tid - 256];
    }
    if (MODE == EP_RES1 || MODE == EP_RES2) {
      const float* mrow = modrow(p, l, brow);
      const int c = bcol + (tid & 255);
      if (tid < 256) cst[256 + tid] = mrow[(MODE == EP_RES1 ? 2048 : 5120) + c];
      else {
        const float* ng = (MODE == EP_RES1) ? p.norm2_g + l * 1024 : p.norm1_g + (l < 3 ? l + 1 : 0) * 1024;
        const float* nsc = (MODE == EP_RES1) ? mrow + 4096 : modrow(p, l < 3 ? l + 1 : 0, brow) + 1024;
        cst[256 + tid] = ng[c] * (1.f + nsc[c]);
      }
    }
    f32x4 acc[2][2][4][2];
#pragma unroll
    for (int a_ = 0; a_ < 2; ++a_)
#pragma unroll
      for (int b_ = 0; b_ < 2; ++b_)
#pragma unroll
        for (int m_ = 0; m_ < 4; ++m_)
#pragma unroll
          for (int n_ = 0; n_ < 2; ++n_) acc[a_][b_][m_][n_] = f32x4{0.f, 0.f, 0.f, 0.f};
    bf16x8 At[4][2], B0[2][2], B1[2][2];
    __syncthreads();
    P8_STAGE(P8_SB(0, 0), Bt, bcol, 0); P8_STAGE(P8_SA(0, 0), A, brow, 0);
    P8_STAGE(P8_SB(0, 1), Bt, bcol + 128, 0); P8_STAGE(P8_SA(0, 1), A, brow + 128, 0);
    if (wr == 1) P8_BAR;
    WAIT_V(4); P8_BAR;
    P8_STAGE(P8_SB(1, 0), Bt, bcol, 1); P8_STAGE(P8_SA(1, 0), A, brow, 1); P8_STAGE(P8_SB(1, 1), Bt, bcol + 128, 1);
    WAIT_V(6); P8_BAR;
    for (int t = 0; t < nt - 2; t += 2) {
      P8_LDB(B0, 0, 0); P8_SCHED; P8_LDA(At, 0, 0); P8_STAGE(P8_SA(1, 1), A, brow + 128, t + 1);
      P8_WAIT_L(8); P8_BAR; P8_WAIT_L(0); P8_MMA(0, 0, At, B0); P8_BAR; P8_SCHED;
      P8_LDB(B1, 0, 1); P8_STAGE(P8_SB(0, 0), Bt, bcol, t + 2);
      P8_BAR; P8_WAIT_L(0); P8_MMA_B1(0, 1, At, B1); P8_BAR;
      P8_LDA(At, 0, 1); P8_STAGE(P8_SA(0, 0), A, brow, t + 2);
      P8_BAR; P8_WAIT_L(0); P8_MMA_A1(1, 0, At, B0); P8_BAR; P8_SCHED;
      P8_STAGE(P8_SB(0, 1), Bt, bcol + 128, t + 2);
      WAIT_V(6); P8_BAR; P8_MMA_B1(1, 1, At, B1); P8_BAR;
      P8_LDB(B0, 1, 0); P8_SCHED; P8_LDA(At, 1, 0); P8_STAGE(P8_SA(0, 1), A, brow + 128, t + 2);
      P8_WAIT_L(8); P8_BAR; P8_WAIT_L(0); P8_MMA(0, 0, At, B0); P8_BAR; P8_SCHED;
      P8_LDB(B1, 1, 1); P8_STAGE(P8_SB(1, 0), Bt, bcol, t + 3);
      P8_BAR; P8_WAIT_L(0); P8_MMA_B1(0, 1, At, B1); P8_BAR;
      P8_LDA(At, 1, 1); P8_STAGE(P8_SA(1, 0), A, brow, t + 3);
      P8_BAR; P8_WAIT_L(0); P8_MMA_A1(1, 0, At, B0); P8_BAR; P8_SCHED;
      P8_STAGE(P8_SB(1, 1), Bt, bcol + 128, t + 3);
      WAIT_V(6); P8_BAR; P8_MMA_B1(1, 1, At, B1); P8_BAR;
    }
    { P8_LDB(B0, 0, 0); P8_LDA(At, 0, 0); P8_STAGE(P8_SA(1, 1), A, brow + 128, nt - 1);
      P8_BAR; P8_WAIT_L(0); P8_MMA(0, 0, At, B0); P8_BAR;
      P8_LDB(B1, 0, 1); P8_BAR; P8_WAIT_L(0); P8_MMA_B1(0, 1, At, B1); P8_BAR;
      P8_LDA(At, 0, 1); WAIT_V(4); P8_BAR; P8_WAIT_L(0); P8_MMA_A1(1, 0, At, B0); P8_MMA_B1(1, 1, At, B1); P8_BAR; }
    { P8_LDB(B0, 1, 0); P8_LDA(At, 1, 0); WAIT_V(2); P8_BAR; P8_WAIT_L(0); P8_MMA(0, 0, At, B0); P8_BAR;
      P8_LDB(B1, 1, 1); WAIT_V(0); P8_BAR; P8_WAIT_L(0); P8_MMA_B1(0, 1, At, B1); P8_BAR;
      P8_LDA(At, 1, 1); P8_BAR; P8_WAIT_L(0); P8_MMA_A1(1, 0, At, B0); P8_MMA_B1(1, 1, At, B1); P8_BAR; }
    if (wr == 0) P8_BAR;
    gemm_epilogue8<MODE>(p, l, acc, brow, bcol, wr, wc, fr, fq, cst, half);
  }
}

template <bool BIAS>
DI void wconv_tile(const float* src0, const float* src1, int N, int K, bf16_t* dst, int kind, int kt, int nt, char* smem, const float* shvec = nullptr, float* bias = nullptr, int npad = 0) {
  float* tile = (float*)smem;
  const int tid = ltid();
  __syncthreads();
  {
    const int nn = tid & 63, kk0 = tid >> 6;
    const int R = nt * 64 + nn;
    const float* src = src0;
    int col = R;
    bool ok = true;
    if (kind == 1) {
      const int grp = R >> 5, up = (R >> 4) & 1;
      col = grp * 16 + (R & 15);
      src = up ? src1 : src0;
    } else ok = R < N;
    float wv[16];
#pragma unroll
    for (int i = 0; i < 16; ++i) wv[i] = ok ? src[(size_t)(kt * 64 + kk0 + i * 4) * N + col] : 0.f;
#pragma unroll
    for (int i = 0; i < 16; ++i) tile[(kk0 + i * 4) * 65 + nn] = wv[i];
    if (BIAS) {
      float* svs = tile + 64 * 65;
      for (int o = tid; o < 9 * 64; o += 256) svs[o] = shvec[(size_t)(o >> 6) * 6144 + kt * 64 + (o & 63)];
    }
  }
  __syncthreads();
  {
    const int rr = tid >> 2, kc = (tid & 3) * 16;
    unsigned o[8];
#pragma unroll
    for (int e = 0; e < 8; ++e) o[e] = pk(tile[(kc + 2 * e) * 65 + rr], tile[(kc + 2 * e + 1) * 65 + rr]);
    bf16_t* d = dst + (size_t)(nt * 64 + rr) * K + kt * 64 + kc;
    *(uint4*)d = uint4{o[0], o[1], o[2], o[3]};
    *(uint4*)(d + 8) = uint4{o[4], o[5], o[6], o[7]};
  }
  if (BIAS) {
    for (int o = tid; o < 9 * 64; o += 256) {
      const int bq = o >> 6, nn = o & 63;
      const float* sv = tile + 64 * 65 + bq * 64;
      float a = 0.f;
#pragma unroll 8
      for (int kk = 0; kk < 64; ++kk) a += sv[kk] * tile[kk * 65 + nn];
      unsafeAtomicAdd(bias + (size_t)bq * npad + nt * 64 + nn, a);
    }
  }
}

DI void mod_item(const Params& p, int item, char* smem) {
  const int l = item / 96, cgp = item % 96;
  float* sc = (float*)smem;
  float* red = sc + 9 * 1024;
  const int tid = ltid();
  __syncthreads();
  for (int i = tid; i < 9 * 1024; i += 256) {
    const int r = i >> 10, k = i & 1023;
    const float v = r < 8 ? p.c[r * 1024 + k] : p.c_ctx[k];
    sc[i] = silu_f(v);
  }
  __syncthreads();
  const int kq = tid >> 6, cc = tid & 63, col = cgp * 64 + cc;
  float acc[9];
#pragma unroll
  for (int r = 0; r < 9; ++r) acc[r] = 0.f;
  const float* wp = p.w_ada + (size_t)l * 1024 * 6144 + col;
#pragma unroll 8
  for (int k = kq * 256; k < kq * 256 + 256; ++k) {
    const float wv = wp[(size_t)k * 6144];
#pragma unroll
    for (int r = 0; r < 9; ++r) acc[r] += sc[r * 1024 + k] * wv;
  }
#pragma unroll
  for (int r = 0; r < 9; ++r) red[(kq * 9 + r) * 64 + cc] = acc[r];
  __syncthreads();
  for (int i = tid; i < 9 * 64; i += 256) {
    const int r = i >> 6, c2 = i & 63;
    const float s = red[(0 * 9 + r) * 64 + c2] + red[(1 * 9 + r) * 64 + c2] + red[(2 * 9 + r) * 64 + c2] + red[(3 * 9 + r) * 64 + c2];
    ((float*)(p.ws + OFF_MOD))[((size_t)(l * 9 + r)) * 6144 + cgp * 64 + c2] = s + p.b_ada[l * 6144 + cgp * 64 + c2];
  }
}

DI void phase0(const Params& p, char* smem) {
  const int tid = ltid(), hf = ltid_full() >> 8;
  constexpr int N_MOD_IT = 384, N_ROPE = 512, N_CS = 32, N_ADC = 512, N_AD = 4160;
  constexpr int TOT = N_MOD_IT + N_ROPE + N_CS + N_ADC + N_AD;
  if (blockIdx.x == 0 && hf == 0 && tid < 64) ((int*)(p.ws + OFF_CTR))[tid] = 0;
  for (int i = blockIdx.x * 512 + ltid_full(); i < 4 * 9 * (2560 + 5632); i += gridDim.x * 512) ((float*)(p.ws + OFF_BIAS1))[i] = 0.f;
  for (int pi = blockIdx.x; pi < TOT / 2; pi += gridDim.x) {
    int i = pi * 2 + hf;
    if (i < N_MOD_IT) { mod_item(p, i, smem + hf * HALF_SMEM); continue; }
    i -= N_MOD_IT;
    if (i < N_ROPE) {
      const int e = i * 256 + tid;
      const int pos = e >> 5, f = e & 31;
      const float pv = (f < 16) ? (float)(pos >> 6) : (float)(pos & 63);
      const float invf = powf(10000.f, -(float)(f & 15) / 16.f);
      const float ang = pv * invf;
      float s, c;
      sincosf(ang, &s, &c);
      ((float*)(p.ws + OFF_ROPEC))[e] = c;
      ((float*)(p.ws + OFF_ROPES))[e] = s;
      continue;
    }
    i -= N_ROPE;
    if (i < N_CS) {
      const int e = i * 256 + tid;
      const int r = e >> 6, n2 = e & 63;
      const int idx = ((r & 63) * n2) & 63;
      float s, c;
      sincospif((float)idx / 32.f, &s, &c);
      ((bf16_t*)(p.ws + OFF_CS64))[e] = f2bf(r < 64 ? c : s);
      continue;
    }
    i -= N_CS;
    if (i < N_ADC) {
      const int e = i * 256 + tid;
      const int k1 = e >> 9, cc = e & 511, n1 = cc & 255;
      const int idx = (k1 * n1) & 255;
      float s, c;
      sincospif((float)idx / 128.f, &s, &c);
      ((bf16_t*)(p.ws + OFF_ADFTC))[e] = f2bf(cc < 256 ? c : -s);
      continue;
    }
    i -= N_ADC;
    if (i < N_AD) {
      const size_t e0 = (size_t)i * 4096 + (size_t)tid * 16;
      const int k1 = (int)(e0 / 4160), c0 = (int)(e0 % 4160);
      unsigned o[8];
#pragma unroll
      for (int e = 0; e < 8; ++e) {
        float v[2];
#pragma unroll
        for (int h = 0; h < 2; ++h) {
          const int cc = c0 + 2 * e + h;
          const int n1 = cc < 2112 ? cc : cc - 2112;
          const int idx = (k1 * n1) & 4095;
          float sn, cs;
          sincospif((float)idx / 2048.f, &sn, &cs);
          v[h] = cc < 2112 ? (cc <= 2048 ? cs : 0.f) : -sn;
        }
        o[e] = pk(v[0], v[1]);
      }
      bf16_t* dd = (bf16_t*)(p.ws + OFF_ADFT) + e0;
      *(uint4*)dd = uint4{o[0], o[1], o[2], o[3]};
      *(uint4*)(dd + 8) = uint4{o[4], o[5], o[6], o[7]};
      continue;
    }
  }
}

DI void norm_item(const Params& p, int item) {
  const int tid = ltid();
  const int w = tid >> 6, lane = tid & 63;
  const int t = item * 4 + w;
  const float* xr = xrow_in(p, t);
  const float* md = modrow(p, 0, t);
  const float* g = p.norm1_g;
  float4 v[4];
  float ss = 0.f;
#pragma unroll
  for (int j = 0; j < 4; ++j) {
    v[j] = *(const float4*)(xr + j * 256 + lane * 4);
    ss += v[j].x * v[j].x + v[j].y * v[j].y + v[j].z * v[j].z + v[j].w * v[j].w;
  }
#pragma unroll
  for (int off = 32; off >= 1; off >>= 1) ss += __shfl_xor(ss, off);
  if (lane == 0) ((float*)(p.ws + OFF_RSS1))[t] = ss;
  float* xo = xrow(p, t);
  bf16_t* hb = (bf16_t*)(p.ws + OFF_HB) + (size_t)t * 1024;
#pragma unroll
  for (int j = 0; j < 4; ++j) {
    const int c = j * 256 + lane * 4;
    *(float4*)(xo + c) = v[j];
    const float4 gg = *(const float4*)(g + c), sc = *(const float4*)(md + 1024 + c);
    *(uint2*)(hb + c) = uint2{pk(v[j].x * gg.x * (1.f + sc.x), v[j].y * gg.y * (1.f + sc.y)), pk(v[j].z * gg.z * (1.f + sc.z), v[j].w * gg.w * (1.f + sc.w))};
  }
}

DI void aprep_item(const Params& p, int l, int item, char* smem) {
  const int b = item / NCH, c = item % NCH;
  const int tok0 = b * TB + c * 64;
  const bool isctx = c < 4;
  int tid_ = ltid();
  const int tid = tid_, lane = tid & 63, w = tid >> 6;
  const bf16_t* P = (const bf16_t*)(p.ws + OFF_P);
  for (int it = 0; it < 12; ++it) {
    const int task = it * 64 + (tid >> 2);
    const int cq = tid & 3;
    const int type = task / 384, rem = task % 384, hr = rem >> 6, tk = rem & 63;
    const int t = tok0 + tk;
    const int pcol = (type ? 1296 : 784) + hr * 64;
    const bf16_t* src = P + (size_t)t * PW + pcol;
    const uint4 u1 = *(const uint4*)(src + cq * 8), u2 = *(const uint4*)(src + 32 + cq * 8);
    float a[8], bb[8];
    a[0] = bflo(u1.x); a[1] = bfhi(u1.x); a[2] = bflo(u1.y); a[3] = bfhi(u1.y); a[4] = bflo(u1.z); a[5] = bfhi(u1.z); a[6] = bflo(u1.w); a[7] = bfhi(u1.w);
    bb[0] = bflo(u2.x); bb[1] = bfhi(u2.x); bb[2] = bflo(u2.y); bb[3] = bfhi(u2.y); bb[4] = bflo(u2.z); bb[5] = bfhi(u2.z); bb[6] = bflo(u2.w); bb[7] = bfhi(u2.w);
    float ss = 0.f;
#pragma unroll
    for (int e = 0; e < 8; ++e) ss += a[e] * a[e] + bb[e] * bb[e];
    ss += __shfl_xor(ss, 1);
    ss += __shfl_xor(ss, 2);
    const float rs = rsqrtf(ss * (1.f / 64.f) + EPS);
    const float* gn = (type ? (hr < 4 ? p.wa_qn : p.wa_kn) : (hr < 4 ? p.ga_qn : p.ga_kn)) + l * 64;
    const float qs = hr < 4 ? 0.125f * LOG2E : 1.f;
    float o1[8], o2[8];
#pragma unroll
    for (int e = 0; e < 8; ++e) {
      a[e] = a[e] * rs * gn[cq * 8 + e];
      bb[e] = bb[e] * rs * gn[32 + cq * 8 + e];
    }
    if (!isctx) {
      const int pos = c * 64 + tk - LC;
      const float* rc = (const float*)(p.ws + OFF_ROPEC) + pos * 32 + cq * 8;
      const float* rsn = (const float*)(p.ws + OFF_ROPES) + pos * 32 + cq * 8;
#pragma unroll
      for (int e = 0; e < 8; ++e) {
        const float cs = rc[e], sn = rsn[e];
        o1[e] = (a[e] * cs - bb[e] * sn) * qs;
        o2[e] = (a[e] * sn + bb[e] * cs) * qs;
      }
    } else {
#pragma unroll
      for (int e = 0; e < 8; ++e) { o1[e] = a[e] * qs; o2[e] = bb[e] * qs; }
    }
    bf16_t* dst = hr < 4 ? (bf16_t*)(p.ws + OFF_QA) + ((size_t)type * T + t) * 256 + hr * 64
                         : (bf16_t*)(p.ws + OFF_KA) + ((size_t)type * T + t) * 128 + (hr - 4) * 64;
    *(uint4*)(dst + cq * 8) = uint4{pk(o1[0], o1[1]), pk(o1[2], o1[3]), pk(o1[4], o1[5]), pk(o1[6], o1[7])};
    *(uint4*)(dst + 32 + cq * 8) = uint4{pk(o2[0], o2[1]), pk(o2[2], o2[3]), pk(o2[4], o2[5]), pk(o2[6], o2[7])};
  }
  {
    bf16_t* sT = (bf16_t*)smem;
#pragma unroll 1
    for (int type = 0; type < 2; ++type) {
      const int vcol = (type ? 1296 : 784) + 384;
      __syncthreads();
#pragma unroll
      for (int i = 0; i < 4; ++i) {
        const int q = tid + i * 256, tk = q >> 4, ch = q & 15;
        *(uint4*)(sT + tk * 136 + ch * 8) = *(const uint4*)(P + (size_t)(tok0 + tk) * PW + vcol + ch * 8);
      }
      __syncthreads();
      const int kd = tid & 127, th = tid >> 7;
      bf16_t* dst = (bf16_t*)(p.ws + OFF_VT) + (((size_t)(type * NB + b) * 128 + kd)) * TB + c * 64 + th * 32;
#pragma unroll
      for (int j0 = 0; j0 < 32; j0 += 8) {
        unsigned o[4];
#pragma unroll
        for (int e = 0; e < 4; ++e) {
          const unsigned lo = sT[(th * 32 + j0 + 2 * e) * 136 + kd], hi = sT[(th * 32 + j0 + 2 * e + 1) * 136 + kd];
          o[e] = lo | (hi << 16);
        }
        *(uint4*)(dst + j0) = uint4{o[0], o[1], o[2], o[3]};
      }
    }
  }
  {
    const int g = w, lr = lane & 15, lq = lane >> 4;
    const bf16_t* CS = (const bf16_t*)(p.ws + OFF_CS64);
    const int cl = c - 4;
    if (isctx || cl <= 32) {
#pragma unroll 1
      for (int nh = 0; nh < 2; ++nh) {
      bf16x8 bs[2][2], bd[2][2];
#pragma unroll
      for (int ntl = 0; ntl < 2; ++ntl) {
        const int nt = nh * 2 + ntl;
        const int n1 = cl * 64 + nt * 16 + lr;
        const bool mir = !isctx && n1 >= 1 && n1 <= 2047;
        const bool zero = !isctx && n1 > 2048;
#pragma unroll
        for (int ks = 0; ks < 2; ++ks) {
          const int coff = 1808 + g * 64 + ks * 32 + lq * 8;
          uint4 a = *(const uint4*)(P + (size_t)(tok0 + nt * 16 + lr) * PW + coff);
          uint4 m = {0u, 0u, 0u, 0u};
          if (mir) m = *(const uint4*)(P + (size_t)(b * TB + LC + 4096 - n1) * PW + coff);
          if (zero) a = uint4{0u, 0u, 0u, 0u};
          const unsigned ua[4] = {a.x, a.y, a.z, a.w}, um[4] = {m.x, m.y, m.z, m.w};
          unsigned os[4], od[4];
#pragma unroll
          for (int e = 0; e < 4; ++e) {
            const float a0 = bflo(ua[e]), a1 = bfhi(ua[e]), m0 = bflo(um[e]), m1 = bfhi(um[e]);
            os[e] = pk(a0 + m0, a1 + m1);
            od[e] = pk(a0 - m0, a1 - m1);
          }
          bs[ntl][ks] = __builtin_bit_cast(bf16x8, uint4{os[0], os[1], os[2], os[3]});
          bd[ntl][ks] = __builtin_bit_cast(bf16x8, uint4{od[0], od[1], od[2], od[3]});
        }
      }
#pragma unroll 1
      for (int mt = 0; mt < 8; ++mt) {
        bf16x8 af[2];
#pragma unroll
        for (int ks = 0; ks < 2; ++ks) af[ks] = *(const bf16x8*)(CS + (mt * 16 + lr) * 64 + ks * 32 + lq * 8);
#pragma unroll
        for (int ntl = 0; ntl < 2; ++ntl) {
          const int nt = nh * 2 + ntl;
          f32x4 acc = {0.f, 0.f, 0.f, 0.f};
          const bool sinpart = mt >= 4;
          acc = MFMA16(af[0], (sinpart && !isctx) ? bd[ntl][0] : bs[ntl][0], acc);
          acc = MFMA16(af[1], (sinpart && !isctx) ? bd[ntl][1] : bs[ntl][1], acc);
#pragma unroll
          for (int r = 0; r < 4; ++r) {
            const int k2row = mt * 16 + lq * 4 + r, k2 = k2row & 63, part = k2row >> 6;
            const int tk = c * 64 + nt * 16 + lr;
            if (isctx) ((bf16_t*)(p.ws + OFF_BTFTC))[((size_t)(b * 256 + g * 64 + k2)) * 512 + part * 256 + tk] = f2bf(acc[r]);
            else {
              const int n1 = tk - LC;
              if (part == 0 || n1 < 2048) ((bf16_t*)(p.ws + OFF_BTFT))[((size_t)(b * 256 + g * 64 + k2)) * 4160 + part * 2112 + n1] = f2bf(acc[r]);
            }
          }
        }
      }
      }
    }
  }
}

DI int dn_step(int c, int d) { return c < 4 ? (d ? 3 - c : c) : 4 + (d ? 67 - c : c - 4); }

DI void dnprep_item(const Params& p, int l, int item, char* smem, char* dsm0) {
  const int b = item / (4 * NCH), h = (item / NCH) & 3, c = item % NCH;
  bf16_t* qb = (bf16_t*)smem;
  bf16_t* kb = qb + 64 * 72;
  float* kf = (float*)(smem + 18432);
  float* vf = kf + 4096;
  float* Am = kf;
  int tid_ = ltid();
  const int tid = tid_, lane = tid & 63, w = tid >> 6, lr = lane & 15, lq = lane >> 4;
  const int tok0 = b * TB + c * 64;
  const bool isctx = c < 4;
  const int sbeg = isctx ? b * TB : b * TB + LC, send = isctx ? b * TB + LC : (b + 1) * TB;
  const bf16_t* P = (const bf16_t*)(p.ws + OFF_P);
  const int tau = tid >> 2, cq = tid & 3;
  const int t = tok0 + tau;
  float qv[16], kv[16], vv[16];
  __syncthreads();
#pragma unroll
  for (int part = 0; part < 3; ++part) {
    const int col = part * 256 + h * 64 + cq * 16;
    const float* cw = p.conv_w + (size_t)l * 3 * 768 + col;
    const bool hasp = t - 1 >= sbeg, hasn = t + 1 < send;
    const u32x4 z4 = {0u, 0u, 0u, 0u};
    const u32x4 a1l = *(const u32x4*)(P + (size_t)t * PW + col), a1h = *(const u32x4*)(P + (size_t)t * PW + col + 8);
    u32x4 a0l = z4, a0h = z4, a2l = z4, a2h = z4;
    if (hasp) { a0l = *(const u32x4*)(P + (size_t)(t - 1) * PW + col); a0h = *(const u32x4*)(P + (size_t)(t - 1) * PW + col + 8); }
    if (hasn) { a2l = *(const u32x4*)(P + (size_t)(t + 1) * PW + col); a2h = *(const u32x4*)(P + (size_t)(t + 1) * PW + col + 8); }
#pragma unroll
    for (int e = 0; e < 16; ++e) {
      const unsigned w0 = e < 8 ? a0l[(e & 7) >> 1] : a0h[(e & 7) >> 1];
      const unsigned w1 = e < 8 ? a1l[(e & 7) >> 1] : a1h[(e & 7) >> 1];
      const unsigned w2 = e < 8 ? a2l[(e & 7) >> 1] : a2h[(e & 7) >> 1];
      const float x0 = (e & 1) ? bfhi(w0) : bflo(w0);
      const float x1 = (e & 1) ? bfhi(w1) : bflo(w1);
      const float x2 = (e & 1) ? bfhi(w2) : bflo(w2);
      const float y = x0 * cw[e] + x1 * cw[768 + e] + x2 * cw[1536 + e];
      const float sv = silu_f(y);
      if (part == 0) qv[e] = sv; else if (part == 1) kv[e] = sv; else vv[e] = sv;
    }
    asm volatile("" ::: "memory");
  }
  {
    float sq = 0.f, sk = 0.f;
#pragma unroll
    for (int e = 0; e < 16; ++e) { sq += qv[e] * qv[e]; sk += kv[e] * kv[e]; }
    sq += __shfl_xor(sq, 1); sq += __shfl_xor(sq, 2);
    sk += __shfl_xor(sk, 1); sk += __shfl_xor(sk, 2);
    const float rq = rsqrtf(sq + EPS) * 0.125f, rk = rsqrtf(sk + EPS);
#pragma unroll
    for (int e = 0; e < 16; ++e) { qv[e] *= rq; kv[e] *= rk; }
  }
  float* gl = (float*)(dsm0 + (ltid_full() >> 8) * HALF_SMEM + 18432 + 32768);
  float* bl = gl + 128;
  float* gc = bl + 128;
  float* bd = gc + 128;
  if (tid < 128) {
    const int d = tid >> 6, i = tid & 63, ta = d ? 63 - i : i;
    const bf16_t* pr = P + (size_t)(tok0 + ta) * PW + 768;
    const float a = bf2f(pr[d * 4 + h]), bb = bf2f(pr[8 + d * 4 + h]);
    const float xx = a + p.dt_bias[l * 8 + d * 4 + h];
    const float ex = __expf(xx);
    const float sp = xx > 20.f ? xx : (ex < 0.03f ? ex * (1.f - ex * (0.5f - ex * (1.f / 3.f - 0.25f * ex))) : __logf(1.f + ex));
    float v = -__expf(p.A_log[l * 8 + d * 4 + h]) * sp;
#pragma unroll
    for (int off = 1; off < 64; off <<= 1) {
      const float tq = __shfl_up(v, off);
      if (i >= off) v += tq;
    }
    gc[d * 64 + i] = v;
    bd[d * 64 + i] = 1.f / (1.f + __expf(-bb));
  }
  {
#pragma unroll
    for (int e = 0; e < 16; e += 4) {
      *(uint2*)(qb + tau * 72 + cq * 16 + e) = uint2{pk(qv[e], qv[e + 1]), pk(qv[e + 2], qv[e + 3])};
      *(uint2*)(kb + tau * 72 + cq * 16 + e) = uint2{pk(kv[e], kv[e + 1]), pk(kv[e + 2], kv[e + 3])};
      *(float4*)(kf + tau * 64 + cq * 16 + e) = float4{kv[e], kv[e + 1], kv[e + 2], kv[e + 3]};
      *(float4*)(vf + tau * 64 + cq * 16 + e) = float4{vv[e], vv[e + 1], vv[e + 2], vv[e + 3]};
    }
  }
  __syncthreads();
#pragma unroll
  for (int d = 0; d < 2; ++d) {
    const int i = d ? 63 - tau : tau;
    const int cb = ((b * 4 + h) * 2 + d) * NCH + dn_step(c, d);
    bf16_t* base = (bf16_t*)(p.ws + OFF_DN + (size_t)cb * SZ_CB);
    const float eg = __expf(gc[d * 64 + i]);
    bf16_t* qd = base + 4096 + i * 64;
#pragma unroll
    for (int q4 = 0; q4 < 4; ++q4) {
      const int pos = (cq >> 1) * 32 + q4 * 8 + (cq & 1) * 4;
      *(uint2*)(qd + pos) = uint2{pk(qv[q4 * 4] * eg, qv[q4 * 4 + 1] * eg), pk(qv[q4 * 4 + 2] * eg, qv[q4 * 4 + 3] * eg)};
    }
  }
#pragma unroll
  for (int d = 0; d < 2; ++d) {
    const int cb = ((b * 4 + h) * 2 + d) * NCH + dn_step(c, d);
    bf16_t* kt = (bf16_t*)(p.ws + OFF_DN + (size_t)cb * SZ_CB) + 3 * 4096 + tau * 64 + cq * 16;
    const float gl63 = gc[d * 64 + 63];
    unsigned o[8];
#pragma unroll
    for (int e2 = 0; e2 < 8; ++e2) {
      float vals[2];
#pragma unroll
      for (int hq = 0; hq < 2; ++hq) {
        const int e = e2 * 2 + hq;
        const int i = (2 * (cq >> 1) + ((e >> 2) & 1)) * 16 + ((((cq & 1) << 1) | (e >> 3)) << 2) + (e & 3);
        const int ta = d ? 63 - i : i;
        vals[hq] = kf[ta * 64 + tau] * __expf(gl63 - gc[d * 64 + i]);
      }
      o[e2] = pk(vals[0], vals[1]);
    }
    *(uint4*)kt = uint4{o[0], o[1], o[2], o[3]};
    *(uint4*)(kt + 8) = uint4{o[4], o[5], o[6], o[7]};
  }
  if (tid < 128) {
    const int d = tid >> 6;
    const int cb = ((b * 4 + h) * 2 + d) * NCH + dn_step(c, d);
    ((float*)(p.ws + OFF_GEND))[(size_t)cb * 64 + (tid & 63)] = __expf(gc[d * 64 + 63]);
  }
  f32x4 KK[4], QK[4];
  {
    bf16x8 ak[2], aq[2];
#pragma unroll
    for (int ks = 0; ks < 2; ++ks) {
      ak[ks] = *(const bf16x8*)(kb + (w * 16 + lr) * 72 + ks * 32 + lq * 8);
      aq[ks] = *(const bf16x8*)(qb + (w * 16 + lr) * 72 + ks * 32 + lq * 8);
    }
#pragma unroll
    for (int nt = 0; nt < 4; ++nt) {
      KK[nt] = f32x4{0.f, 0.f, 0.f, 0.f};
      QK[nt] = f32x4{0.f, 0.f, 0.f, 0.f};
#pragma unroll
      for (int ks = 0; ks < 2; ++ks) {
        const bf16x8 bk = *(const bf16x8*)(kb + (nt * 16 + lr) * 72 + ks * 32 + lq * 8);
        KK[nt] = MFMA16(ak[ks], bk, KK[nt]);
        QK[nt] = MFMA16(aq[ks], bk, QK[nt]);
      }
    }
  }
  const int sd = w >> 1, half = w & 1;
  float xs[64];
#pragma unroll
  for (int i = 0; i < 64; ++i) {
    const int ta = sd ? 63 - i : i;
    const float bt = bd[sd * 64 + i];
    xs[i] = half ? kf[ta * 64 + lane] * bt * __expf(gc[sd * 64 + i]) : vf[ta * 64 + lane] * bt;
    if ((i & 7) == 7) asm volatile("" ::: "memory");
  }
  __syncthreads();
#pragma unroll
  for (int d = 0; d < 2; ++d) {
    const int cb = ((b * 4 + h) * 2 + d) * NCH + dn_step(c, d);
    bf16_t* inb = (bf16_t*)(p.ws + OFF_DN + (size_t)cb * SZ_CB) + 2 * 4096;
#pragma unroll
    for (int nt = 0; nt < 4; ++nt)
#pragma unroll
      for (int r = 0; r < 4; ++r) {
        const int ti = w * 16 + lq * 4 + r, tj = nt * 16 + lr;
        const int i = d ? 63 - ti : ti, j = d ? 63 - tj : tj;
        const float dec = (i >= j) ? __expf(gc[d * 64 + i] - gc[d * 64 + j]) : 0.f;
        Am[d * 4096 + i * 64 + j] = (i > j) ? bd[d * 64 + i] * KK[nt][r] * dec : 0.f;
        inb[i * 64 + permk(j)] = f2bf(QK[nt][r] * dec);
        if (r == 3) asm volatile("" ::: "memory");
      }
  }
  __syncthreads();
  {
    const float* Ad = Am + sd * 4096;
    f32x4 an[16];
    an[0] = *(const f32x4*)(Ad + 1 * 64);
#pragma unroll
    for (int i = 1; i < 64; ++i) {
      f32x4 ac[16];
#pragma unroll
      for (int j4 = 0; j4 <= (i - 1) / 4; ++j4) ac[j4] = an[j4];
      if (i + 1 < 64) {
#pragma unroll
        for (int j4 = 0; j4 <= i / 4; ++j4) an[j4] = *(const f32x4*)(Ad + (i + 1) * 64 + j4 * 4);
      }
      float sacc = xs[i];
#pragma unroll
      for (int j4 = 0; j4 <= (i - 1) / 4; ++j4) {
        sacc -= ac[j4][0] * xs[j4 * 4];
        sacc -= ac[j4][1] * xs[j4 * 4 + 1];
        sacc -= ac[j4][2] * xs[j4 * 4 + 2];
        sacc -= ac[j4][3] * xs[j4 * 4 + 3];
      }
      xs[i] = sacc;
      asm volatile("" ::: "memory");
    }
    const int cb = ((b * 4 + h) * 2 + sd) * NCH + dn_step(c, sd);
    bf16_t* base = (bf16_t*)(p.ws + OFF_DN + (size_t)cb * SZ_CB);
    if (half == 0) {
      bf16_t* U = base + 4 * 4096;
#pragma unroll
      for (int i4 = 0; i4 < 16; ++i4) {
        const int mt = i4 >> 2, q4 = i4 & 3;
        *(uint2*)(U + ((((mt * 4 + (lane >> 4)) * 4 + q4) * 16 + (lane & 15)) << 2)) = uint2{pk(xs[i4 * 4], xs[i4 * 4 + 1]), pk(xs[i4 * 4 + 2], xs[i4 * 4 + 3])};
      }
    } else {
      bf16_t* Wn = base;
      const int pc = permk(lane);
#pragma unroll
      for (int i = 0; i < 64; ++i) Wn[i * 64 + pc] = f2bf(-xs[i]);
    }
  }
}

DI bf16x8 pack8(const f32x4& a, const f32x4& b) {
  uint4 u = {pk(a[0], a[1]), pk(a[2], a[3]), pk(b[0], b[1]), pk(b[2], b[3])};
  return __builtin_bit_cast(bf16x8, u);
}

DI void dnscan_item(const Params& p, int item, LAS char* lb) {
  const int b = item >> 3, h = (item >> 1) & 3, d = item & 1;
  int tid_ = ltid();
  const int lane = tid_ & 63, w = tid_ >> 6, lr = lane & 15, lq = lane >> 4;
  f32x4 S[4];
#pragma unroll
  for (int mt = 0; mt < 4; ++mt) S[mt] = f32x4{0.f, 0.f, 0.f, 0.f};
  const int cb0 = ((b * 4 + h) * 2 + d) * NCH;
  unsigned pfacc = 0u;
  int soff[8];
#pragma unroll
  for (int i = 0; i < 8; ++i) {
    const int j = w * 512 + i * 64 + lane, jj = j & 511, row = jj >> 3, ch = jj & 7;
    soff[i] = (j >> 9) * 4096 + row * 64 + ((ch ^ (row & 7)) << 3);
  }
#define SC_STAGE(buf, step)                                                                                                                   \
  do {                                                                                                                                        \
    const bf16_t* gb_ = (const bf16_t*)(p.ws + OFF_DN + (size_t)(cb0 + (step)) * SZ_CB);                                                       \
    _Pragma("unroll") for (int i = 0; i < 8; ++i)                                                                                             \
      __builtin_amdgcn_global_load_lds((const unsigned*)(gb_ + soff[i]), (LAS unsigned*)(lb + (buf) * 32768 + (w * 512 + i * 64) * 16), 16, 0, 0); \
  } while (0)
  int foff[4][2];
#pragma unroll
  for (int mt = 0; mt < 4; ++mt)
#pragma unroll
    for (int ks = 0; ks < 2; ++ks) { const int row = mt * 16 + lr; foff[mt][ks] = row * 128 + (((ks * 4 + lq) ^ (row & 7)) << 4); }
  SC_STAGE(0, 0);
  uint2 uu[4];
  float ge;
  {
    const bf16_t* base = (const bf16_t*)(p.ws + OFF_DN + (size_t)cb0 * SZ_CB);
#pragma unroll
    for (int mt = 0; mt < 4; ++mt) uu[mt] = *(const uint2*)(base + 4 * 4096 + ((((mt * 4 + w) * 4 + lq) * 16 + lr) << 2));
    ge = ((const float*)(p.ws + OFF_GEND))[(size_t)cb0 * 64 + lane];
  }
  WAIT_V(0);
#pragma unroll 1
  for (int s = 0; s < NCH; ++s) {
    WAIT_V(8);
    __syncthreads();
    if (s + 1 < NCH) SC_STAGE((s + 1) & 1, s + 1);
    uint2 un[4] = {uu[0], uu[1], uu[2], uu[3]};
    float gn = ge;
    if (s + 1 < NCH) {
      const bf16_t* nb = (const bf16_t*)(p.ws + OFF_DN + (size_t)(cb0 + s + 1) * SZ_CB);
#pragma unroll
      for (int mt = 0; mt < 4; ++mt) un[mt] = *(const uint2*)(nb + 4 * 4096 + ((((mt * 4 + w) * 4 + lq) * 16 + lr) << 2));
      gn = ((const float*)(p.ws + OFF_GEND))[(size_t)(cb0 + s + 1) * 64 + lane];
    }
    unsigned pf0 = 0u, pf1 = 0u;
    if (s + 2 < NCH) {
      const unsigned* nb = (const unsigned*)(p.ws + OFF_DN + (size_t)(cb0 + s + 2) * SZ_CB);
      pf0 = nb[(w * 80 + lane) * 32];
      if (lane < 16) pf1 = nb[(w * 80 + 64 + lane) * 32];
    }
    const LAS char* sb = lb + (s & 1) * 32768;
    bf16x8 sB[2];
    sB[0] = pack8(S[0], S[1]);
    sB[1] = pack8(S[2], S[3]);
    f32x4 vn[4], o[4];
#pragma unroll
    for (int mt = 0; mt < 4; ++mt) {
      vn[mt] = f32x4{bflo(uu[mt].x), bfhi(uu[mt].x), bflo(uu[mt].y), bfhi(uu[mt].y)};
      o[mt] = f32x4{0.f, 0.f, 0.f, 0.f};
#pragma unroll
      for (int ks = 0; ks < 2; ++ks) {
        const bf16x8 aw = *(const LAS bf16x8*)(sb + foff[mt][ks]);
        const bf16x8 aq = *(const LAS bf16x8*)(sb + 8192 + foff[mt][ks]);
        vn[mt] = MFMA16(aw, sB[ks], vn[mt]);
        o[mt] = MFMA16(aq, sB[ks], o[mt]);
      }
    }
    bf16x8 vB[2];
    vB[0] = pack8(vn[0], vn[1]);
    vB[1] = pack8(vn[2], vn[3]);
#pragma unroll
    for (int mt = 0; mt < 4; ++mt) {
#pragma unroll
      for (int r = 0; r < 4; ++r) S[mt][r] *= ge;
#pragma unroll
      for (int ks = 0; ks < 2; ++ks) {
        const bf16x8 ai = *(const LAS bf16x8*)(sb + 16384 + foff[mt][ks]);
        const bf16x8 ak = *(const LAS bf16x8*)(sb + 24576 + foff[mt][ks]);
        o[mt] = MFMA16(ai, vB[ks], o[mt]);
        S[mt] = MFMA16(ak, vB[ks], S[mt]);
      }
    }
    pfacc ^= pf0 ^ pf1;
#pragma unroll
    for (int mt = 0; mt < 4; ++mt) uu[mt] = un[mt];
    ge = gn;
    int dl = d;
    asm volatile("" : "+v"(dl));
    float* Od = (float*)(p.ws + OFF_ODN) + (size_t)dl * T * 256;
    const int c = s < 4 ? (d ? 3 - s : s) : 4 + (d ? 67 - s : s - 4);
#pragma unroll
    for (int mt = 0; mt < 4; ++mt)
#pragma unroll
      for (int r = 0; r < 4; ++r) {
        const int i = mt * 16 + lq * 4 + r;
        const int ta = d ? 63 - i : i;
        Od[((size_t)(b * TB + c * 64 + ta)) * 256 + h * 64 + w * 16 + lr] = o[mt][r];
      }
  }
#undef SC_STAGE
  __syncthreads();
  if (pfacc == 0x9e3779b9u && ((const float*)(p.ws + OFF_GEND))[0] == 123.456f) ((float*)(p.ws + OFF_ODN))[0] = 0.f;
}

DI void attn_item(const Params& p, int l, int type, int b, int kvh, int qb, char* smem) {
  constexpr int KB = 64 * 64 * 2, VB = 64 * 72 * 2, SB = KB + VB;
  int tid_ = ltid();
  const int tid = tid_, lane = tid & 63, w = tid >> 6, lr = lane & 15, lq = lane >> 4;
  const int g = w >> 1, qh = kvh * 2 + g;
  const int qloc0 = qb * 64 + (w & 1) * 32;
  const bool isctx = qb < 4;
  const bf16_t* Qa = (const bf16_t*)(p.ws + OFF_QA) + ((size_t)type * T + (size_t)b * TB) * 256 + qh * 64;
  const bf16_t* Kg = (const bf16_t*)(p.ws + OFF_KA) + ((size_t)type * T + (size_t)b * TB) * 128 + kvh * 64;
  const bf16_t* Vg = (const bf16_t*)(p.ws + OFF_VT) + ((size_t)(type * NB + b) * 128 + kvh * 64) * TB;
  bf16x8 qf[2][2];
#pragma unroll
  for (int nt = 0; nt < 2; ++nt)
#pragma unroll
    for (int ks = 0; ks < 2; ++ks) qf[nt][ks] = *(const bf16x8*)(Qa + (size_t)(qloc0 + nt * 16 + lr) * 256 + ks * 32 + lq * 8);
  float neg_big;
  asm volatile("v_mov_b32 %0, 0xf149f2ca" : "=v"(neg_big));
  float mrun[2];
  f32x4 O[4][2], Ls[2];
  const bf16x8 ones8 = {(short)0x3F80, (short)0x3F80, (short)0x3F80, (short)0x3F80, (short)0x3F80, (short)0x3F80, (short)0x3F80, (short)0x3F80};
#pragma unroll
  for (int nt = 0; nt < 2; ++nt) {
    if (type == 1) { mrun[nt] = p.wa_sink[l * 4 + qh] * LOG2E; Ls[nt] = f32x4{1.f, 1.f, 1.f, 1.f}; }
    else { mrun[nt] = neg_big; Ls[nt] = f32x4{0.f, 0.f, 0.f, 0.f}; }
#pragma unroll
    for (int mt = 0; mt < 4; ++mt) O[mt][nt] = f32x4{0.f, 0.f, 0.f, 0.f};
  }
  const int n_lat_lo = (!isctx && type == 1) ? qb - 2 : 4;
  const int ntiles = isctx ? 4 : (type == 0 ? NCH : 9);
  const int lrow = tid >> 3, lch = tid & 7;
  u32x4 rk[2], rv[2];
#pragma unroll
  for (int i = 0; i < 2; ++i) {
    rk[i] = *(const u32x4*)(Kg + (size_t)(lrow + i * 32) * 128 + lch * 8);
    rv[i] = *(const u32x4*)(Vg + (size_t)(lrow + i * 32) * TB + lch * 8);
  }
#pragma unroll
  for (int i = 0; i < 2; ++i) {
    const int r = lrow + i * 32;
    *(u32x4*)(smem + r * 128 + ((lch ^ (r & 7)) << 4)) = rk[i];
    *(u32x4*)(smem + KB + r * 144 + lch * 16) = rv[i];
  }
  __syncthreads();
  for (int ti = 0; ti < ntiles; ++ti) {
    const int jraw = ti < 4 ? ti : n_lat_lo + (ti - 4);
    const bool tvalid = ti < 4 || (jraw >= 4 && jraw < NCH);
    const int jt = ti < 4 ? ti : (jraw < 4 ? 4 : (jraw > NCH - 1 ? NCH - 1 : jraw));
    const char* sK = smem + (ti & 1) * SB;
    const char* sV = sK + KB;
    if (ti + 1 < ntiles) {
      const int jn0 = (ti + 1) < 4 ? ti + 1 : n_lat_lo + (ti + 1 - 4);
      const int jn = (ti + 1) < 4 ? jn0 : (jn0 < 4 ? 4 : (jn0 > NCH - 1 ? NCH - 1 : jn0));
#pragma unroll
      for (int i = 0; i < 2; ++i) {
        rk[i] = *(const u32x4*)(Kg + (size_t)(jn * 64 + lrow + i * 32) * 128 + lch * 8);
        rv[i] = *(const u32x4*)(Vg + (size_t)(lrow + i * 32) * TB + jn * 64 + lch * 8);
      }
    }
    f32x4 sc[4][2];
#pragma unroll
    for (int mt = 0; mt < 4; ++mt) {
      const int r = mt * 16 + lr;
      const bf16x8 kf0 = *(const bf16x8*)(sK + r * 128 + ((lq ^ (r & 7)) << 4));
      const bf16x8 kf1 = *(const bf16x8*)(sK + r * 128 + (((4 + lq) ^ (r & 7)) << 4));
#pragma unroll
      for (int nt = 0; nt < 2; ++nt) {
        f32x4 a = {0.f, 0.f, 0.f, 0.f};
        a = MFMA16(kf0, qf[nt][0], a);
        a = MFMA16(kf1, qf[nt][1], a);
        sc[mt][nt] = a;
      }
    }
    const bool domask = (type == 1) && !isctx && (jt >= 4);
#pragma unroll
    for (int nt = 0; nt < 2; ++nt) {
      if (domask) {
#pragma unroll
        for (int mt = 0; mt < 4; ++mt)
#pragma unroll
          for (int r = 0; r < 4; ++r) {
            const int kpos = jt * 64 + mt * 16 + lq * 4 + r, qpos = qloc0 + nt * 16 + lr;
            const int df = qpos - kpos;
            if (df > 128 || df < -128 || !tvalid) sc[mt][nt][r] = neg_big;
          }
      }
      float mx = fmaxf(fmaxf(sc[0][nt][0], sc[0][nt][1]), fmaxf(sc[0][nt][2], sc[0][nt][3]));
#pragma unroll
      for (int mt = 1; mt < 4; ++mt) mx = fmaxf(mx, fmaxf(fmaxf(sc[mt][nt][0], sc[mt][nt][1]), fmaxf(sc[mt][nt][2], sc[mt][nt][3])));
      mx = fmaxf(mx, __shfl_xor(mx, 16));
      mx = fmaxf(mx, __shfl_xor(mx, 32));
      if (__builtin_amdgcn_ballot_w64(mx > mrun[nt] + 8.f) != 0ull) {
        const float mnew = fmaxf(mrun[nt], mx);
        const float alpha = __builtin_amdgcn_exp2f(mrun[nt] - mnew);
        mrun[nt] = mnew;
#pragma unroll
        for (int r = 0; r < 4; ++r) Ls[nt][r] *= alpha;
#pragma unroll
        for (int mt = 0; mt < 4; ++mt)
#pragma unroll
          for (int r = 0; r < 4; ++r) O[mt][nt][r] *= alpha;
      }
      const float mref = mrun[nt];
#pragma unroll
      for (int mt = 0; mt < 4; ++mt)
#pragma unroll
        for (int r = 0; r < 4; ++r) sc[mt][nt][r] = __builtin_amdgcn_exp2f(sc[mt][nt][r] - mref);
    }
    bf16x8 pB[2][2];
#pragma unroll
    for (int nt = 0; nt < 2; ++nt) {
      pB[nt][0] = pack8(sc[0][nt], sc[1][nt]);
      pB[nt][1] = pack8(sc[2][nt], sc[3][nt]);
      Ls[nt] = MFMA16(ones8, pB[nt][0], Ls[nt]);
      Ls[nt] = MFMA16(ones8, pB[nt][1], Ls[nt]);
    }
#pragma unroll
    for (int mt = 0; mt < 4; ++mt)
#pragma unroll
      for (int ks = 0; ks < 2; ++ks) {
        const bf16x4 v0 = *(const bf16x4*)(sV + (mt * 16 + lr) * 144 + ((2 * ks) * 16 + lq * 4) * 2);
        const bf16x4 v1 = *(const bf16x4*)(sV + (mt * 16 + lr) * 144 + ((2 * ks + 1) * 16 + lq * 4) * 2);
        const bf16x8 vfr = __builtin_shufflevector(v0, v1, 0, 1, 2, 3, 4, 5, 6, 7);
#pragma unroll
        for (int nt = 0; nt < 2; ++nt) O[mt][nt] = MFMA16(vfr, pB[nt][ks], O[mt][nt]);
      }
    if (ti + 1 < ntiles) {
      char* dK = smem + ((ti + 1) & 1) * SB;
#pragma unroll
      for (int i = 0; i < 2; ++i) {
        const int r = lrow + i * 32;
        *(u32x4*)(dK + r * 128 + ((lch ^ (r & 7)) << 4)) = rk[i];
        *(u32x4*)(dK + KB + r * 144 + lch * 16) = rv[i];
      }
    }
    __syncthreads();
  }
  bf16_t* Y = (bf16_t*)(p.ws + OFF_YMIX);
#pragma unroll
  for (int nt = 0; nt < 2; ++nt) {
    const float inv = 1.f / Ls[nt][0];
    const size_t row = (size_t)b * TB + qloc0 + nt * 16 + lr;
#pragma unroll
    for (int mt = 0; mt < 4; ++mt) {
      uint2 v = {pk(O[mt][nt][0] * inv, O[mt][nt][1] * inv), pk(O[mt][nt][2] * inv, O[mt][nt][3] * inv)};
      *(uint2*)(Y + row * 1024 + (type ? 512 : 256) + qh * 64 + mt * 16 + lq * 4) = v;
    }
  }
}

DI void dnmerge_item(const Params& p, int l, int item) {
  const int tid = ltid();
  const int w = tid >> 6, lane = tid & 63;
  const int t = item * 4 + w;
  const float* o0 = (const float*)(p.ws + OFF_ODN) + (size_t)t * 256 + lane * 4;
  const float* o1 = o0 + (size_t)T * 256;
  const float4 a = *(const float4*)o0, bq = *(const float4*)o1;
  float v[4] = {a.x + bq.x, a.y + bq.y, a.z + bq.z, a.w + bq.w};
  float ss = v[0] * v[0] + v[1] * v[1] + v[2] * v[2] + v[3] * v[3];
  ss += __shfl_xor(ss, 1); ss += __shfl_xor(ss, 2); ss += __shfl_xor(ss, 4); ss += __shfl_xor(ss, 8);
  const float rs = rsqrtf(ss * (1.f / 64.f) + EPS);
  const int dim = (lane & 15) * 4;
  const float4 gn = *(const float4*)(p.dn_norm_g + l * 64 + dim);
  const uint2 zz = *(const uint2*)((const bf16_t*)(p.ws + OFF_Z) + (size_t)t * 256 + lane * 4);
  const float z0 = bflo(zz.x), z1 = bfhi(zz.x), z2 = bflo(zz.y), z3 = bfhi(zz.y);
  const float y0 = v[0] * rs * gn.x * silu_f(z0), y1 = v[1] * rs * gn.y * silu_f(z1), y2 = v[2] * rs * gn.z * silu_f(z2), y3 = v[3] * rs * gn.w * silu_f(z3);
  *(uint2*)((bf16_t*)(p.ws + OFF_YMIX) + (size_t)t * 1024 + lane * 4) = uint2{pk(y0, y1), pk(y2, y3)};
  if (lane == 0) { ((float*)(p.ws + OFF_RSS1))[t] = 0.f; ((float*)(p.ws + OFF_RSS2))[t] = 0.f; }
}


#define XB_TMO      128
#define XB_XCNT(j)  (256  + 64 * (j))
#define XB_XSUB(j)  (1280 + 64 * (j))
#define XB_XGEN(j)  (2304 + 64 * (j))
#define XB_TOP      3328
#define XB_TOPGEN   3392
#define XCD_BAR_WORDS 3456
#define XB_SPIN_CAP (1u << 18)
DI unsigned xb_ld(unsigned* p) { return __hip_atomic_load(p, __ATOMIC_RELAXED, __HIP_MEMORY_SCOPE_AGENT); }
DI unsigned xb_add(unsigned* p, unsigned v) { return __hip_atomic_fetch_add(p, v, __ATOMIC_RELAXED, __HIP_MEMORY_SCOPE_AGENT); }
DI unsigned xb_xcc_id() { return (unsigned)__builtin_amdgcn_s_getreg((3 << 11) | 20) & 0xFu; }
#define XB_SPIN(cond, bar) do { unsigned _sp = 0; while (cond) { __builtin_amdgcn_s_sleep(1); \
    if ((++_sp & 255u) == 0u) { if (xb_ld(&(bar)[XB_TMO])) break; if (_sp > XB_SPIN_CAP) { atomicAdd(&(bar)[XB_TMO], 1u); break; } } } } while (0)
struct XcdBarrier { unsigned* bar; unsigned x; volatile LAS unsigned* st; };
DI XcdBarrier xcd_barrier_post(unsigned* bar, volatile LAS unsigned* st) {
  XcdBarrier b; b.bar = bar; b.x = xb_xcc_id(); b.st = st;
  if (threadIdx.x == 0) (void)xb_add(&bar[XB_XCNT(b.x)], 1u);
  return b;
}
DI void xcd_barrier_complete(unsigned* bar, unsigned x, unsigned& nloc, unsigned& nx) {
  const unsigned G = gridDim.x * gridDim.y * gridDim.z;
  unsigned sum, cnt, mine, sp = 0u;
  for (;;) {
    sum = 0u; cnt = 0u; mine = 0u;
#pragma unroll
    for (unsigned j = 0; j < 16; ++j) { const unsigned c = xb_ld(&bar[XB_XCNT(j)]); sum += c; cnt += (c > 0u) ? 1u : 0u; mine = (j == x) ? c : mine; }
    if (sum == G) break;
    __builtin_amdgcn_s_sleep(1);
    if ((++sp & 255u) == 0u) { if (xb_ld(&bar[XB_TMO])) break; if (sp > XB_SPIN_CAP) { atomicAdd(&bar[XB_TMO], 1u); break; } }
  }
  nloc = mine > 0u ? mine : 1u; nx = cnt > 0u ? cnt : 1u;
}
DI void xcd_barrier(const XcdBarrier& b) {
  asm volatile("s_waitcnt vmcnt(0)" ::: "memory");
  __syncthreads();
  if (ltid_full() == 0) {
    unsigned* bar = b.bar;
    asm volatile("" : "+s"(bar));
    __builtin_amdgcn_s_waitcnt(0);
    unsigned nloc = b.st[0], nx = b.st[1];
    if (nloc == 0u) { xcd_barrier_complete(bar, b.x, nloc, nx); b.st[0] = nloc; b.st[1] = nx; }
    const unsigned old = xb_add(&bar[XB_XSUB(b.x)], 1u);
    const unsigned gen = old / nloc;
    if (old + 1u == (gen + 1u) * nloc) {
      __builtin_amdgcn_fence(__ATOMIC_RELEASE, "agent");
      asm volatile("s_waitcnt vmcnt(0)" ::: "memory");
      const unsigned og = xb_add(&bar[XB_TOP], 1u);
      const unsigned tg = og / nx;
      if (og + 1u == (tg + 1u) * nx) xb_add(&bar[XB_TOPGEN], 1u);
      else XB_SPIN(xb_ld(&bar[XB_TOPGEN]) == tg, bar);
      __builtin_amdgcn_fence(__ATOMIC_ACQUIRE, "agent");
      xb_add(&bar[XB_XGEN(b.x)], 1u);
      asm volatile("s_waitcnt vmcnt(0)" ::: "memory");
    } else {
      XB_SPIN(xb_ld(&bar[XB_XGEN(b.x)]) == gen, bar);
      __builtin_amdgcn_fence(__ATOMIC_ACQUIRE, "agent");
      asm volatile("s_waitcnt vmcnt(0)" ::: "memory");
    }
  }
  __syncthreads();
}


DI Params load_params(const volatile LAS unsigned* sp) {
  Params q;
  unsigned long long* dst = (unsigned long long*)&q;
#pragma unroll
  for (int i = 0; i < (int)(sizeof(Params) / 8); ++i) {
    const unsigned lo = (unsigned)__builtin_amdgcn_readfirstlane((int)sp[2 * i]), hi = (unsigned)__builtin_amdgcn_readfirstlane((int)sp[2 * i + 1]);
    dst[i] = ((unsigned long long)hi << 32) | lo;
  }
  return q;
}
#define GSYNC() do { XcdBarrier xb_; xb_.bar = (unsigned*)(q.ws + OFF_BAR); xb_.x = xb_xcc_id(); xb_.st = (volatile LAS unsigned*)&xb_words; xcd_barrier(xb_); } while (0)
__global__ void __launch_bounds__(512, 2) mega(Params p) {
  extern __shared__ __attribute__((aligned(1024))) char dsm[];
  __shared__ uint4 xb_words;
  __shared__ int s_item;
  cg::grid_group grid = cg::this_grid();
  __shared__ unsigned sparams[sizeof(Params) / 4];
  if (threadIdx.x == 0) xb_words = make_uint4(0u, 0u, 0u, 0u);
  if (threadIdx.x < sizeof(Params) / 4) sparams[threadIdx.x] = ((const unsigned*)&p)[threadIdx.x];
  __syncthreads();
  (void)xcd_barrier_post((unsigned*)(p.ws + OFF_BAR), (volatile LAS unsigned*)&xb_words);
  const int nblk = gridDim.x, bid = blockIdx.x;
  LAS char* lds = (LAS char*)dsm;
  phase0(p, dsm);
#if EXP == 6
  __syncthreads();
  phase0(p, dsm);
#endif
  grid.sync();
  for (int l = 0; l < 4; ++l) {
    Params q = load_params((const volatile LAS unsigned*)sparams);
#define RELAUNDER() q = load_params((const volatile LAS unsigned*)sparams)
#define Hb ((const bf16_t*)(q.ws + OFF_HB))
    RELAUNDER();
    if (l == 0) {
      { const int hf = ltid_full() >> 8; char* smem = dsm + hf * HALF_SMEM; (void)smem;
      for (int pi = bid; pi < (T / 4 + 16 * 40) / 2; pi += nblk) {
        const int it = pi * 2 + hf;
        if (it < T / 4) norm_item(q, it);
        else { const int j = it - T / 4; wconv_tile<true>(q.w_in, nullptr, 2320, 1024, (bf16_t*)(q.ws + OFF_WIN), 0, j % 16, j / 16, smem, (const float*)(q.ws + OFF_MOD), (float*)(q.ws + OFF_BIAS1), 2560); }
      }
      }
      GSYNC();
    }
    RELAUNDER();
    gemm_phase8<EP_P>(q, l, Hb, (const bf16_t*)(q.ws + OFF_WIN), 1024, 136, 10, lds, 2);
#if EXP == 1
    gemm_phase<EP_P>(q, l, Hb, 1024, (const bf16_t*)(q.ws + OFF_WIN), 1024, 1024, 136, 10, lds);
#endif
    GSYNC();
    RELAUNDER();
    { const int hf = ltid_full() >> 8; char* smem = dsm + hf * HALF_SMEM; (void)smem;
#if EXP == 3
    for (int rep = 0; rep < 2; ++rep)
#endif
    for (int pi = bid; pi < (NB * 4 * NCH + NB * NCH) / 2; pi += nblk) {
      const int it = pi * 2 + hf;
      if (it < NB * 4 * NCH) dnprep_item(q, l, it, smem, dsm);
      else aprep_item(q, l, it - NB * 4 * NCH, smem);
    }
    }
    GSYNC();
    RELAUNDER();
    {
    {
#if EXP == 2
      for (int rep = 0; rep < 2; ++rep) {
      int* ctr = (int*)(q.ws + OFF_CTR) + l + rep * 8;
#else
      {
      int* ctr = (int*)(q.ws + OFF_CTR) + l;
#endif
      constexpr int N_SCAN = 32, N_FT = 128, N_FTC = 8, N_GA = 512, N_WA = 512, N_CTXA = 64;
      constexpr int N_WO = 16 * 16 / 2, N_GU = 16 * 88 / 2, N_WD = 44 * 16 / 2, N_WI = 16 * 40 / 2;
      const int n_ctxa = l < 3 ? N_CTXA : 0;
      const int TOT = N_SCAN + N_FT + N_FTC + N_GA + N_WA + n_ctxa + N_WO + N_GU + N_WD + (l < 3 ? N_WI : 0);
      while (true) {
        __syncthreads();
        if (ltid_full() == 0) s_item = atomicAdd(ctr, 1);
        __syncthreads();
        int it = s_item;
        if (it >= TOT) break;
        const int hf = ltid_full() >> 8; char* smem = dsm + hf * HALF_SMEM;
        if (it < N_SCAN) { dnscan_item(q, it * 2 + hf, lds + hf * 65536); continue; }
        it -= N_SCAN;
        if (it < N_FT) { gemm8<EP_FT>(q, l, (const bf16_t*)(q.ws + OFF_ADFT), 4160, (const bf16_t*)(q.ws + OFF_BTFT), 4160, 4160, (it >> 3) * 256, (it & 7) * 256, lds); continue; }
        it -= N_FT;
        if (it < N_FTC) { gemm8<EP_FTC>(q, l, (const bf16_t*)(q.ws + OFF_ADFTC), 512, (const bf16_t*)(q.ws + OFF_BTFTC), 512, 512, 0, it * 256, lds); continue; }
        it -= N_FTC;
        if (it < N_GA) { const int j = it * 2 + hf; attn_item(q, l, 0, j >> 7, (j >> 6) & 1, 4 + (j & 63), smem); continue; }
        it -= N_GA;
        if (it < N_WA) { const int j = it * 2 + hf; attn_item(q, l, 1, j >> 7, (j >> 6) & 1, 4 + (j & 63), smem); continue; }
        it -= N_WA;
        if (it < n_ctxa) { const int j = it * 2 + hf; const int type = j >> 6, r = j & 63; attn_item(q, l, type, r >> 3, (r >> 2) & 1, r & 3, smem); continue; }
        it -= n_ctxa;
        {
          int j = it * 2 + hf;
          if (j < 2 * N_WO) { wconv_tile<false>(q.w_out + (size_t)l * 1024 * 1024, nullptr, 1024, 1024, (bf16_t*)(q.ws + OFF_WOUT), 0, j % 16, j / 16, smem); continue; }
          j -= 2 * N_WO;
          if (j < 2 * N_GU) { wconv_tile<true>(q.w_gate + (size_t)l * 1024 * HID, q.w_up + (size_t)l * 1024 * HID, HID, 1024, (bf16_t*)(q.ws + OFF_WGU), 1, j % 16, j / 16, smem,
                                     (const float*)(q.ws + OFF_MOD) + (size_t)l * 9 * 6144 + 3072, (float*)(q.ws + OFF_BIAS2) + (size_t)l * 9 * 5632, 5632); continue; }
          j -= 2 * N_GU;
          if (j < 2 * N_WD) { wconv_tile<false>(q.w_down + (size_t)l * HID * 1024, nullptr, 1024, HID, (bf16_t*)(q.ws + OFF_WD), 0, j % 44, j / 44, smem); continue; }
          j -= 2 * N_WD;
          wconv_tile<true>(q.w_in + (size_t)(l + 1) * 1024 * 2320, nullptr, 2320, 1024, (bf16_t*)(q.ws + OFF_WIN), 0, j % 16, j / 16, smem,
                           (const float*)(q.ws + OFF_MOD) + (size_t)(l + 1) * 9 * 6144, (float*)(q.ws + OFF_BIAS1) + (size_t)(l + 1) * 9 * 2560, 2560);
        }
      }
      }
    }
    }
    GSYNC();
    RELAUNDER();
    { const int hf = ltid_full() >> 8; char* smem = dsm + hf * HALF_SMEM; (void)smem;
    {
      for (int pi = bid; pi < T / 8; pi += nblk) dnmerge_item(q, l, pi * 2 + hf);
    }
    }
    GSYNC();
    RELAUNDER();
#if EXP == 1
    gemm_phase<EP_DUMMY>(q, l, (const bf16_t*)(q.ws + OFF_YMIX), 1024, (const bf16_t*)(q.ws + OFF_WOUT), 1024, 1024, 136, 4, lds);
#endif
    gemm_phase8<EP_RES1>(q, l, (const bf16_t*)(q.ws + OFF_YMIX), (const bf16_t*)(q.ws + OFF_WOUT), 1024, l == 3 ? 128 : 136, 4, lds, l == 3 ? 1 : 2);
    GSYNC();
    RELAUNDER();
    gemm_phase8<EP_GU>(q, l, Hb, (const bf16_t*)(q.ws + OFF_WGU), 1024, l == 3 ? 128 : 136, 22, lds, l == 3 ? 1 : 0);
#if EXP == 1
    gemm_phase<EP_GU>(q, l, Hb, 1024, (const bf16_t*)(q.ws + OFF_WGU), 1024, 1024, l == 3 ? 128 : 136, 22, lds, l == 3);
#endif
    GSYNC();
    RELAUNDER();
#if EXP == 1
    gemm_phase<EP_DUMMY>(q, l, (const bf16_t*)(q.ws + OFF_HM), HID, (const bf16_t*)(q.ws + OFF_WD), HID, HID, 136, 4, lds);
#endif
    gemm_phase8<EP_RES2>(q, l, (const bf16_t*)(q.ws + OFF_HM), (const bf16_t*)(q.ws + OFF_WD), HID, l == 3 ? 128 : 136, 4, lds, l == 3 ? 1 : 2);
    GSYNC();
  }
}

#undef Hb
extern "C" void kernel_launch(void* const* d_in, const int* in_sizes, int n_in, void* d_out, int out_size, void* d_ws, size_t ws_size,
                              hipStream_t stream) {
  if (ws_size < WS_NEED) { fprintf(stderr, "workspace too small: %zu < %zu\n", ws_size, (size_t)WS_NEED); return; }
  static int grid_blocks = 0;
  if (!grid_blocks) {
    int dev = 0, cus = 0, per_cu = 0;
    (void)hipGetDevice(&dev);
    (void)hipDeviceGetAttribute(&cus, hipDeviceAttributeMultiprocessorCount, dev);
    if (hipFuncSetAttribute((const void*)mega, hipFuncAttributeMaxDynamicSharedMemorySize, LDS_BYTES) != hipSuccess) fprintf(stderr, "hipFuncSetAttribute failed\n");
    (void)hipOccupancyMaxActiveBlocksPerMultiprocessor(&per_cu, mega, 512, LDS_BYTES);
    if (per_cu < 1) { fprintf(stderr, "occupancy query returned %d\n", per_cu); per_cu = 1; }
    grid_blocks = (cus / 8) * 8;
  }
  Params p{};
  const float** pf = (const float**)&p;
  for (int i = 0; i < 22; ++i) pf[i] = (const float*)d_in[i];
  p.out = (float*)d_out;
  p.ws = (char*)d_ws;
  (void)hipMemsetAsync((char*)d_ws + OFF_BAR, 0, XCD_BAR_WORDS * 4, stream);
  void* args[] = {&p};
  hipError_t e = hipLaunchCooperativeKernel((void*)mega, dim3(grid_blocks), dim3(512), args, LDS_BYTES, stream);
  if (e != hipSuccess) fprintf(stderr, "cooperative launch failed: %s (grid %d)\n", hipGetErrorString(e), grid_blocks);
}
```

```cpp
#include <hip/hip_runtime.h>
#include <hip/hip_cooperative_groups.h>
#include <stdint.h>
#include <stdio.h>
namespace cg = cooperative_groups;

typedef unsigned short bf16_t;
typedef short bf16x8 __attribute__((ext_vector_type(8)));
typedef short bf16x4 __attribute__((ext_vector_type(4)));
typedef float f32x4 __attribute__((ext_vector_type(4)));
typedef unsigned u32x4 __attribute__((ext_vector_type(4)));
#define DI __device__ __forceinline__
#define MFMA16(a, b, c) __builtin_amdgcn_mfma_f32_16x16x32_bf16((a), (b), (c), 0, 0, 0)

constexpr int NB = 8, SEQ = 4096, LC = 256, TB = 4352, T = NB * TB, DM = 1024, PW = 2064, HID = 2816, NCH = 68;
constexpr int NIN_PAD = 2560;
constexpr float EPS = 1e-6f;
constexpr float LOG2E = 1.4426950408889634f;

constexpr size_t OFF_MOD = 0;
constexpr size_t OFF_ROPEC = 1u << 20;
constexpr size_t OFF_ROPES = OFF_ROPEC + 524288;
constexpr size_t OFF_CS64 = OFF_ROPES + 524288;
constexpr size_t OFF_ADFTC = OFF_CS64 + 16384;
constexpr size_t OFF_CTR = OFF_ADFTC + 262144;
constexpr size_t OFF_BAR = OFF_CTR + 4096;
constexpr size_t OFF_XC = 2621440;
constexpr size_t OFF_HB = OFF_XC + 8388608;
constexpr size_t SZ_HB = (size_t)T * 1024 * 2;
constexpr size_t OFF_QA = OFF_HB;
constexpr size_t OFF_KA = OFF_QA + (size_t)2 * T * 256 * 2;
constexpr size_t OFF_VT = OFF_KA + (size_t)2 * T * 128 * 2;
constexpr size_t OFF_P = OFF_HB + SZ_HB;
constexpr size_t SZ_P = (size_t)T * PW * 2;
constexpr size_t OFF_YMIX = OFF_P;
constexpr size_t OFF_ODN = OFF_P + SZ_HB;
constexpr size_t OFF_Z = OFF_P + SZ_P;
constexpr size_t OFF_BTFT = OFF_Z + (size_t)T * 256 * 2;
constexpr size_t OFF_BTFTC = OFF_BTFT + (size_t)2048 * 8192 * 2;
constexpr size_t OFF_HM = OFF_P;
constexpr size_t OFF_ADFT = OFF_BTFTC + (size_t)2048 * 512 * 2;
constexpr size_t OFF_RSS1 = OFF_ADFT + (size_t)4096 * 4160 * 2;
constexpr size_t OFF_RSS2 = OFF_RSS1 + (size_t)T * 4;
constexpr size_t OFF_BIAS1 = OFF_RSS2 + (size_t)T * 4;
constexpr size_t OFF_BIAS2 = OFF_BIAS1 + (size_t)4 * 9 * 2560 * 4;
constexpr size_t OFF_DN = OFF_ADFT + (size_t)4096 * 8192 * 2;
constexpr size_t SZ_CB = 40960;
constexpr int NCB = NB * 4 * 2 * NCH;
constexpr size_t OFF_GEND = OFF_DN + (size_t)NCB * SZ_CB;
constexpr size_t WS_NEED = OFF_GEND + (size_t)NCB * 64 * 4;
constexpr size_t OFF_WIN = OFF_BIAS2 + (size_t)4 * 9 * 5632 * 4;
constexpr size_t OFF_WOUT = OFF_WIN + (size_t)NIN_PAD * 1024 * 2;
constexpr size_t OFF_WGU = OFF_WOUT + (size_t)1024 * 1024 * 2;
constexpr size_t OFF_WD = OFF_WGU + (size_t)5632 * 1024 * 2;
static_assert(OFF_WD + (size_t)1024 * 2816 * 2 <= OFF_ADFT + (size_t)4096 * 8192 * 2, "weights overflow the ADFT region tail");
static_assert((size_t)T * HID * 2 <= OFF_ADFT - OFF_P, "Hm alias overflow");

struct Params {
  const float *x, *c, *ctx, *c_ctx, *norm1_g, *norm2_g, *w_ada, *b_ada, *w_in, *conv_w, *A_log, *dt_bias, *dn_norm_g,
      *ga_qn, *ga_kn, *wa_qn, *wa_kn, *wa_sink, *w_out, *w_gate, *w_up, *w_down;
  float* out;
  char* ws;
};

constexpr int HALF_SMEM = 53248;
constexpr int LDS_BYTES = 131072 + 8192;
#define LAS __attribute__((address_space(3)))
#define WAIT_V(n) asm volatile("s_waitcnt vmcnt(%0)" ::"n"(n) : "memory")

DI unsigned pk(float a, float b) {
  typedef __bf16 bf2 __attribute__((ext_vector_type(2)));
  typedef float f2 __attribute__((ext_vector_type(2)));
  f2 v = {a, b};
  bf2 r = __builtin_convertvector(v, bf2);
  return __builtin_bit_cast(unsigned, r);
}
DI bf16_t f2bf(float a) { return (bf16_t)(pk(a, 0.f) & 0xffffu); }
DI float bf2f(bf16_t h) { return __uint_as_float(((unsigned)h) << 16); }
DI float bflo(unsigned u) { return __uint_as_float(u << 16); }
DI float bfhi(unsigned u) { return __uint_as_float(u & 0xffff0000u); }
DI int ltid_full() { int t = threadIdx.x; asm volatile("" : "+v"(t)); return t; }
DI int ltid() { return ltid_full() & 255; }
DI float silu_f(float x) { return x * __builtin_amdgcn_rcpf(1.f + __expf(-x)); }
DI int permk(int x) { return ((x >> 5) << 5) + (((x >> 2) & 3) << 3) + (((x >> 4) & 1) << 2) + (x & 3); }

DI float* xrow(const Params& p, int t) {
  int b = t / TB, tb = t - b * TB;
  return tb < LC ? (float*)(p.ws + OFF_XC) + ((size_t)(b * LC + tb)) * DM : p.out + ((size_t)(b * SEQ + tb - LC)) * DM;
}
DI const float* xrow_in(const Params& p, int t) {
  int b = t / TB, tb = t - b * TB;
  return tb < LC ? p.ctx + ((size_t)(b * LC + tb)) * DM : p.x + ((size_t)(b * SEQ + tb - LC)) * DM;
}
DI int bidx_of(int t) { const int b = t / TB, tb = t - b * TB; return tb < LC ? 8 : b; }
DI const float* modrow(const Params& p, int l, int t) {
  int b = t / TB, tb = t - b * TB;
  int bi = tb < LC ? 8 : b;
  return (const float*)(p.ws + OFF_MOD) + ((size_t)(l * 9 + bi)) * 6144;
}

enum { EP_P = 0, EP_RES1 = 1, EP_GU = 2, EP_RES2 = 3, EP_FT = 4, EP_FTC = 5, EP_DUMMY = 6 };
#ifndef EXP
#define EXP 0
#endif

DI int lds_byte(int r, int c) {
  const int st = (r >> 4) * 2 + (c >> 5), ob = (r & 15) * 64 + (c & 31) * 2;
  return st * 1024 + (ob ^ (((ob >> 9) & 1) << 5));
}
DI void stage_rc(int b, int& R, int& C) {
  const int st = b >> 10, sb = b & 1023, swz = sb ^ (((sb >> 9) & 1) << 5);
  R = (st >> 1) * 16 + swz / 64;
  C = (st & 1) * 32 + (swz % 64) / 2;
}

template <int MODE>
DI void gemm_epilogue(const Params& p, int l, const f32x4 (&acc)[8][4], int m0, int n0, int wr, int wc, int fr, int fq, const LAS float* cst) {
#pragma unroll
  for (int i = 0; i < 8; ++i) {
    const int m = m0 + wr * 128 + i * 16 + fr;
    if (MODE == EP_P) {
      bf16_t* Pp = (bf16_t*)(p.ws + OFF_P) + (size_t)m * PW;
      bf16_t* Zp = (bf16_t*)(p.ws + OFF_Z) + (size_t)m * 256;
      const float rs = rsqrtf(cst[wr * 128 + i * 16 + fr] * (1.f / 1024.f) + EPS);
#pragma unroll
      for (int j = 0; j < 4; ++j) {
        const int n = n0 + wc * 64 + j * 16 + fq * 4;
        const f32x4 bq = *(const LAS f32x4*)(cst + 256 + wc * 64 + j * 16 + fq * 4);
        uint2 v = {pk(acc[i][j][0] * rs + bq[0], acc[i][j][1] * rs + bq[1]), pk(acc[i][j][2] * rs + bq[2], acc[i][j][3] * rs + bq[3])};
        if (n < 768) *(uint2*)(Pp + n) = v;
        else if (n < 1024) *(uint2*)(Zp + (n - 768)) = v;
        else if (n < 2320) *(uint2*)(Pp + (n - 256)) = v;
      }
    } else if (MODE == EP_RES1 || MODE == EP_RES2) {
      float* xo = xrow(p, m);
      const bool emit = (MODE == EP_RES1) || (l < 3);
      bf16_t* hb = (bf16_t*)(p.ws + OFF_HB) + (size_t)m * 1024;
      float4 xv[4];
#pragma unroll
      for (int j = 0; j < 4; ++j) xv[j] = *(const float4*)(xo + n0 + wc * 64 + j * 16 + fq * 4);
      float ssq = 0.f;
#pragma unroll
      for (int j = 0; j < 4; ++j) {
        const int n = n0 + wc * 64 + j * 16 + fq * 4;
        const f32x4 gq = *(const LAS f32x4*)(cst + 256 + wc * 64 + j * 16 + fq * 4), mq = *(const LAS f32x4*)(cst + 512 + wc * 64 + j * 16 + fq * 4);
        const float4 gv = {gq[0], gq[1], gq[2], gq[3]}, mv = {mq[0], mq[1], mq[2], mq[3]};
        xv[j].x += gv.x * acc[i][j][0]; xv[j].y += gv.y * acc[i][j][1]; xv[j].z += gv.z * acc[i][j][2]; xv[j].w += gv.w * acc[i][j][3];
        *(float4*)(xo + n) = xv[j];
        if (emit) {
          ssq += xv[j].x * xv[j].x + xv[j].y * xv[j].y + xv[j].z * xv[j].z + xv[j].w * xv[j].w;
          *(uint2*)(hb + n) = uint2{pk(xv[j].x * mv.x, xv[j].y * mv.y), pk(xv[j].z * mv.z, xv[j].w * mv.w)};
        }
      }
      if (emit) {
        ssq += __shfl_xor(ssq, 16);
        ssq += __shfl_xor(ssq, 32);
        if (fq == 0) unsafeAtomicAdd((float*)(p.ws + (MODE == EP_RES1 ? OFF_RSS2 : OFF_RSS1)) + m, ssq);
      }
    } else if (MODE == EP_GU) {
      bf16_t* hp = (bf16_t*)(p.ws + OFF_HM) + (size_t)m * HID;
      const float rs = rsqrtf(cst[wr * 128 + i * 16 + fr] * (1.f / 1024.f) + EPS);
#pragma unroll
      for (int jj = 0; jj < 2; ++jj) {
        const int hcol = ((n0 + wc * 64) >> 1) + jj * 16 + fq * 4;
        const f32x4 bg = *(const LAS f32x4*)(cst + 256 + wc * 64 + (2 * jj) * 16 + fq * 4), bu = *(const LAS f32x4*)(cst + 256 + wc * 64 + (2 * jj + 1) * 16 + fq * 4);
        const float bgv[4] = {bg[0], bg[1], bg[2], bg[3]}, buv[4] = {bu[0], bu[1], bu[2], bu[3]};
        float o[4];
#pragma unroll
        for (int r = 0; r < 4; ++r) o[r] = silu_f(acc[i][2 * jj][r] * rs + bgv[r]) * (acc[i][2 * jj + 1][r] * rs + buv[r]);
        uint2 v = {pk(o[0], o[1]), pk(o[2], o[3])};
        *(uint2*)(hp + hcol) = v;
      }
    } else if (MODE == EP_DUMMY) {
      bf16_t* dp = (bf16_t*)(p.ws + OFF_DN + (size_t)40 * 1024 * 1024) + (size_t)m * 1024;
#pragma unroll
      for (int j = 0; j < 4; ++j) {
        const int n = n0 + wc * 64 + j * 16 + fq * 4;
        *(uint2*)(dp + n) = uint2{pk(acc[i][j][0], acc[i][j][1]), pk(acc[i][j][2], acc[i][j][3])};
      }
    } else {
      bf16_t* Y = (bf16_t*)(p.ws + OFF_YMIX);
      const float scale = (MODE == EP_FT) ? (1.f / 512.f) : (1.f / 128.f);
#pragma unroll
      for (int j = 0; j < 4; ++j) {
        const int n = n0 + wc * 64 + j * 16 + fq * 4;
        const int b = n >> 8;
        const size_t row = (size_t)b * TB + (MODE == EP_FT ? LC : 0) + m;
        uint2 v = {pk(acc[i][j][0] * scale, acc[i][j][1] * scale), pk(acc[i][j][2] * scale, acc[i][j][3] * scale)};
        *(uint2*)(Y + row * 1024 + 768 + (n & 255)) = v;
      }
    }
  }
}

constexpr int G8_TILE_B = 256 * 64 * 2, G8_STAGE_B = 2 * G8_TILE_B;
#define G8_STAGE(Ab_, Bb_, buf, kt)                                                                                                            \
  do {                                                                                                                                        \
    _Pragma("unroll") for (int i = 0; i < 4; ++i) {                                                                                           \
      __builtin_amdgcn_global_load_lds((const unsigned*)((Ab_) + offA[i] + (kt) * 64), (LAS unsigned*)(lds + (buf) * G8_STAGE_B + wid * 1024 + i * 8192), 16, 0, 0);               \
      __builtin_amdgcn_global_load_lds((const unsigned*)((Bb_) + offB[i] + (kt) * 64), (LAS unsigned*)(lds + (buf) * G8_STAGE_B + G8_TILE_B + wid * 1024 + i * 8192), 16, 0, 0);   \
    }                                                                                                                                         \
  } while (0)
#define G8_COMPUTE(buf)                                                                                                                       \
  do {                                                                                                                                        \
    const LAS char* sa = lds + (buf) * G8_STAGE_B;                                                                                            \
    const LAS char* sb = sa + G8_TILE_B;                                                                                                      \
    _Pragma("unroll") for (int ks = 0; ks < 2; ++ks) {                                                                                        \
      bf16x8 bfr[4];                                                                                                                          \
      _Pragma("unroll") for (int j = 0; j < 4; ++j) bfr[j] = *(const LAS bf16x8*)(sb + lds_byte(wc * 64 + j * 16 + fr, ks * 32 + fq * 8));    \
      bf16x8 a_cur = *(const LAS bf16x8*)(sa + lds_byte(wr * 128 + fr, ks * 32 + fq * 8));                                                    \
      _Pragma("unroll") for (int i = 0; i < 8; ++i) {                                                                                         \
        bf16x8 a_nxt = a_cur;                                                                                                                 \
        if (i < 7) a_nxt = *(const LAS bf16x8*)(sa + lds_byte(wr * 128 + (i + 1) * 16 + fr, ks * 32 + fq * 8));          \
        _Pragma("unroll") for (int j = 0; j < 4; ++j) acc[i][j] = MFMA16(bfr[j], a_cur, acc[i][j]);                                           \
        __builtin_amdgcn_sched_group_barrier(0x100, 1, 0);                                                                                    \
        __builtin_amdgcn_sched_group_barrier(0x008, 4, 0);                                                                                    \
        a_cur = a_nxt;                                                                                                                        \
      }                                                                                                                                       \
    }                                                                                                                                         \
  } while (0)
#define G8_SETUP()                                                                                                                            \
  const int tid = ltid_full(), wid = tid >> 6, lane = tid & 63;                                                                               \
  const int wr = wid >> 2, wc = wid & 3, fr = lane & 15, fq = lane >> 4;                                                                      \
  int offA[4], offB[4];                                                                                                                       \
  _Pragma("unroll") for (int i = 0; i < 4; ++i) {                                                                                             \
    int R, C;                                                                                                                                 \
    stage_rc(wid * 1024 + i * 8192 + lane * 16, R, C);                                                                                        \
    offA[i] = R * lda + C;                                                                                                                    \
    offB[i] = R * ldb + C;                                                                                                                    \
  }

template <int MODE>
DI void gemm8(const Params& p, int l, const bf16_t* A, int lda, const bf16_t* Bt, int ldb, int K, int m0, int n0, LAS char* lds) {
  G8_SETUP();
  f32x4 acc[8][4];
#pragma unroll
  for (int i = 0; i < 8; ++i)
#pragma unroll
    for (int j = 0; j < 4; ++j) acc[i][j] = f32x4{0.f, 0.f, 0.f, 0.f};
  const bf16_t* Ab = A + (size_t)m0 * lda;
  const bf16_t* Bb = Bt + (size_t)n0 * ldb;
  const int nt = K >> 6;
  G8_STAGE(Ab, Bb, 0, 0);
  WAIT_V(0);
  __syncthreads();
  for (int t = 0; t < nt; ++t) {
    const int cur = t & 1;
    if (t + 1 < nt) G8_STAGE(Ab, Bb, cur ^ 1, t + 1);
    G8_COMPUTE(cur);
    WAIT_V(0);
    __syncthreads();
  }
  gemm_epilogue<MODE>(p, l, acc, m0, n0, wr, wc, fr, fq, (const LAS float*)(lds + 131072));
}

struct GTile { int m0, n0, kb, nk, atomic; };
template <int MODE>
DI bool gemm_next_tile(int k, int nM, int nN, int Kit, GTile& g, bool skipctx = false) {
  const int ntl = nM * nN, per = ntl >> 3;
  const int nb8 = gridDim.x >> 3, xcd = blockIdx.x & 7, j = blockIdx.x >> 3;
  const int R = per / nb8, rem = per - R * nb8;
  int loc;
  g.kb = 0; g.nk = Kit; g.atomic = 0;
  if (k < R) loc = k * nb8 + j;
  else if (k == R && rem > 0) {
    int S = 1;
    if (false) { S = nb8 / rem; while (S > 1 && (Kit % S)) --S; }
    if (j >= rem * S) return false;
    loc = R * nb8 + j / S;
    if (S > 1) { g.nk = Kit / S; g.kb = (j % S) * g.nk; g.atomic = 1; }
  } else return false;
  const int L = xcd * per + loc;
  const int nig = 8 * nN, gid = L / nig, fm = gid * 8, gsz = (nM - fm) < 8 ? (nM - fm) : 8;
  int pm = fm + ((L % nig) % gsz);
  if (skipctx) pm += pm / 16 + 1;
  g.m0 = pm * 256;
  g.n0 = ((L % nig) / gsz) * 256;
  return true;
}

template <int MODE>
DI void gemm_phase(const Params& p, int l, const bf16_t* A, int lda, const bf16_t* Bt, int ldb, int K, int nM, int nN, LAS char* lds, bool skipctx = false) {
  G8_SETUP();
  const int Kit = K >> 6;
  GTile cur, nxt;
  bool have = gemm_next_tile<MODE>(0, nM, nN, Kit, cur, skipctx);
  if (have) G8_STAGE(A + (size_t)cur.m0 * lda, Bt + (size_t)cur.n0 * ldb, 0, cur.kb);
  for (int k = 0; have; ++k) {
    const bool hn = gemm_next_tile<MODE>(k + 1, nM, nN, Kit, nxt, skipctx);
    f32x4 acc[8][4];
#pragma unroll
    for (int i = 0; i < 8; ++i)
#pragma unroll
      for (int j = 0; j < 4; ++j) acc[i][j] = f32x4{0.f, 0.f, 0.f, 0.f};
    const bf16_t* Ab = A + (size_t)cur.m0 * lda;
    const bf16_t* Bb = Bt + (size_t)cur.n0 * ldb;
    LAS float* cst = (LAS float*)(lds + 131072 + (k & 1) * 4096);
    if (MODE == EP_P || MODE == EP_GU) {
      const float* rss = (const float*)(p.ws + (MODE == EP_P ? OFF_RSS1 : OFF_RSS2));
      const float* bias = (const float*)(p.ws + (MODE == EP_P ? OFF_BIAS1 : OFF_BIAS2)) + ((size_t)(l * 9 + bidx_of(cur.m0))) * (MODE == EP_P ? 2560 : 5632);
      cst[tid] = tid < 256 ? rss[cur.m0 + tid] : bias[cur.n0 + tid - 256];
    }
    if (MODE == EP_RES1 || MODE == EP_RES2) {
      const float* mrow = modrow(p, l, cur.m0);
      const int c = cur.n0 + (tid & 255);
      if (tid < 256) cst[256 + tid] = mrow[(MODE == EP_RES1 ? 2048 : 5120) + c];
      else {
        const float* ng = (MODE == EP_RES1) ? p.norm2_g + l * 1024 : p.norm1_g + (l < 3 ? l + 1 : 0) * 1024;
        const float* nsc = (MODE == EP_RES1) ? mrow + 4096 : modrow(p, l < 3 ? l + 1 : 0, cur.m0) + 1024;
        cst[256 + tid] = ng[c] * (1.f + nsc[c]);
      }
    }
    WAIT_V(0);
    __syncthreads();
    for (int t = 0; t < cur.nk; ++t) {
      const int cb = t & 1;
      if (t + 1 < cur.nk) G8_STAGE(Ab, Bb, cb ^ 1, cur.kb + t + 1);
      G8_COMPUTE(cb);
      WAIT_V(0);
      __syncthreads();
    }
    if (hn) G8_STAGE(A + (size_t)nxt.m0 * lda, Bt + (size_t)nxt.n0 * ldb, 0, nxt.kb);
    gemm_epilogue<MODE>(p, l, acc, cur.m0, cur.n0, wr, wc, fr, fq, cst);
    cur = nxt;
    have = hn;
  }
}

template <int MODE>
DI void gemm_epilogue8(const Params& p, int l, const f32x4 (&acc)[2][2][4][2], int m0, int n0, int wr, int wc, int fr, int fq, const LAS float* cst, bool half) {
#pragma unroll
  for (int ai = 0; ai < 2; ++ai)
#pragma unroll
    for (int mm = 0; mm < 4; ++mm) {
      if (ai == 1 && half) continue;
      const int rl = ai * 128 + wr * 64 + mm * 16 + fr;
      const int m = m0 + rl;
      if (MODE == EP_P) {
        bf16_t* Pp = (bf16_t*)(p.ws + OFF_P) + (size_t)m * PW;
        bf16_t* Zp = (bf16_t*)(p.ws + OFF_Z) + (size_t)m * 256;
        const float rs = rsqrtf(cst[rl] * (1.f / 1024.f) + EPS);
#pragma unroll
        for (int bj = 0; bj < 2; ++bj)
#pragma unroll
          for (int nn = 0; nn < 2; ++nn) {
            const int cl = bj * 128 + wc * 32 + nn * 16 + fq * 4, n = n0 + cl;
            const f32x4 bq = *(const LAS f32x4*)(cst + 256 + cl);
            const f32x4& a = acc[ai][bj][mm][nn];
            uint2 v = {pk(a[0] * rs + bq[0], a[1] * rs + bq[1]), pk(a[2] * rs + bq[2], a[3] * rs + bq[3])};
            if (n < 768) *(uint2*)(Pp + n) = v;
            else if (n < 1024) *(uint2*)(Zp + (n - 768)) = v;
            else if (n < 2320) *(uint2*)(Pp + (n - 256)) = v;
          }
      } else if (MODE == EP_RES1 || MODE == EP_RES2) {
        float* xo = xrow(p, m);
        const bool emit = (MODE == EP_RES1) || (l < 3);
        bf16_t* hb = (bf16_t*)(p.ws + OFF_HB) + (size_t)m * 1024;
        float4 xv[4];
#pragma unroll
        for (int q4 = 0; q4 < 4; ++q4) xv[q4] = *(const float4*)(xo + n0 + (q4 >> 1) * 128 + wc * 32 + (q4 & 1) * 16 + fq * 4);
        float ssq = 0.f;
#pragma unroll
        for (int q4 = 0; q4 < 4; ++q4) {
          const int cl = (q4 >> 1) * 128 + wc * 32 + (q4 & 1) * 16 + fq * 4, n = n0 + cl;
          const f32x4 gq = *(const LAS f32x4*)(cst + 256 + cl), mq = *(const LAS f32x4*)(cst + 512 + cl);
          const f32x4& a = acc[ai][q4 >> 1][mm][q4 & 1];
          xv[q4].x += gq[0] * a[0]; xv[q4].y += gq[1] * a[1]; xv[q4].z += gq[2] * a[2]; xv[q4].w += gq[3] * a[3];
          *(float4*)(xo + n) = xv[q4];
          if (emit) {
            ssq += xv[q4].x * xv[q4].x + xv[q4].y * xv[q4].y + xv[q4].z * xv[q4].z + xv[q4].w * xv[q4].w;
            *(uint2*)(hb + n) = uint2{pk(xv[q4].x * mq[0], xv[q4].y * mq[1]), pk(xv[q4].z * mq[2], xv[q4].w * mq[3])};
          }
        }
        if (emit) {
          ssq += __shfl_xor(ssq, 16);
          ssq += __shfl_xor(ssq, 32);
          if (fq == 0) unsafeAtomicAdd((float*)(p.ws + (MODE == EP_RES1 ? OFF_RSS2 : OFF_RSS1)) + m, ssq);
        }
      } else if (MODE == EP_GU) {
        bf16_t* hp = (bf16_t*)(p.ws + OFF_HM) + (size_t)m * HID;
        const float rs = rsqrtf(cst[rl] * (1.f / 1024.f) + EPS);
#pragma unroll
        for (int bj = 0; bj < 2; ++bj) {
          const int cl = bj * 128 + wc * 32 + fq * 4;
          const int hcol = ((n0 + bj * 128 + wc * 32) >> 1) + fq * 4;
          const f32x4 bg = *(const LAS f32x4*)(cst + 256 + cl), bu = *(const LAS f32x4*)(cst + 256 + cl + 16);
          const f32x4& ag = acc[ai][bj][mm][0];
          const f32x4& au = acc[ai][bj][mm][1];
          float o[4];
#pragma unroll
          for (int r = 0; r < 4; ++r) o[r] = silu_f(ag[r] * rs + bg[r]) * (au[r] * rs + bu[r]);
          *(uint2*)(hp + hcol) = uint2{pk(o[0], o[1]), pk(o[2], o[3])};
        }
      } else {
        bf16_t* dp = (bf16_t*)(p.ws + OFF_DN + (size_t)40 * 1024 * 1024) + (size_t)m * 1024;
#pragma unroll
        for (int q4 = 0; q4 < 4; ++q4) {
          const f32x4& a = acc[ai][q4 >> 1][mm][q4 & 1];
          *(uint2*)(dp + n0 + (q4 >> 1) * 128 + wc * 32 + (q4 & 1) * 16 + fq * 4) = uint2{pk(a[0], a[1]), pk(a[2], a[3])};
        }
      }
    }
}

DI bool next_tile8(int k, int nM, int nN, int Kit, GTile& g, int ctxmode) {
  if (ctxmode != 2) return gemm_next_tile<EP_P>(k, nM, nN, Kit, g, ctxmode == 1);
  if (gemm_next_tile<EP_P>(k, 128, nN, Kit, g, true)) return true;
  const int nb8 = gridDim.x >> 3, per = 16 * nN, R = per / nb8, kx = R + ((per - R * nb8) > 0 ? 1 : 0);
  const int j = blockIdx.x >> 3;
  if (k != kx || j >= 2 * nN) return false;
  const int u = (blockIdx.x & 7) * (2 * nN) + j;
  g.m0 = (blockIdx.x & 7) * 17 * 256 + ((j / nN) & 1) * 128;
  g.n0 = (j % nN) * 256;
  g.kb = 0; g.nk = Kit; g.atomic = 1;
  (void)u;
  return true;
}

template <int MODE>
DI void gemm_phase8(const Params& p, int l, const bf16_t* A, const bf16_t* Bt, int K, int nM, int nN, LAS char* lds, int ctxmode) {
  constexpr int HT = 128 * 64;
  const int tid = ltid_full(), wid = tid >> 6, lane = tid & 63;
  const int wr = wid >> 2, wc = wid & 3, fr = lane & 15, fq = lane >> 4;
  unsigned soff[2];
#pragma unroll
  for (int i = 0; i < 2; ++i) { int R, C; stage_rc(tid * 16 + i * 8192, R, C); soff[i] = (unsigned)(R * K + C) * 2u; }
#define P8_SA(b, h) (lds + (((b) * 2 + (h)) * HT) * 2)
#define P8_SB(b, h) (lds + ((4 + (b) * 2 + (h)) * HT) * 2)
#define P8_STAGE(P_, BASE_, br_, kt_)                                                                                                          \
  do {                                                                                                                                        \
    const unsigned long long _gi = (unsigned long long)((BASE_) + (size_t)(br_) * K + (size_t)(kt_) * 64);                                       \
    const char* _g = (const char*)(((unsigned long long)(unsigned)__builtin_amdgcn_readfirstlane((int)(_gi >> 32)) << 32) |                    \
                                   (unsigned)__builtin_amdgcn_readfirstlane((int)(unsigned)_gi));     \
    _Pragma("unroll") for (int _i = 0; _i < 2; ++_i)                                                                                          \
      __builtin_amdgcn_global_load_lds((const unsigned*)(_g + soff[_i]), (LAS unsigned*)((P_) + wid * 1024 + _i * 8192), 16, 0, 0);            \
  } while (0)
#define P8_LDA(dst, b, h)                                                                                                                     \
  _Pragma("unroll") for (int m_ = 0; m_ < 4; ++m_) _Pragma("unroll") for (int k_ = 0; k_ < 2; ++k_)                                           \
    dst[m_][k_] = *(const LAS bf16x8*)(P8_SA(b, h) + lds_byte(wr * 64 + m_ * 16 + fr, k_ * 32 + fq * 8))
#define P8_LDB(dst, b, h)                                                                                                                     \
  _Pragma("unroll") for (int n_ = 0; n_ < 2; ++n_) _Pragma("unroll") for (int k_ = 0; k_ < 2; ++k_)                                           \
    dst[n_][k_] = *(const LAS bf16x8*)(P8_SB(b, h) + lds_byte(wc * 32 + n_ * 16 + fr, k_ * 32 + fq * 8))
#define P8_MMA(ai, bj, At_, Bt_)                                                                                                              \
  do {                                                                                                                                        \
    __builtin_amdgcn_s_setprio(1);                                                                                                            \
    _Pragma("unroll") for (int m_ = 0; m_ < 4; ++m_) _Pragma("unroll") for (int n_ = 0; n_ < 2; ++n_) _Pragma("unroll") for (int k_ = 0; k_ < 2; ++k_) \
      acc[ai][bj][m_][n_] = MFMA16(Bt_[n_][k_], At_[m_][k_], acc[ai][bj][m_][n_]);                                                            \
    __builtin_amdgcn_s_setprio(0);                                                                                                            \
  } while (0)
#define P8_MMA_B1(ai, bj, At_, Bt_) do { if (!skipb1 && !((ai) == 1 && half)) P8_MMA(ai, bj, At_, Bt_); } while (0)
#define P8_MMA_A1(ai, bj, At_, Bt_) do { if (!half) P8_MMA(ai, bj, At_, Bt_); } while (0)
#define P8_WAIT_L(n) asm volatile("s_waitcnt lgkmcnt(%0)" ::"n"(n) : "memory")
#define P8_BAR __builtin_amdgcn_s_barrier()
#define P8_SCHED __builtin_amdgcn_sched_barrier(0)
  const int nt = K >> 6;
  GTile cur;
  for (int k = 0; next_tile8(k, nM, nN, nt, cur, ctxmode); ++k) {
    const int brow = cur.m0, bcol = cur.n0;
    const bool half = cur.atomic != 0;
    const bool skipb1 = (MODE == EP_P) && (bcol + 128 >= 2320);
    LAS float* cst = (LAS float*)(lds + 131072 + (k & 1) * 4096);
    if (MODE == EP_P || MODE == EP_GU) {
      const float* rss = (const float*)(p.ws + (MODE == EP_P ? OFF_RSS1 : OFF_RSS2));
      const float* bias = (const float*)(p.ws + (MODE == EP_P ? OFF_BIAS1 : OFF_BIAS2)) + ((size_t)(l * 9 + bidx_of(brow))) * (MODE == EP_P ? 2560 : 5632);
      cst[tid] = tid < 256 ? rss[brow + tid] : bias[bcol + tid - 256];
    }
    if (MODE == EP_RES1 || MODE == EP_RES2) {
      const float* mrow = modrow(p, l, brow);
      const int c = bcol + (tid & 255);
      if (tid < 256) cst[256 + tid] = mrow[(MODE == EP_RES1 ? 2048 : 5120) + c];
      else {
        const float* ng = (MODE == EP_RES1) ? p.norm2_g + l * 1024 : p.norm1_g + (l < 3 ? l + 1 : 0) * 1024;
        const float* nsc = (MODE == EP_RES1) ? mrow + 4096 : modrow(p, l < 3 ? l + 1 : 0, brow) + 1024;
        cst[256 + tid] = ng[c] * (1.f + nsc[c]);
      }
    }
    f32x4 acc[2][2][4][2];
#pragma unroll
    for (int a_ = 0; a_ < 2; ++a_)
#pragma unroll
      for (int b_ = 0; b_ < 2; ++b_)
#pragma unroll
        for (int m_ = 0; m_ < 4; ++m_)
#pragma unroll
          for (int n_ = 0; n_ < 2; ++n_) acc[a_][b_][m_][n_] = f32x4{0.f, 0.f, 0.f, 0.f};
    bf16x8 At[4][2], B0[2][2], B1[2][2];
    __syncthreads();
    P8_STAGE(P8_SB(0, 0), Bt, bcol, 0); P8_STAGE(P8_SA(0, 0), A, brow, 0);
    P8_STAGE(P8_SB(0, 1), Bt, bcol + 128, 0); P8_STAGE(P8_SA(0, 1), A, brow + 128, 0);
    if (wr == 1) P8_BAR;
    WAIT_V(4); P8_BAR;
    P8_STAGE(P8_SB(1, 0), Bt, bcol, 1); P8_STAGE(P8_SA(1, 0), A, brow, 1); P8_STAGE(P8_SB(1, 1), Bt, bcol + 128, 1);
    WAIT_V(6); P8_BAR;
    for (int t = 0; t < nt - 2; t += 2) {
      P8_LDB(B0, 0, 0); P8_SCHED; P8_LDA(At, 0, 0); P8_STAGE(P8_SA(1, 1), A, brow + 128, t + 1);
      P8_WAIT_L(8); P8_BAR; P8_WAIT_L(0); P8_MMA(0, 0, At, B0); P8_BAR; P8_SCHED;
      P8_LDB(B1, 0, 1); P8_STAGE(P8_SB(0, 0), Bt, bcol, t + 2);
      P8_BAR; P8_WAIT_L(0); P8_MMA_B1(0, 1, At, B1); P8_BAR;
      P8_LDA(At, 0, 1); P8_STAGE(P8_SA(0, 0), A, brow, t + 2);
      P8_BAR; P8_WAIT_L(0); P8_MMA_A1(1, 0, At, B0); P8_BAR; P8_SCHED;
      P8_STAGE(P8_SB(0, 1), Bt, bcol + 128, t + 2);
      WAIT_V(6); P8_BAR; P8_MMA_B1(1, 1, At, B1); P8_BAR;
      P8_LDB(B0, 1, 0); P8_SCHED; P8_LDA(At, 1, 0); P8_STAGE(P8_SA(0, 1), A, brow + 128, t + 2);
      P8_WAIT_L(8); P8_BAR; P8_WAIT_L(0); P8_MMA(0, 0, At, B0); P8_BAR; P8_SCHED;
      P8_LDB(B1, 1, 1); P8_STAGE(P8_SB(1, 0), Bt, bcol, t + 3);
      P8_BAR; P8_WAIT_L(0); P8_MMA_B1(0, 1, At, B1); P8_BAR;
      P8_LDA(At, 1, 1); P8_STAGE(P8_SA(1, 0), A, brow, t + 3);
      P8_BAR; P8_WAIT_L(0); P8_MMA_A1(1, 0, At, B0); P8_BAR; P8_SCHED;
      P8_STAGE(P8_SB(1, 1), Bt, bcol + 128, t + 3);
      WAIT_V(6); P8_BAR; P8_MMA_B1(1, 1, At, B1); P8_BAR;
    }
    { P8_LDB(B0, 0, 0); P8_LDA(At, 0, 0); P8_STAGE(P8_SA(1, 1), A, brow + 128, nt - 1);
      P8_BAR; P8_WAIT_L(0); P8_MMA(0, 0, At, B0); P8_BAR;
      P8_LDB(B1, 0, 1); P8_BAR; P8_WAIT_L(0); P8_MMA_B1(0, 1, At, B1); P8_BAR;
      P8_LDA(At, 0, 1); WAIT_V(4); P8_BAR; P8_WAIT_L(0); P8_MMA_A1(1, 0, At, B0); P8_MMA_B1(1, 1, At, B1); P8_BAR; }
    { P8_LDB(B0, 1, 0); P8_LDA(At, 1, 0); WAIT_V(2); P8_BAR; P8_WAIT_L(0); P8_MMA(0, 0, At, B0); P8_BAR;
      P8_LDB(B1, 1, 1); WAIT_V(0); P8_BAR; P8_WAIT_L(0); P8_MMA_B1(0, 1, At, B1); P8_BAR;
      P8_LDA(At, 1, 1); P8_BAR; P8_WAIT_L(0); P8_MMA_A1(1, 0, At, B0); P8_MMA_B1(1, 1, At, B1); P8_BAR; }
    if (wr == 0) P8_BAR;
    gemm_epilogue8<MODE>(p, l, acc, brow, bcol, wr, wc, fr, fq, cst, half);
  }
}

template <bool BIAS>
DI void wconv_tile(const float* src0, const float* src1, int N, int K, bf16_t* dst, int kind, int kt, int nt, char* smem, const float* shvec = nullptr, float* bias = nullptr, int npad = 0) {
  float* tile = (float*)smem;
  const int tid = ltid();
  __syncthreads();
  {
    const int nn = tid & 63, kk0 = tid >> 6;
    const int R = nt * 64 + nn;
    const float* src = src0;
    int col = R;
    bool ok = true;
    if (kind == 1) {
      const int grp = R >> 5, up = (R >> 4) & 1;
      col = grp * 16 + (R & 15);
      src = up ? src1 : src0;
    } else ok = R < N;
    float wv[16];
#pragma unroll
    for (int i = 0; i < 16; ++i) wv[i] = ok ? src[(size_t)(kt * 64 + kk0 + i * 4) * N + col] : 0.f;
#pragma unroll
    for (int i = 0; i < 16; ++i) tile[(kk0 + i * 4) * 65 + nn] = wv[i];
    if (BIAS) {
      float* svs = tile + 64 * 65;
      for (int o = tid; o < 9 * 64; o += 256) svs[o] = shvec[(size_t)(o >> 6) * 6144 + kt * 64 + (o & 63)];
    }
  }
  __syncthreads();
  {
    const int rr = tid >> 2, kc = (tid & 3) * 16;
    unsigned o[8];
#pragma unroll
    for (int e = 0; e < 8; ++e) o[e] = pk(tile[(kc + 2 * e) * 65 + rr], tile[(kc + 2 * e + 1) * 65 + rr]);
    bf16_t* d = dst + (size_t)(nt * 64 + rr) * K + kt * 64 + kc;
    *(uint4*)d = uint4{o[0], o[1], o[2], o[3]};
    *(uint4*)(d + 8) = uint4{o[4], o[5], o[6], o[7]};
  }
  if (BIAS) {
    for (int o = tid; o < 9 * 64; o += 256) {
      const int bq = o >> 6, nn = o & 63;
      const float* sv = tile + 64 * 65 + bq * 64;
      float a = 0.f;
#pragma unroll 8
      for (int kk = 0; kk < 64; ++kk) a += sv[kk] * tile[kk * 65 + nn];
      unsafeAtomicAdd(bias + (size_t)bq * npad + nt * 64 + nn, a);
    }
  }
}

DI void mod_item(const Params& p, int item, char* smem) {
  const int l = item / 96, cgp = item % 96;
  float* sc = (float*)smem;
  float* red = sc + 9 * 1024;
  const int tid = ltid();
  __syncthreads();
  for (int i = tid; i < 9 * 1024; i += 256) {
    const int r = i >> 10, k = i & 1023;
    const float v = r < 8 ? p.c[r * 1024 + k] : p.c_ctx[k];
    sc[i] = silu_f(v);
  }
  __syncthreads();
  const int kq = tid >> 6, cc = tid & 63, col = cgp * 64 + cc;
  float acc[9];
#pragma unroll
  for (int r = 0; r < 9; ++r) acc[r] = 0.f;
  const float* wp = p.w_ada + (size_t)l * 1024 * 6144 + col;
#pragma unroll 8
  for (int k = kq * 256; k < kq * 256 + 256; ++k) {
    const float wv = wp[(size_t)k * 6144];
#pragma unroll
    for (int r = 0; r < 9; ++r) acc[r] += sc[r * 1024 + k] * wv;
  }
#pragma unroll
  for (int r = 0; r < 9; ++r) red[(kq * 9 + r) * 64 + cc] = acc[r];
  __syncthreads();
  for (int i = tid; i < 9 * 64; i += 256) {
    const int r = i >> 6, c2 = i & 63;
    const float s = red[(0 * 9 + r) * 64 + c2] + red[(1 * 9 + r) * 64 + c2] + red[(2 * 9 + r) * 64 + c2] + red[(3 * 9 + r) * 64 + c2];
    ((float*)(p.ws + OFF_MOD))[((size_t)(l * 9 + r)) * 6144 + cgp * 64 + c2] = s + p.b_ada[l * 6144 + cgp * 64 + c2];
  }
}

DI void phase0(const Params& p, char* smem) {
  const int tid = ltid(), hf = ltid_full() >> 8;
  constexpr int N_MOD_IT = 384, N_ROPE = 512, N_CS = 32, N_ADC = 512, N_AD = 4160;
  constexpr int TOT = N_MOD_IT + N_ROPE + N_CS + N_ADC + N_AD;
  if (blockIdx.x == 0 && hf == 0 && tid < 64) ((int*)(p.ws + OFF_CTR))[tid] = 0;
  for (int i = blockIdx.x * 512 + ltid_full(); i < 4 * 9 * (2560 + 5632); i += gridDim.x * 512) ((float*)(p.ws + OFF_BIAS1))[i] = 0.f;
  for (int pi = blockIdx.x; pi < TOT / 2; pi += gridDim.x) {
    int i = pi * 2 + hf;
    if (i < N_MOD_IT) { mod_item(p, i, smem + hf * HALF_SMEM); continue; }
    i -= N_MOD_IT;
    if (i < N_ROPE) {
      const int e = i * 256 + tid;
      const int pos = e >> 5, f = e & 31;
      const float pv = (f < 16) ? (float)(pos >> 6) : (float)(pos & 63);
      const float invf = powf(10000.f, -(float)(f & 15) / 16.f);
      const float ang = pv * invf;
      float s, c;
      sincosf(ang, &s, &c);
      ((float*)(p.ws + OFF_ROPEC))[e] = c;
      ((float*)(p.ws + OFF_ROPES))[e] = s;
      continue;
    }
    i -= N_ROPE;
    if (i < N_CS) {
      const int e = i * 256 + tid;
      const int r = e >> 6, n2 = e & 63;
      const int idx = ((r & 63) * n2) & 63;
      float s, c;
      sincospif((float)idx / 32.f, &s, &c);
      ((bf16_t*)(p.ws + OFF_CS64))[e] = f2bf(r < 64 ? c : s);
      continue;
    }
    i -= N_CS;
    if (i < N_ADC) {
      const int e = i * 256 + tid;
      const int k1 = e >> 9, cc = e & 511, n1 = cc & 255;
      const int idx = (k1 * n1) & 255;
      float s, c;
      sincospif((float)idx / 128.f, &s, &c);
      ((bf16_t*)(p.ws + OFF_ADFTC))[e] = f2bf(cc < 256 ? c : -s);
      continue;
    }
    i -= N_ADC;
    if (i < N_AD) {
      const size_t e0 = (size_t)i * 4096 + (size_t)tid * 16;
      const int k1 = (int)(e0 / 4160), c0 = (int)(e0 % 4160);
      unsigned o[8];
#pragma unroll
      for (int e = 0; e < 8; ++e) {
        float v[2];
#pragma unroll
        for (int h = 0; h < 2; ++h) {
          const int cc = c0 + 2 * e + h;
          const int n1 = cc < 2112 ? cc : cc - 2112;
          const int idx = (k1 * n1) & 4095;
          float sn, cs;
          sincospif((float)idx / 2048.f, &sn, &cs);
          v[h] = cc < 2112 ? (cc <= 2048 ? cs : 0.f) : -sn;
        }
        o[e] = pk(v[0], v[1]);
      }
      bf16_t* dd = (bf16_t*)(p.ws + OFF_ADFT) + e0;
      *(uint4*)dd = uint4{o[0], o[1], o[2], o[3]};
      *(uint4*)(dd + 8) = uint4{o[4], o[5], o[6], o[7]};
      continue;
    }
  }
}

DI void norm_item(const Params& p, int item) {
  const int tid = ltid();
  const int w = tid >> 6, lane = tid & 63;
  const int t = item * 4 + w;
  const float* xr = xrow_in(p, t);
  const float* md = modrow(p, 0, t);
  const float* g = p.norm1_g;
  float4 v[4];
  float ss = 0.f;
#pragma unroll
  for (int j = 0; j < 4; ++j) {
    v[j] = *(const float4*)(xr + j * 256 + lane * 4);
    ss += v[j].x * v[j].x + v[j].y * v[j].y + v[j].z * v[j].z + v[j].w * v[j].w;
  }
#pragma unroll
  for (int off = 32; off >= 1; off >>= 1) ss += __shfl_xor(ss, off);
  if (lane == 0) ((float*)(p.ws + OFF_RSS1))[t] = ss;
  float* xo = xrow(p, t);
  bf16_t* hb = (bf16_t*)(p.ws + OFF_HB) + (size_t)t * 1024;
#pragma unroll
  for (int j = 0; j < 4; ++j) {
    const int c = j * 256 + lane * 4;
    *(float4*)(xo + c) = v[j];
    const float4 gg = *(const float4*)(g + c), sc = *(const float4*)(md + 1024 + c);
    *(uint2*)(hb + c) = uint2{pk(v[j].x * gg.x * (1.f + sc.x), v[j].y * gg.y * (1.f + sc.y)), pk(v[j].z * gg.z * (1.f + sc.z), v[j].w * gg.w * (1.f + sc.w))};
  }
}

DI void aprep_item(const Params& p, int l, int item, char* smem) {
  const int b = item / NCH, c = item % NCH;
  const int tok0 = b * TB + c * 64;
  const bool isctx = c < 4;
  int tid_ = ltid();
  const int tid = tid_, lane = tid & 63, w = tid >> 6;
  const bf16_t* P = (const bf16_t*)(p.ws + OFF_P);
  for (int it = 0; it < 12; ++it) {
    const int task = it * 64 + (tid >> 2);
    const int cq = tid & 3;
    const int type = task / 384, rem = task % 384, hr = rem >> 6, tk = rem & 63;
    const int t = tok0 + tk;
    const int pcol = (type ? 1296 : 784) + hr * 64;
    const bf16_t* src = P + (size_t)t * PW + pcol;
    const uint4 u1 = *(const uint4*)(src + cq * 8), u2 = *(const uint4*)(src + 32 + cq * 8);
    float a[8], bb[8];
    a[0] = bflo(u1.x); a[1] = bfhi(u1.x); a[2] = bflo(u1.y); a[3] = bfhi(u1.y); a[4] = bflo(u1.z); a[5] = bfhi(u1.z); a[6] = bflo(u1.w); a[7] = bfhi(u1.w);
    bb[0] = bflo(u2.x); bb[1] = bfhi(u2.x); bb[2] = bflo(u2.y); bb[3] = bfhi(u2.y); bb[4] = bflo(u2.z); bb[5] = bfhi(u2.z); bb[6] = bflo(u2.w); bb[7] = bfhi(u2.w);
    float ss = 0.f;
#pragma unroll
    for (int e = 0; e < 8; ++e) ss += a[e] * a[e] + bb[e] * bb[e];
    ss += __shfl_xor(ss, 1);
    ss += __shfl_xor(ss, 2);
    const float rs = rsqrtf(ss * (1.f / 64.f) + EPS);
    const float* gn = (type ? (hr < 4 ? p.wa_qn : p.wa_kn) : (hr < 4 ? p.ga_qn : p.ga_kn)) + l * 64;
    const float qs = hr < 4 ? 0.125f * LOG2E : 1.f;
    float o1[8], o2[8];
#pragma unroll
    for (int e = 0; e < 8; ++e) {
      a[e] = a[e] * rs * gn[cq * 8 + e];
      bb[e] = bb[e] * rs * gn[32 + cq * 8 + e];
    }
    if (!isctx) {
      const int pos = c * 64 + tk - LC;
      const float* rc = (const float*)(p.ws + OFF_ROPEC) + pos * 32 + cq * 8;
      const float* rsn = (const float*)(p.ws + OFF_ROPES) + pos * 32 + cq * 8;
#pragma unroll
      for (int e = 0; e < 8; ++e) {
        const float cs = rc[e], sn = rsn[e];
        o1[e] = (a[e] * cs - bb[e] * sn) * qs;
        o2[e] = (a[e] * sn + bb[e] * cs) * qs;
      }
    } else {
#pragma unroll
      for (int e = 0; e < 8; ++e) { o1[e] = a[e] * qs; o2[e] = bb[e] * qs; }
    }
    bf16_t* dst = hr < 4 ? (bf16_t*)(p.ws + OFF_QA) + ((size_t)type * T + t) * 256 + hr * 64
                         : (bf16_t*)(p.ws + OFF_KA) + ((size_t)type * T + t) * 128 + (hr - 4) * 64;
    *(uint4*)(dst + cq * 8) = uint4{pk(o1[0], o1[1]), pk(o1[2], o1[3]), pk(o1[4], o1[5]), pk(o1[6], o1[7])};
    *(uint4*)(dst + 32 + cq * 8) = uint4{pk(o2[0], o2[1]), pk(o2[2], o2[3]), pk(o2[4], o2[5]), pk(o2[6], o2[7])};
  }
  {
    bf16_t* sT = (bf16_t*)smem;
#pragma unroll 1
    for (int type = 0; type < 2; ++type) {
      const int vcol = (type ? 1296 : 784) + 384;
      __syncthreads();
#pragma unroll
      for (int i = 0; i < 4; ++i) {
        const int q = tid + i * 256, tk = q >> 4, ch = q & 15;
        *(uint4*)(sT + tk * 136 + ch * 8) = *(const uint4*)(P + (size_t)(tok0 + tk) * PW + vcol + ch * 8);
      }
      __syncthreads();
      const int kd = tid & 127, th = tid >> 7;
      bf16_t* dst = (bf16_t*)(p.ws + OFF_VT) + (((size_t)(type * NB + b) * 128 + kd)) * TB + c * 64 + th * 32;
#pragma unroll
      for (int j0 = 0; j0 < 32; j0 += 8) {
        unsigned o[4];
#pragma unroll
        for (int e = 0; e < 4; ++e) {
          const unsigned lo = sT[(th * 32 + j0 + 2 * e) * 136 + kd], hi = sT[(th * 32 + j0 + 2 * e + 1) * 136 + kd];
          o[e] = lo | (hi << 16);
        }
        *(uint4*)(dst + j0) = uint4{o[0], o[1], o[2], o[3]};
      }
    }
  }
  {
    const int g = w, lr = lane & 15, lq = lane >> 4;
    const bf16_t* CS = (const bf16_t*)(p.ws + OFF_CS64);
    const int cl = c - 4;
    if (isctx || cl <= 32) {
#pragma unroll 1
      for (int nh = 0; nh < 2; ++nh) {
      bf16x8 bs[2][2], bd[2][2];
#pragma unroll
      for (int ntl = 0; ntl < 2; ++ntl) {
        const int nt = nh * 2 + ntl;
        const int n1 = cl * 64 + nt * 16 + lr;
        const bool mir = !isctx && n1 >= 1 && n1 <= 2047;
        const bool zero = !isctx && n1 > 2048;
#pragma unroll
        for (int ks = 0; ks < 2; ++ks) {
          const int coff = 1808 + g * 64 + ks * 32 + lq * 8;
          uint4 a = *(const uint4*)(P + (size_t)(tok0 + nt * 16 + lr) * PW + coff);
          uint4 m = {0u, 0u, 0u, 0u};
          if (mir) m = *(const uint4*)(P + (size_t)(b * TB + LC + 4096 - n1) * PW + coff);
          if (zero) a = uint4{0u, 0u, 0u, 0u};
          const unsigned ua[4] = {a.x, a.y, a.z, a.w}, um[4] = {m.x, m.y, m.z, m.w};
          unsigned os[4], od[4];
#pragma unroll
          for (int e = 0; e < 4; ++e) {
            const float a0 = bflo(ua[e]), a1 = bfhi(ua[e]), m0 = bflo(um[e]), m1 = bfhi(um[e]);
            os[e] = pk(a0 + m0, a1 + m1);
            od[e] = pk(a0 - m0, a1 - m1);
          }
          bs[ntl][ks] = __builtin_bit_cast(bf16x8, uint4{os[0], os[1], os[2], os[3]});
          bd[ntl][ks] = __builtin_bit_cast(bf16x8, uint4{od[0], od[1], od[2], od[3]});
        }
      }
#pragma unroll 1
      for (int mt = 0; mt < 8; ++mt) {
        bf16x8 af[2];
#pragma unroll
        for (int ks = 0; ks < 2; ++ks) af[ks] = *(const bf16x8*)(CS + (mt * 16 + lr) * 64 + ks * 32 + lq * 8);
#pragma unroll
        for (int ntl = 0; ntl < 2; ++ntl) {
          const int nt = nh * 2 + ntl;
          f32x4 acc = {0.f, 0.f, 0.f, 0.f};
          const bool sinpart = mt >= 4;
          acc = MFMA16(af[0], (sinpart && !isctx) ? bd[ntl][0] : bs[ntl][0], acc);
          acc = MFMA16(af[1], (sinpart && !isctx) ? bd[ntl][1] : bs[ntl][1], acc);
#pragma unroll
          for (int r = 0; r < 4; ++r) {
            const int k2row = mt * 16 + lq * 4 + r, k2 = k2row & 63, part = k2row >> 6;
            const int tk = c * 64 + nt * 16 + lr;
            if (isctx) ((bf16_t*)(p.ws + OFF_BTFTC))[((size_t)(b * 256 + g * 64 + k2)) * 512 + part * 256 + tk] = f2bf(acc[r]);
            else {
              const int n1 = tk - LC;
              if (part == 0 || n1 < 2048) ((bf16_t*)(p.ws + OFF_BTFT))[((size_t)(b * 256 + g * 64 + k2)) * 4160 + part * 2112 + n1] = f2bf(acc[r]);
            }
          }
        }
      }
      }
    }
  }
}

DI int dn_step(int c, int d) { return c < 4 ? (d ? 3 - c : c) : 4 + (d ? 67 - c : c - 4); }

DI void dnprep_item(const Params& p, int l, int item, char* smem, char* dsm0) {
  const int b = item / (4 * NCH), h = (item / NCH) & 3, c = item % NCH;
  bf16_t* qb = (bf16_t*)smem;
  bf16_t* kb = qb + 64 * 72;
  float* kf = (float*)(smem + 18432);
  float* vf = kf + 4096;
  float* Am = kf;
  int tid_ = ltid();
  const int tid = tid_, lane = tid & 63, w = tid >> 6, lr = lane & 15, lq = lane >> 4;
  const int tok0 = b * TB + c * 64;
  const bool isctx = c < 4;
  const int sbeg = isctx ? b * TB : b * TB + LC, send = isctx ? b * TB + LC : (b + 1) * TB;
  const bf16_t* P = (const bf16_t*)(p.ws + OFF_P);
  const int tau = tid >> 2, cq = tid & 3;
  const int t = tok0 + tau;
  float qv[16], kv[16], vv[16];
  __syncthreads();
#pragma unroll
  for (int part = 0; part < 3; ++part) {
    const int col = part * 256 + h * 64 + cq * 16;
    const float* cw = p.conv_w + (size_t)l * 3 * 768 + col;
    const bool hasp = t - 1 >= sbeg, hasn = t + 1 < send;
    const u32x4 z4 = {0u, 0u, 0u, 0u};
    const u32x4 a1l = *(const u32x4*)(P + (size_t)t * PW + col), a1h = *(const u32x4*)(P + (size_t)t * PW + col + 8);
    u32x4 a0l = z4, a0h = z4, a2l = z4, a2h = z4;
    if (hasp) { a0l = *(const u32x4*)(P + (size_t)(t - 1) * PW + col); a0h = *(const u32x4*)(P + (size_t)(t - 1) * PW + col + 8); }
    if (hasn) { a2l = *(const u32x4*)(P + (size_t)(t + 1) * PW + col); a2h = *(const u32x4*)(P + (size_t)(t + 1) * PW + col + 8); }
#pragma unroll
    for (int e = 0; e < 16; ++e) {
      const unsigned w0 = e < 8 ? a0l[(e & 7) >> 1] : a0h[(e & 7) >> 1];
      const unsigned w1 = e < 8 ? a1l[(e & 7) >> 1] : a1h[(e & 7) >> 1];
      const unsigned w2 = e < 8 ? a2l[(e & 7) >> 1] : a2h[(e & 7) >> 1];
      const float x0 = (e & 1) ? bfhi(w0) : bflo(w0);
      const float x1 = (e & 1) ? bfhi(w1) : bflo(w1);
      const float x2 = (e & 1) ? bfhi(w2) : bflo(w2);
      const float y = x0 * cw[e] + x1 * cw[768 + e] + x2 * cw[1536 + e];
      const float sv = silu_f(y);
      if (part == 0) qv[e] = sv; else if (part == 1) kv[e] = sv; else vv[e] = sv;
    }
    asm volatile("" ::: "memory");
  }
  {
    float sq = 0.f, sk = 0.f;
#pragma unroll
    for (int e = 0; e < 16; ++e) { sq += qv[e] * qv[e]; sk += kv[e] * kv[e]; }
    sq += __shfl_xor(sq, 1); sq += __shfl_xor(sq, 2);
    sk += __shfl_xor(sk, 1); sk += __shfl_xor(sk, 2);
    const float rq = rsqrtf(sq + EPS) * 0.125f, rk = rsqrtf(sk + EPS);
#pragma unroll
    for (int e = 0; e < 16; ++e) { qv[e] *= rq; kv[e] *= rk; }
  }
  float* gl = (float*)(dsm0 + (ltid_full() >> 8) * HALF_SMEM + 18432 + 32768);
  float* bl = gl + 128;
  float* gc = bl + 128;
  float* bd = gc + 128;
  if (tid < 128) {
    const int d = tid >> 6, i = tid & 63, ta = d ? 63 - i : i;
    const bf16_t* pr = P + (size_t)(tok0 + ta) * PW + 768;
    const float a = bf2f(pr[d * 4 + h]), bb = bf2f(pr[8 + d * 4 + h]);
    const float xx = a + p.dt_bias[l * 8 + d * 4 + h];
    const float ex = __expf(xx);
    const float sp = xx > 20.f ? xx : (ex < 0.03f ? ex * (1.f - ex * (0.5f - ex * (1.f / 3.f - 0.25f * ex))) : __logf(1.f + ex));
    float v = -__expf(p.A_log[l * 8 + d * 4 + h]) * sp;
#pragma unroll
    for (int off = 1; off < 64; off <<= 1) {
      const float tq = __shfl_up(v, off);
      if (i >= off) v += tq;
    }
    gc[d * 64 + i] = v;
    bd[d * 64 + i] = 1.f / (1.f + __expf(-bb));
  }
  {
#pragma unroll
    for (int e = 0; e < 16; e += 4) {
      *(uint2*)(qb + tau * 72 + cq * 16 + e) = uint2{pk(qv[e], qv[e + 1]), pk(qv[e + 2], qv[e + 3])};
      *(uint2*)(kb + tau * 72 + cq * 16 + e) = uint2{pk(kv[e], kv[e + 1]), pk(kv[e + 2], kv[e + 3])};
      *(float4*)(kf + tau * 64 + cq * 16 + e) = float4{kv[e], kv[e + 1], kv[e + 2], kv[e + 3]};
      *(float4*)(vf + tau * 64 + cq * 16 + e) = float4{vv[e], vv[e + 1], vv[e + 2], vv[e + 3]};
    }
  }
  __syncthreads();
#pragma unroll
  for (int d = 0; d < 2; ++d) {
    const int i = d ? 63 - tau : tau;
    const int cb = ((b * 4 + h) * 2 + d) * NCH + dn_step(c, d);
    bf16_t* base = (bf16_t*)(p.ws + OFF_DN + (size_t)cb * SZ_CB);
    const float eg = __expf(gc[d * 64 + i]);
    bf16_t* qd = base + 4096 + i * 64;
#pragma unroll
    for (int q4 = 0; q4 < 4; ++q4) {
      const int pos = (cq >> 1) * 32 + q4 * 8 + (cq & 1) * 4;
      *(uint2*)(qd + pos) = uint2{pk(qv[q4 * 4] * eg, qv[q4 * 4 + 1] * eg), pk(qv[q4 * 4 + 2] * eg, qv[q4 * 4 + 3] * eg)};
    }
  }
#pragma unroll
  for (int d = 0; d < 2; ++d) {
    const int cb = ((b * 4 + h) * 2 + d) * NCH + dn_step(c, d);
    bf16_t* kt = (bf16_t*)(p.ws + OFF_DN + (size_t)cb * SZ_CB) + 3 * 4096 + tau * 64 + cq * 16;
    const float gl63 = gc[d * 64 + 63];
    unsigned o[8];
#pragma unroll
    for (int e2 = 0; e2 < 8; ++e2) {
      float vals[2];
#pragma unroll
      for (int hq = 0; hq < 2; ++hq) {
        const int e = e2 * 2 + hq;
        const int i = (2 * (cq >> 1) + ((e >> 2) & 1)) * 16 + ((((cq & 1) << 1) | (e >> 3)) << 2) + (e & 3);
        const int ta = d ? 63 - i : i;
        vals[hq] = kf[ta * 64 + tau] * __expf(gl63 - gc[d * 64 + i]);
      }
      o[e2] = pk(vals[0], vals[1]);
    }
    *(uint4*)kt = uint4{o[0], o[1], o[2], o[3]};
    *(uint4*)(kt + 8) = uint4{o[4], o[5], o[6], o[7]};
  }
  if (tid < 128) {
    const int d = tid >> 6;
    const int cb = ((b * 4 + h) * 2 + d) * NCH + dn_step(c, d);
    ((float*)(p.ws + OFF_GEND))[(size_t)cb * 64 + (tid & 63)] = __expf(gc[d * 64 + 63]);
  }
  f32x4 KK[4], QK[4];
  {
    bf16x8 ak[2], aq[2];
#pragma unroll
    for (int ks = 0; ks < 2; ++ks) {
      ak[ks] = *(const bf16x8*)(kb + (w * 16 + lr) * 72 + ks * 32 + lq * 8);
      aq[ks] = *(const bf16x8*)(qb + (w * 16 + lr) * 72 + ks * 32 + lq * 8);
    }
#pragma unroll
    for (int nt = 0; nt < 4; ++nt) {
      KK[nt] = f32x4{0.f, 0.f, 0.f, 0.f};
      QK[nt] = f32x4{0.f, 0.f, 0.f, 0.f};
#pragma unroll
      for (int ks = 0; ks < 2; ++ks) {
        const bf16x8 bk = *(const bf16x8*)(kb + (nt * 16 + lr) * 72 + ks * 32 + lq * 8);
        KK[nt] = MFMA16(ak[ks], bk, KK[nt]);
        QK[nt] = MFMA16(aq[ks], bk, QK[nt]);
      }
    }
  }
  const int sd = w >> 1, half = w & 1;
  float xs[64];
#pragma unroll
  for (int i = 0; i < 64; ++i) {
    const int ta = sd ? 63 - i : i;
    const float bt = bd[sd * 64 + i];
    xs[i] = half ? kf[ta * 64 + lane] * bt * __expf(gc[sd * 64 + i]) : vf[ta * 64 + lane] * bt;
    if ((i & 7) == 7) asm volatile("" ::: "memory");
  }
  __syncthreads();
#pragma unroll
  for (int d = 0; d < 2; ++d) {
    const int cb = ((b * 4 + h) * 2 + d) * NCH + dn_step(c, d);
    bf16_t* inb = (bf16_t*)(p.ws + OFF_DN + (size_t)cb * SZ_CB) + 2 * 4096;
#pragma unroll
    for (int nt = 0; nt < 4; ++nt)
#pragma unroll
      for (int r = 0; r < 4; ++r) {
        const int ti = w * 16 + lq * 4 + r, tj = nt * 16 + lr;
        const int i = d ? 63 - ti : ti, j = d ? 63 - tj : tj;
        const float dec = (i >= j) ? __expf(gc[d * 64 + i] - gc[d * 64 + j]) : 0.f;
        Am[d * 4096 + i * 64 + j] = (i > j) ? bd[d * 64 + i] * KK[nt][r] * dec : 0.f;
        inb[i * 64 + permk(j)] = f2bf(QK[nt][r] * dec);
        if (r == 3) asm volatile("" ::: "memory");
      }
  }
  __syncthreads();
  {
    const float* Ad = Am + sd * 4096;
    f32x4 an[16];
    an[0] = *(const f32x4*)(Ad + 1 * 64);
#pragma unroll
    for (int i = 1; i < 64; ++i) {
      f32x4 ac[16];
#pragma unroll
      for (int j4 = 0; j4 <= (i - 1) / 4; ++j4) ac[j4] = an[j4];
      if (i + 1 < 64) {
#pragma unroll
        for (int j4 = 0; j4 <= i / 4; ++j4) an[j4] = *(const f32x4*)(Ad + (i + 1) * 64 + j4 * 4);
      }
      float sacc = xs[i];
#pragma unroll
      for (int j4 = 0; j4 <= (i - 1) / 4; ++j4) {
        sacc -= ac[j4][0] * xs[j4 * 4];
        sacc -= ac[j4][1] * xs[j4 * 4 + 1];
        sacc -= ac[j4][2] * xs[j4 * 4 + 2];
        sacc -= ac[j4][3] * xs[j4 * 4 + 3];
      }
      xs[i] = sacc;
      asm volatile("" ::: "memory");
    }
    const int cb = ((b * 4 + h) * 2 + sd) * NCH + dn_step(c, sd);
    bf16_t* base = (bf16_t*)(p.ws + OFF_DN + (size_t)cb * SZ_CB);
    if (half == 0) {
      bf16_t* U = base + 4 * 4096;
#pragma unroll
      for (int i4 = 0; i4 < 16; ++i4) {
        const int mt = i4 >> 2, q4 = i4 & 3;
        *(uint2*)(U + ((((mt * 4 + (lane >> 4)) * 4 + q4) * 16 + (lane & 15)) << 2)) = uint2{pk(xs[i4 * 4], xs[i4 * 4 + 1]), pk(xs[i4 * 4 + 2], xs[i4 * 4 + 3])};
      }
    } else {
      bf16_t* Wn = base;
      const int pc = permk(lane);
#pragma unroll
      for (int i = 0; i < 64; ++i) Wn[i * 64 + pc] = f2bf(-xs[i]);
    }
  }
}

DI bf16x8 pack8(const f32x4& a, const f32x4& b) {
  uint4 u = {pk(a[0], a[1]), pk(a[2], a[3]), pk(b[0], b[1]), pk(b[2], b[3])};
  return __builtin_bit_cast(bf16x8, u);
}

DI void dnscan_item(const Params& p, int item, LAS char* lb) {
  const int b = item >> 3, h = (item >> 1) & 3, d = item & 1;
  int tid_ = ltid();
  const int lane = tid_ & 63, w = tid_ >> 6, lr = lane & 15, lq = lane >> 4;
  f32x4 S[4];
#pragma unroll
  for (int mt = 0; mt < 4; ++mt) S[mt] = f32x4{0.f, 0.f, 0.f, 0.f};
  const int cb0 = ((b * 4 + h) * 2 + d) * NCH;
  unsigned pfacc = 0u;
  int soff[8];
#pragma unroll
  for (int i = 0; i < 8; ++i) {
    const int j = w * 512 + i * 64 + lane, jj = j & 511, row = jj >> 3, ch = jj & 7;
    soff[i] = (j >> 9) * 4096 + row * 64 + ((ch ^ (row & 7)) << 3);
  }
#define SC_STAGE(buf, step)                                                                                                                   \
  do {                                                                                                                                        \
    const bf16_t* gb_ = (const bf16_t*)(p.ws + OFF_DN + (size_t)(cb0 + (step)) * SZ_CB);                                                       \
    _Pragma("unroll") for (int i = 0; i < 8; ++i)                                                                                             \
      __builtin_amdgcn_global_load_lds((const unsigned*)(gb_ + soff[i]), (LAS unsigned*)(lb + (buf) * 32768 + (w * 512 + i * 64) * 16), 16, 0, 0); \
  } while (0)
  int foff[4][2];
#pragma unroll
  for (int mt = 0; mt < 4; ++mt)
#pragma unroll
    for (int ks = 0; ks < 2; ++ks) { const int row = mt * 16 + lr; foff[mt][ks] = row * 128 + (((ks * 4 + lq) ^ (row & 7)) << 4); }
  SC_STAGE(0, 0);
  uint2 uu[4];
  float ge;
  {
    const bf16_t* base = (const bf16_t*)(p.ws + OFF_DN + (size_t)cb0 * SZ_CB);
#pragma unroll
    for (int mt = 0; mt < 4; ++mt) uu[mt] = *(const uint2*)(base + 4 * 4096 + ((((mt * 4 + w) * 4 + lq) * 16 + lr) << 2));
    ge = ((const float*)(p.ws + OFF_GEND))[(size_t)cb0 * 64 + lane];
  }
  WAIT_V(0);
#pragma unroll 1
  for (int s = 0; s < NCH; ++s) {
    WAIT_V(8);
    __syncthreads();
    if (s + 1 < NCH) SC_STAGE((s + 1) & 1, s + 1);
    uint2 un[4] = {uu[0], uu[1], uu[2], uu[3]};
    float gn = ge;
    if (s + 1 < NCH) {
      const bf16_t* nb = (const bf16_t*)(p.ws + OFF_DN + (size_t)(cb0 + s + 1) * SZ_CB);
#pragma unroll
      for (int mt = 0; mt < 4; ++mt) un[mt] = *(const uint2*)(nb + 4 * 4096 + ((((mt * 4 + w) * 4 + lq) * 16 + lr) << 2));
      gn = ((const float*)(p.ws + OFF_GEND))[(size_t)(cb0 + s + 1) * 64 + lane];
    }
    unsigned pf0 = 0u, pf1 = 0u;
    if (s + 2 < NCH) {
      const unsigned* nb = (const unsigned*)(p.ws + OFF_DN + (size_t)(cb0 + s + 2) * SZ_CB);
      pf0 = nb[(w * 80 + lane) * 32];
      if (lane < 16) pf1 = nb[(w * 80 + 64 + lane) * 32];
    }
    const LAS char* sb = lb + (s & 1) * 32768;
    bf16x8 sB[2];
    sB[0] = pack8(S[0], S[1]);
    sB[1] = pack8(S[2], S[3]);
    f32x4 vn[4], o[4];
#pragma unroll
    for (int mt = 0; mt < 4; ++mt) {
      vn[mt] = f32x4{bflo(uu[mt].x), bfhi(uu[mt].x), bflo(uu[mt].y), bfhi(uu[mt].y)};
      o[mt] = f32x4{0.f, 0.f, 0.f, 0.f};
#pragma unroll
      for (int ks = 0; ks < 2; ++ks) {
        const bf16x8 aw = *(const LAS bf16x8*)(sb + foff[mt][ks]);
        const bf16x8 aq = *(const LAS bf16x8*)(sb + 8192 + foff[mt][ks]);
        vn[mt] = MFMA16(aw, sB[ks], vn[mt]);
        o[mt] = MFMA16(aq, sB[ks], o[mt]);
      }
    }
    bf16x8 vB[2];
    vB[0] = pack8(vn[0], vn[1]);
    vB[1] = pack8(vn[2], vn[3]);
#pragma unroll
    for (int mt = 0; mt < 4; ++mt) {
#pragma unroll
      for (int r = 0; r < 4; ++r) S[mt][r] *= ge;
#pragma unroll
      for (int ks = 0; ks < 2; ++ks) {
        const bf16x8 ai = *(const LAS bf16x8*)(sb + 16384 + foff[mt][ks]);
        const bf16x8 ak = *(const LAS bf16x8*)(sb + 24576 + foff[mt][ks]);
        o[mt] = MFMA16(ai, vB[ks], o[mt]);
        S[mt] = MFMA16(ak, vB[ks], S[mt]);
      }
    }
    pfacc ^= pf0 ^ pf1;
#pragma unroll
    for (int mt = 0; mt < 4; ++mt) uu[mt] = un[mt];
    ge = gn;
    int dl = d;
    asm volatile("" : "+v"(dl));
    float* Od = (float*)(p.ws + OFF_ODN) + (size_t)dl * T * 256;
    const int c = s < 4 ? (d ? 3 - s : s) : 4 + (d ? 67 - s : s - 4);
#pragma unroll
    for (int mt = 0; mt < 4; ++mt)
#pragma unroll
      for (int r = 0; r < 4; ++r) {
        const int i = mt * 16 + lq * 4 + r;
        const int ta = d ? 63 - i : i;
        Od[((size_t)(b * TB + c * 64 + ta)) * 256 + h * 64 + w * 16 + lr] = o[mt][r];
      }
  }
#undef SC_STAGE
  __syncthreads();
  if (pfacc == 0x9e3779b9u && ((const float*)(p.ws + OFF_GEND))[0] == 123.456f) ((float*)(p.ws + OFF_ODN))[0] = 0.f;
}

DI void attn_item(const Params& p, int l, int type, int b, int kvh, int qb, char* smem) {
  constexpr int KB = 64 * 64 * 2, VB = 64 * 72 * 2, SB = KB + VB;
  int tid_ = ltid();
  const int tid = tid_, lane = tid & 63, w = tid >> 6, lr = lane & 15, lq = lane >> 4;
  const int g = w >> 1, qh = kvh * 2 + g;
  const int qloc0 = qb * 64 + (w & 1) * 32;
  const bool isctx = qb < 4;
  const bf16_t* Qa = (const bf16_t*)(p.ws + OFF_QA) + ((size_t)type * T + (size_t)b * TB) * 256 + qh * 64;
  const bf16_t* Kg = (const bf16_t*)(p.ws + OFF_KA) + ((size_t)type * T + (size_t)b * TB) * 128 + kvh * 64;
  const bf16_t* Vg = (const bf16_t*)(p.ws + OFF_VT) + ((size_t)(type * NB + b) * 128 + kvh * 64) * TB;
  bf16x8 qf[2][2];
#pragma unroll
  for (int nt = 0; nt < 2; ++nt)
#pragma unroll
    for (int ks = 0; ks < 2; ++ks) qf[nt][ks] = *(const bf16x8*)(Qa + (size_t)(qloc0 + nt * 16 + lr) * 256 + ks * 32 + lq * 8);
  float neg_big;
  asm volatile("v_mov_b32 %0, 0xf149f2ca" : "=v"(neg_big));
  float mrun[2];
  f32x4 O[4][2], Ls[2];
  const bf16x8 ones8 = {(short)0x3F80, (short)0x3F80, (short)0x3F80, (short)0x3F80, (short)0x3F80, (short)0x3F80, (short)0x3F80, (short)0x3F80};
#pragma unroll
  for (int nt = 0; nt < 2; ++nt) {
    if (type == 1) { mrun[nt] = p.wa_sink[l * 4 + qh] * LOG2E; Ls[nt] = f32x4{1.f, 1.f, 1.f, 1.f}; }
    else { mrun[nt] = neg_big; Ls[nt] = f32x4{0.f, 0.f, 0.f, 0.f}; }
#pragma unroll
    for (int mt = 0; mt < 4; ++mt) O[mt][nt] = f32x4{0.f, 0.f, 0.f, 0.f};
  }
  const int n_lat_lo = (!isctx && type == 1) ? qb - 2 : 4;
  const int ntiles = isctx ? 4 : (type == 0 ? NCH : 9);
  const int lrow = tid >> 3, lch = tid & 7;
  u32x4 rk[2], rv[2];
#pragma unroll
  for (int i = 0; i < 2; ++i) {
    rk[i] = *(const u32x4*)(Kg + (size_t)(lrow + i * 32) * 128 + lch * 8);
    rv[i] = *(const u32x4*)(Vg + (size_t)(lrow + i * 32) * TB + lch * 8);
  }
#pragma unroll
  for (int i = 0; i < 2; ++i) {
    const int r = lrow + i * 32;
    *(u32x4*)(smem + r * 128 + ((lch ^ (r & 7)) << 4)) = rk[i];
    *(u32x4*)(smem + KB + r * 144 + lch * 16) = rv[i];
  }
  __syncthreads();
  for (int ti = 0; ti < ntiles; ++ti) {
    const int jraw = ti < 4 ? ti : n_lat_lo + (ti - 4);
    const bool tvalid = ti < 4 || (jraw >= 4 && jraw < NCH);
    const int jt = ti < 4 ? ti : (jraw < 4 ? 4 : (jraw > NCH - 1 ? NCH - 1 : jraw));
    const char* sK = smem + (ti & 1) * SB;
    const char* sV = sK + KB;
    if (ti + 1 < ntiles) {
      const int jn0 = (ti + 1) < 4 ? ti + 1 : n_lat_lo + (ti + 1 - 4);
      const int jn = (ti + 1) < 4 ? jn0 : (jn0 < 4 ? 4 : (jn0 > NCH - 1 ? NCH - 1 : jn0));
#pragma unroll
      for (int i = 0; i < 2; ++i) {
        rk[i] = *(const u32x4*)(Kg + (size_t)(jn * 64 + lrow + i * 32) * 128 + lch * 8);
        rv[i] = *(const u32x4*)(Vg + (size_t)(lrow + i * 32) * TB + jn * 64 + lch * 8);
      }
    }
    f32x4 sc[4][2];
#pragma unroll
    for (int mt = 0; mt < 4; ++mt) {
      const int r = mt * 16 + lr;
      const bf16x8 kf0 = *(const bf16x8*)(sK + r * 128 + ((lq ^ (r & 7)) << 4));
      const bf16x8 kf1 = *(const bf16x8*)(sK + r * 128 + (((4 + lq) ^ (r & 7)) << 4));
#pragma unroll
      for (int nt = 0; nt < 2; ++nt) {
        f32x4 a = {0.f, 0.f, 0.f, 0.f};
        a = MFMA16(kf0, qf[nt][0], a);
        a = MFMA16(kf1, qf[nt][1], a);
        sc[mt][nt] = a;
      }
    }
    const bool domask = (type == 1) && !isctx && (jt >= 4);
#pragma unroll
    for (int nt = 0; nt < 2; ++nt) {
      if (domask) {
#pragma unroll
        for (int mt = 0; mt < 4; ++mt)
#pragma unroll
          for (int r = 0; r < 4; ++r) {
            const int kpos = jt * 64 + mt * 16 + lq * 4 + r, qpos = qloc0 + nt * 16 + lr;
            const int df = qpos - kpos;
            if (df > 128 || df < -128 || !tvalid) sc[mt][nt][r] = neg_big;
          }
      }
      float mx = fmaxf(fmaxf(sc[0][nt][0], sc[0][nt][1]), fmaxf(sc[0][nt][2], sc[0][nt][3]));
#pragma unroll
      for (int mt = 1; mt < 4; ++mt) mx = fmaxf(mx, fmaxf(fmaxf(sc[mt][nt][0], sc[mt][nt][1]), fmaxf(sc[mt][nt][2], sc[mt][nt][3])));
      mx = fmaxf(mx, __shfl_xor(mx, 16));
      mx = fmaxf(mx, __shfl_xor(mx, 32));
      if (__builtin_amdgcn_ballot_w64(mx > mrun[nt] + 8.f) != 0ull) {
        const float mnew = fmaxf(mrun[nt], mx);
        const float alpha = __builtin_amdgcn_exp2f(mrun[nt] - mnew);
        mrun[nt] = mnew;
#pragma unroll
        for (int r = 0; r < 4; ++r) Ls[nt][r] *= alpha;
#pragma unroll
        for (int mt = 0; mt < 4; ++mt)
#pragma unroll
          for (int r = 0; r < 4; ++r) O[mt][nt][r] *= alpha;
      }
      const float mref = mrun[nt];
#pragma unroll
      for (int mt = 0; mt < 4; ++mt)
#pragma unroll
        for (int r = 0; r < 4; ++r) sc[mt][nt][r] = __builtin_amdgcn_exp2f(sc[mt][nt][r] - mref);
    }
    bf16x8 pB[2][2];
#pragma unroll
    for (int nt = 0; nt < 2; ++nt) {
      pB[nt][0] = pack8(sc[0][nt], sc[1][nt]);
      pB[nt][1] = pack8(sc[2][nt], sc[3][nt]);
      Ls[nt] = MFMA16(ones8, pB[nt][0], Ls[nt]);
      Ls[nt] = MFMA16(ones8, pB[nt][1], Ls[nt]);
    }
#pragma unroll
    for (int mt = 0; mt < 4; ++mt)
#pragma unroll
      for (int ks = 0; ks < 2; ++ks) {
        const bf16x4 v0 = *(const bf16x4*)(sV + (mt * 16 + lr) * 144 + ((2 * ks) * 16 + lq * 4) * 2);
        const bf16x4 v1 = *(const bf16x4*)(sV + (mt * 16 + lr) * 144 + ((2 * ks + 1) * 16 + lq * 4) * 2);
        const bf16x8 vfr = __builtin_shufflevector(v0, v1, 0, 1, 2, 3, 4, 5, 6, 7);
#pragma unroll
        for (int nt = 0; nt < 2; ++nt) O[mt][nt] = MFMA16(vfr, pB[nt][ks], O[mt][nt]);
      }
    if (ti + 1 < ntiles) {
      char* dK = smem + ((ti + 1) & 1) * SB;
#pragma unroll
      for (int i = 0; i < 2; ++i) {
        const int r = lrow + i * 32;
        *(u32x4*)(dK + r * 128 + ((lch ^ (r & 7)) << 4)) = rk[i];
        *(u32x4*)(dK + KB + r * 144 + lch * 16) = rv[i];
      }
    }
    __syncthreads();
  }
  bf16_t* Y = (bf16_t*)(p.ws + OFF_YMIX);
#pragma unroll
  for (int nt = 0; nt < 2; ++nt) {
    const float inv = 1.f / Ls[nt][0];
    const size_t row = (size_t)b * TB + qloc0 + nt * 16 + lr;
#pragma unroll
    for (int mt = 0; mt < 4; ++mt) {
      uint2 v = {pk(O[mt][nt][0] * inv, O[mt][nt][1] * inv), pk(O[mt][nt][2] * inv, O[mt][nt][3] * inv)};
      *(uint2*)(Y + row * 1024 + (type ? 512 : 256) + qh * 64 + mt * 16 + lq * 4) = v;
    }
  }
}

DI void dnmerge_item(const Params& p, int l, int item) {
  const int tid = ltid();
  const int w = tid >> 6, lane = tid & 63;
  const int t = item * 4 + w;
  const float* o0 = (const float*)(p.ws + OFF_ODN) + (size_t)t * 256 + lane * 4;
  const float* o1 = o0 + (size_t)T * 256;
  const float4 a = *(const float4*)o0, bq = *(const float4*)o1;
  float v[4] = {a.x + bq.x, a.y + bq.y, a.z + bq.z, a.w + bq.w};
  float ss = v[0] * v[0] + v[1] * v[1] + v[2] * v[2] + v[3] * v[3];
  ss += __shfl_xor(ss, 1); ss += __shfl_xor(ss, 2); ss += __shfl_xor(ss, 4); ss += __shfl_xor(ss, 8);
  const float rs = rsqrtf(ss * (1.f / 64.f) + EPS);
  const int dim = (lane & 15) * 4;
  const float4 gn = *(const float4*)(p.dn_norm_g + l * 64 + dim);
  const uint2 zz = *(const uint2*)((const bf16_t*)(p.ws + OFF_Z) + (size_t)t * 256 + lane * 4);
  const float z0 = bflo(zz.x), z1 = bfhi(zz.x), z2 = bflo(zz.y), z3 = bfhi(zz.y);
  const float y0 = v[0] * rs * gn.x * silu_f(z0), y1 = v[1] * rs * gn.y * silu_f(z1), y2 = v[2] * rs * gn.z * silu_f(z2), y3 = v[3] * rs * gn.w * silu_f(z3);
  *(uint2*)((bf16_t*)(p.ws + OFF_YMIX) + (size_t)t * 1024 + lane * 4) = uint2{pk(y0, y1), pk(y2, y3)};
  if (lane == 0) { ((float*)(p.ws + OFF_RSS1))[t] = 0.f; ((float*)(p.ws + OFF_RSS2))[t] = 0.f; }
}


#define XB_TMO      128
#define XB_XCNT(j)  (256  + 64 * (j))
#define XB_XSUB(j)  (1280 + 64 * (j))
#define XB_XGEN(j)  (2304 + 64 * (j))
#define XB_TOP      3328
#define XB_TOPGEN   3392
#define XCD_BAR_WORDS 3456
#define XB_SPIN_CAP (1u << 18)
DI unsigned xb_ld(unsigned* p) { return __hip_atomic_load(p, __ATOMIC_RELAXED, __HIP_MEMORY_SCOPE_AGENT); }
DI unsigned xb_add(unsigned* p, unsigned v) { return __hip_atomic_fetch_add(p, v, __ATOMIC_RELAXED, __HIP_MEMORY_SCOPE_AGENT); }
DI unsigned xb_xcc_id() { return (unsigned)__builtin_amdgcn_s_getreg((3 << 11) | 20) & 0xFu; }
#define XB_SPIN(cond, bar) do { unsigned _sp = 0; while (cond) { __builtin_amdgcn_s_sleep(1); \
    if ((++_sp & 255u) == 0u) { if (xb_ld(&(bar)[XB_TMO])) break; if (_sp > XB_SPIN_CAP) { atomicAdd(&(bar)[XB_TMO], 1u); break; } } } } while (0)
struct XcdBarrier { unsigned* bar; unsigned x; volatile LAS unsigned* st; };
DI XcdBarrier xcd_barrier_post(unsigned* bar, volatile LAS unsigned* st) {
  XcdBarrier b; b.bar = bar; b.x = xb_xcc_id(); b.st = st;
  if (threadIdx.x == 0) (void)xb_add(&bar[XB_XCNT(b.x)], 1u);
  return b;
}
DI void xcd_barrier_complete(unsigned* bar, unsigned x, unsigned& nloc, unsigned& nx) {
  const unsigned G = gridDim.x * gridDim.y * gridDim.z;
  unsigned sum, cnt, mine, sp = 0u;
  for (;;) {
    sum = 0u; cnt = 0u; mine = 0u;
#pragma unroll
    for (unsigned j = 0; j < 16; ++j) { const unsigned c = xb_ld(&bar[XB_XCNT(j)]); sum += c; cnt += (c > 0u) ? 1u : 0u; mine = (j == x) ? c : mine; }
    if (sum == G) break;
    __builtin_amdgcn_s_sleep(1);
    if ((++sp & 255u) == 0u) { if (xb_ld(&bar[XB_TMO])) break; if (sp > XB_SPIN_CAP) { atomicAdd(&bar[XB_TMO], 1u); break; } }
  }
  nloc = mine > 0u ? mine : 1u; nx = cnt > 0u ? cnt : 1u;
}
DI void xcd_barrier(const XcdBarrier& b) {
  asm volatile("s_waitcnt vmcnt(0)" ::: "memory");
  __syncthreads();
  if (ltid_full() == 0) {
    unsigned* bar = b.bar;
    asm volatile("" : "+s"(bar));
    __builtin_amdgcn_s_waitcnt(0);
    unsigned nloc = b.st[0], nx = b.st[1];
    if (nloc == 0u) { xcd_barrier_complete(bar, b.x, nloc, nx); b.st[0] = nloc; b.st[1] = nx; }
    const unsigned old = xb_add(&bar[XB_XSUB(b.x)], 1u);
    const unsigned gen = old / nloc;
    if (old + 1u == (gen + 1u) * nloc) {
      __builtin_amdgcn_fence(__ATOMIC_RELEASE, "agent");
      asm volatile("s_waitcnt vmcnt(0)" ::: "memory");
      const unsigned og = xb_add(&bar[XB_TOP], 1u);
      const unsigned tg = og / nx;
      if (og + 1u == (tg + 1u) * nx) xb_add(&bar[XB_TOPGEN], 1u);
      else XB_SPIN(xb_ld(&bar[XB_TOPGEN]) == tg, bar);
      __builtin_amdgcn_fence(__ATOMIC_ACQUIRE, "agent");
      xb_add(&bar[XB_XGEN(b.x)], 1u);
      asm volatile("s_waitcnt vmcnt(0)" ::: "memory");
    } else {
      XB_SPIN(xb_ld(&bar[XB_XGEN(b.x)]) == gen, bar);
      __builtin_amdgcn_fence(__ATOMIC_ACQUIRE, "agent");
      asm volatile("s_waitcnt vmcnt(0)" ::: "memory");
    }
  }
  __syncthreads();
}


DI Params load_params(const volatile LAS unsigned* sp) {
  Params q;
  unsigned long long* dst = (unsigned long long*)&q;
#pragma unroll
  for (int i = 0; i < (int)(sizeof(Params) / 8); ++i) {
    const unsigned lo = (unsigned)__builtin_amdgcn_readfirstlane((int)sp[2 * i]), hi = (unsigned)__builtin_amdgcn_readfirstlane((int)sp[2 * i + 1]);
    dst[i] = ((unsigned long long)hi << 32) | lo;
  }
  return q;
}
#define GSYNC() do { XcdBarrier xb_; xb_.bar = (unsigned*)(q.ws + OFF_BAR); xb_.x = xb_xcc_id(); xb_.st = (volatile LAS unsigned*)&xb_words; xcd_barrier(xb_); } while (0)
__global__ void __launch_bounds__(512, 2) mega(Params p) {
  extern __shared__ __attribute__((aligned(1024))) char dsm[];
  __shared__ uint4 xb_words;
  __shared__ int s_item;
  cg::grid_group grid = cg::this_grid();
  __shared__ unsigned sparams[sizeof(Params) / 4];
  if (threadIdx.x == 0) xb_words = make_uint4(0u, 0u, 0u, 0u);
  if (threadIdx.x < sizeof(Params) / 4) sparams[threadIdx.x] = ((const unsigned*)&p)[threadIdx.x];
  __syncthreads();
  (void)xcd_barrier_post((unsigned*)(p.ws + OFF_BAR), (volatile LAS unsigned*)&xb_words);
  const int nblk = gridDim.x, bid = blockIdx.x;
  LAS char* lds = (LAS char*)dsm;
  phase0(p, dsm);
#if EXP == 6
  __syncthreads();
  phase0(p, dsm);
#endif
  grid.sync();
  for (int l = 0; l < 4; ++l) {
    Params q = load_params((const volatile LAS unsigned*)sparams);
#define RELAUNDER() q = load_params((const volatile LAS unsigned*)sparams)
#define Hb ((const bf16_t*)(q.ws + OFF_HB))
    RELAUNDER();
    if (l == 0) {
      { const int hf = ltid_full() >> 8; char* smem = dsm + hf * HALF_SMEM; (void)smem;
      for (int pi = bid; pi < (T / 4 + 16 * 40) / 2; pi += nblk) {
        const int it = pi * 2 + hf;
        if (it < T / 4) norm_item(q, it);
        else { const int j = it - T / 4; wconv_tile<true>(q.w_in, nullptr, 2320, 1024, (bf16_t*)(q.ws + OFF_WIN), 0, j % 16, j / 16, smem, (const float*)(q.ws + OFF_MOD), (float*)(q.ws + OFF_BIAS1), 2560); }
      }
      }
      GSYNC();
    }
    RELAUNDER();
    gemm_phase8<EP_P>(q, l, Hb, (const bf16_t*)(q.ws + OFF_WIN), 1024, 136, 10, lds, 2);
#if EXP == 1
    gemm_phase<EP_P>(q, l, Hb, 1024, (const bf16_t*)(q.ws + OFF_WIN), 1024, 1024, 136, 10, lds);
#endif
    GSYNC();
    RELAUNDER();
    {
      int* ctrc = (int*)(q.ws + OFF_CTR) + 8 + l;
      constexpr int NPAIR = (NB * 4 * NCH + NB * NCH) / 2;
      while (true) {
        __syncthreads();
        if (ltid_full() == 0) s_item = atomicAdd(ctrc, 1);
        __syncthreads();
        const int pi = s_item;
        if (pi >= NPAIR) break;
        const int hf = ltid_full() >> 8; char* smem = dsm + hf * HALF_SMEM;
        const int it = pi * 2 + hf;
        if (it < NB * 4 * NCH) dnprep_item(q, l, it, smem, dsm);
        else aprep_item(q, l, it - NB * 4 * NCH, smem);
      }
    }
    GSYNC();
    RELAUNDER();
    {
    {
#if EXP == 2
      for (int rep = 0; rep < 2; ++rep) {
      int* ctr = (int*)(q.ws + OFF_CTR) + l + rep * 8;
#else
      {
      int* ctr = (int*)(q.ws + OFF_CTR) + l;
#endif
      constexpr int N_SCAN = 32, N_FT = 128, N_FTC = 8, N_GA = 512, N_WA = 512, N_CTXA = 64;
      constexpr int N_WO = 16 * 16 / 2, N_GU = 16 * 88 / 2, N_WD = 44 * 16 / 2, N_WI = 16 * 40 / 2;
      const int n_ctxa = l < 3 ? N_CTXA : 0;
      const int TOT = N_SCAN + N_FT + N_FTC + N_GA + N_WA + n_ctxa + N_WO + N_GU + N_WD + (l < 3 ? N_WI : 0);
      while (true) {
        __syncthreads();
        if (ltid_full() == 0) s_item = atomicAdd(ctr, 1);
        __syncthreads();
        int it = s_item;
        if (it >= TOT) break;
        const int hf = ltid_full() >> 8; char* smem = dsm + hf * HALF_SMEM;
        if (it < N_SCAN) { dnscan_item(q, it * 2 + hf, lds + hf * 65536); continue; }
        it -= N_SCAN;
        if (it < N_FT) { gemm8<EP_FT>(q, l, (const bf16_t*)(q.ws + OFF_ADFT), 4160, (const bf16_t*)(q.ws + OFF_BTFT), 4160, 4160, (it >> 3) * 256, (it & 7) * 256, lds); continue; }
        it -= N_FT;
        if (it < N_FTC) { gemm8<EP_FTC>(q, l, (const bf16_t*)(q.ws + OFF_ADFTC), 512, (const bf16_t*)(q.ws + OFF_BTFTC), 512, 512, 0, it * 256, lds); continue; }
        it -= N_FTC;
        if (it < N_GA) { const int j = it * 2 + hf; attn_item(q, l, 0, j >> 7, (j >> 6) & 1, 4 + (j & 63), smem); continue; }
        it -= N_GA;
        if (it < N_WA) { const int j = it * 2 + hf; attn_item(q, l, 1, j >> 7, (j >> 6) & 1, 4 + (j & 63), smem); continue; }
        it -= N_WA;
        if (it < n_ctxa) { const int j = it * 2 + hf; const int type = j >> 6, r = j & 63; attn_item(q, l, type, r >> 3, (r >> 2) & 1, r & 3, smem); continue; }
        it -= n_ctxa;
        {
          int j = it * 2 + hf;
          if (j < 2 * N_WO) { wconv_tile<false>(q.w_out + (size_t)l * 1024 * 1024, nullptr, 1024, 1024, (bf16_t*)(q.ws + OFF_WOUT), 0, j % 16, j / 16, smem); continue; }
          j -= 2 * N_WO;
          if (j < 2 * N_GU) { wconv_tile<true>(q.w_gate + (size_t)l * 1024 * HID, q.w_up + (size_t)l * 1024 * HID, HID, 1024, (bf16_t*)(q.ws + OFF_WGU), 1, j % 16, j / 16, smem,
                                     (const float*)(q.ws + OFF_MOD) + (size_t)l * 9 * 6144 + 3072, (float*)(q.ws + OFF_BIAS2) + (size_t)l * 9 * 5632, 5632); continue; }
          j -= 2 * N_GU;
          if (j < 2 * N_WD) { wconv_tile<false>(q.w_down + (size_t)l * HID * 1024, nullptr, 1024, HID, (bf16_t*)(q.ws + OFF_WD), 0, j % 44, j / 44, smem); continue; }
          j -= 2 * N_WD;
          wconv_tile<true>(q.w_in + (size_t)(l + 1) * 1024 * 2320, nullptr, 2320, 1024, (bf16_t*)(q.ws + OFF_WIN), 0, j % 16, j / 16, smem,
                           (const float*)(q.ws + OFF_MOD) + (size_t)(l + 1) * 9 * 6144, (float*)(q.ws + OFF_BIAS1) + (size_t)(l + 1) * 9 * 2560, 2560);
        }
      }
      }
    }
    }
    GSYNC();
    RELAUNDER();
    { const int hf = ltid_full() >> 8; char* smem = dsm + hf * HALF_SMEM; (void)smem;
    {
      for (int pi = bid; pi < T / 8; pi += nblk) dnmerge_item(q, l, pi * 2 + hf);
    }
    }
    GSYNC();
    RELAUNDER();
#if EXP == 1
    gemm_phase<EP_DUMMY>(q, l, (const bf16_t*)(q.ws + OFF_YMIX), 1024, (const bf16_t*)(q.ws + OFF_WOUT), 1024, 1024, 136, 4, lds);
#endif
    gemm_phase8<EP_RES1>(q, l, (const bf16_t*)(q.ws + OFF_YMIX), (const bf16_t*)(q.ws + OFF_WOUT), 1024, l == 3 ? 128 : 136, 4, lds, l == 3 ? 1 : 2);
    GSYNC();
    RELAUNDER();
    gemm_phase8<EP_GU>(q, l, Hb, (const bf16_t*)(q.ws + OFF_WGU), 1024, l == 3 ? 128 : 136, 22, lds, l == 3 ? 1 : 0);
#if EXP == 1
    gemm_phase<EP_GU>(q, l, Hb, 1024, (const bf16_t*)(q.ws + OFF_WGU), 1024, 1024, l == 3 ? 128 : 136, 22, lds, l == 3);
#endif
    GSYNC();
    RELAUNDER();
#if EXP == 1
    gemm_phase<EP_DUMMY>(q, l, (const bf16_t*)(q.ws + OFF_HM), HID, (const bf16_t*)(q.ws + OFF_WD), HID, HID, 136, 4, lds);
#endif
    gemm_phase8<EP_RES2>(q, l, (const bf16_t*)(q.ws + OFF_HM), (const bf16_t*)(q.ws + OFF_WD), HID, l == 3 ? 128 : 136, 4, lds, l == 3 ? 1 : 2);
    GSYNC();
  }
}

#undef Hb
extern "C" void kernel_launch(void* const* d_in, const int* in_sizes, int n_in, void* d_out, int out_size, void* d_ws, size_t ws_size,
                              hipStream_t stream) {
  if (ws_size < WS_NEED) { fprintf(stderr, "workspace too small: %zu < %zu\n", ws_size, (size_t)WS_NEED); return; }
  static int grid_blocks = 0;
  if (!grid_blocks) {
    int dev = 0, cus = 0, per_cu = 0;
    (void)hipGetDevice(&dev);
    (void)hipDeviceGetAttribute(&cus, hipDeviceAttributeMultiprocessorCount, dev);
    if (hipFuncSetAttribute((const void*)mega, hipFuncAttributeMaxDynamicSharedMemorySize, LDS_BYTES) != hipSuccess) fprintf(stderr, "hipFuncSetAttribute failed\n");
    (void)hipOccupancyMaxActiveBlocksPerMultiprocessor(&per_cu, mega, 512, LDS_BYTES);
    if (per_cu < 1) { fprintf(stderr, "occupancy query returned %d\n", per_cu); per_cu = 1; }
    grid_blocks = (cus / 8) * 8;
  }
  Params p{};
  const float** pf = (const float**)&p;
  for (int i = 0; i < 22; ++i) pf[i] = (const float*)d_in[i];
  p.out = (float*)d_out;
  p.ws = (char*)d_ws;
  (void)hipMemsetAsync((char*)d_ws + OFF_BAR, 0, XCD_BAR_WORDS * 4, stream);
  void* args[] = {&p};
  hipError_t e = hipLaunchCooperativeKernel((void*)mega, dim3(grid_blocks), dim3(512), args, LDS_BYTES, stream);
  if (e != hipSuccess) fprintf(stderr, "cooperative launch failed: %s (grid %d)\n", hipGetErrorString(e), grid_blocks);
}
```

```cpp
#include <hip/hip_runtime.h>
#include <hip/hip_cooperative_groups.h>
#include <stdint.h>
#include <stdio.h>
namespace cg = cooperative_groups;

typedef unsigned short bf16_t;
typedef short bf16x8 __attribute__((ext_vector_type(8)));
typedef short bf16x4 __attribute__((ext_vector_type(4)));
typedef float f32x4 __attribute__((ext_vector_type(4)));
typedef unsigned u32x4 __attribute__((ext_vector_type(4)));
#define DI __device__ __forceinline__
#define MFMA16(a, b, c) __builtin_amdgcn_mfma_f32_16x16x32_bf16((a), (b), (c), 0, 0, 0)

constexpr int NB = 8, SEQ = 4096, LC = 256, TB = 4352, T = NB * TB, DM = 1024, PW = 2064, HID = 2816, NCH = 68;
constexpr int NIN_PAD = 2560;
constexpr float EPS = 1e-6f;
constexpr float LOG2E = 1.4426950408889634f;

constexpr size_t OFF_MOD = 0;
constexpr size_t OFF_ROPEC = 1u << 20;
constexpr size_t OFF_ROPES = OFF_ROPEC + 524288;
constexpr size_t OFF_CS64 = OFF_ROPES + 524288;
constexpr size_t OFF_ADFTC = OFF_CS64 + 16384;
constexpr size_t OFF_CTR = OFF_ADFTC + 262144;
constexpr size_t OFF_BAR = OFF_CTR + 4096;
constexpr size_t OFF_XC = 2621440;
constexpr size_t OFF_HB = OFF_XC + 8388608;
constexpr size_t SZ_HB = (size_t)T * 1024 * 2;
constexpr size_t OFF_QA = OFF_HB;
constexpr size_t OFF_KA = OFF_QA + (size_t)2 * T * 256 * 2;
constexpr size_t OFF_VT = OFF_KA + (size_t)2 * T * 128 * 2;
constexpr size_t OFF_P = OFF_HB + SZ_HB;
constexpr size_t SZ_P = (size_t)T * PW * 2;
constexpr size_t OFF_YMIX = OFF_P;
constexpr size_t OFF_ODN = OFF_P + SZ_HB;
constexpr size_t OFF_Z = OFF_P + SZ_P;
constexpr size_t OFF_BTFT = OFF_Z + (size_t)T * 256 * 2;
constexpr size_t OFF_BTFTC = OFF_BTFT + (size_t)2048 * 8192 * 2;
constexpr size_t OFF_HM = OFF_P;
constexpr size_t OFF_ADFT = OFF_BTFTC + (size_t)2048 * 512 * 2;
constexpr size_t OFF_RSS1 = OFF_ADFT + (size_t)4096 * 4160 * 2;
constexpr size_t OFF_RSS2 = OFF_RSS1 + (size_t)T * 4;
constexpr size_t OFF_BIAS1 = OFF_RSS2 + (size_t)T * 4;
constexpr size_t OFF_BIAS2 = OFF_BIAS1 + (size_t)4 * 9 * 2560 * 4;
constexpr size_t OFF_DN = OFF_ADFT + (size_t)4096 * 8192 * 2;
constexpr size_t SZ_CB = 40960;
constexpr int NCB = NB * 4 * 2 * NCH;
constexpr size_t OFF_GEND = OFF_DN + (size_t)NCB * SZ_CB;
constexpr size_t WS_NEED = OFF_GEND + (size_t)NCB * 64 * 4;
constexpr size_t OFF_WIN = OFF_BIAS2 + (size_t)4 * 9 * 5632 * 4;
constexpr size_t OFF_WOUT = OFF_WIN + (size_t)NIN_PAD * 1024 * 2;
constexpr size_t OFF_WGU = OFF_WOUT + (size_t)1024 * 1024 * 2;
constexpr size_t OFF_WD = OFF_WGU + (size_t)5632 * 1024 * 2;
static_assert(OFF_WD + (size_t)1024 * 2816 * 2 <= OFF_ADFT + (size_t)4096 * 8192 * 2, "weights overflow the ADFT region tail");
static_assert((size_t)T * HID * 2 <= OFF_ADFT - OFF_P, "Hm alias overflow");

struct Params {
  const float *x, *c, *ctx, *c_ctx, *norm1_g, *norm2_g, *w_ada, *b_ada, *w_in, *conv_w, *A_log, *dt_bias, *dn_norm_g,
      *ga_qn, *ga_kn, *wa_qn, *wa_kn, *wa_sink, *w_out, *w_gate, *w_up, *w_down;
  float* out;
  char* ws;
};

constexpr int HALF_SMEM = 53248;
constexpr int LDS_BYTES = 131072 + 8192;
#define LAS __attribute__((address_space(3)))
#define WAIT_V(n) asm volatile("s_waitcnt vmcnt(%0)" ::"n"(n) : "memory")

DI unsigned pk(float a, float b) {
  typedef __bf16 bf2 __attribute__((ext_vector_type(2)));
  typedef float f2 __attribute__((ext_vector_type(2)));
  f2 v = {a, b};
  bf2 r = __builtin_convertvector(v, bf2);
  return __builtin_bit_cast(unsigned, r);
}
DI bf16_t f2bf(float a) { return (bf16_t)(pk(a, 0.f) & 0xffffu); }
DI float bf2f(bf16_t h) { return __uint_as_float(((unsigned)h) << 16); }
DI float bflo(unsigned u) { return __uint_as_float(u << 16); }
DI float bfhi(unsigned u) { return __uint_as_float(u & 0xffff0000u); }
DI int ltid_full() { int t = threadIdx.x; asm volatile("" : "+v"(t)); return t; }
DI int ltid() { return ltid_full() & 255; }
DI float silu_f(float x) { return x * __builtin_amdgcn_rcpf(1.f + __expf(-x)); }
DI int permk(int x) { return ((x >> 5) << 5) + (((x >> 2) & 3) << 3) + (((x >> 4) & 1) << 2) + (x & 3); }

DI float* xrow(const Params& p, int t) {
  int b = t / TB, tb = t - b * TB;
  return tb < LC ? (float*)(p.ws + OFF_XC) + ((size_t)(b * LC + tb)) * DM : p.out + ((size_t)(b * SEQ + tb - LC)) * DM;
}
DI const float* xrow_in(const Params& p, int t) {
  int b = t / TB, tb = t - b * TB;
  return tb < LC ? p.ctx + ((size_t)(b * LC + tb)) * DM : p.x + ((size_t)(b * SEQ + tb - LC)) * DM;
}
DI int bidx_of(int t) { const int b = t / TB, tb = t - b * TB; return tb < LC ? 8 : b; }
DI const float* modrow(const Params& p, int l, int t) {
  int b = t / TB, tb = t - b * TB;
  int bi = tb < LC ? 8 : b;
  return (const float*)(p.ws + OFF_MOD) + ((size_t)(l * 9 + bi)) * 6144;
}

enum { EP_P = 0, EP_RES1 = 1, EP_GU = 2, EP_RES2 = 3, EP_FT = 4, EP_FTC = 5, EP_DUMMY = 6 };
#ifndef EXP
#define EXP 0
#endif

DI int lds_byte(int r, int c) {
  const int st = (r >> 4) * 2 + (c >> 5), ob = (r & 15) * 64 + (c & 31) * 2;
  return st * 1024 + (ob ^ (((ob >> 9) & 1) << 5));
}
DI void stage_rc(int b, int& R, int& C) {
  const int st = b >> 10, sb = b & 1023, swz = sb ^ (((sb >> 9) & 1) << 5);
  R = (st >> 1) * 16 + swz / 64;
  C = (st & 1) * 32 + (swz % 64) / 2;
}

template <int MODE>
DI void gemm_epilogue(const Params& p, int l, const f32x4 (&acc)[8][4], int m0, int n0, int wr, int wc, int fr, int fq, const LAS float* cst) {
#pragma unroll
  for (int i = 0; i < 8; ++i) {
    const int m = m0 + wr * 128 + i * 16 + fr;
    if (MODE == EP_P) {
      bf16_t* Pp = (bf16_t*)(p.ws + OFF_P) + (size_t)m * PW;
      bf16_t* Zp = (bf16_t*)(p.ws + OFF_Z) + (size_t)m * 256;
      const float rs = rsqrtf(cst[wr * 128 + i * 16 + fr] * (1.f / 1024.f) + EPS);
#pragma unroll
      for (int j = 0; j < 4; ++j) {
        const int n = n0 + wc * 64 + j * 16 + fq * 4;
        const f32x4 bq = *(const LAS f32x4*)(cst + 256 + wc * 64 + j * 16 + fq * 4);
        uint2 v = {pk(acc[i][j][0] * rs + bq[0], acc[i][j][1] * rs + bq[1]), pk(acc[i][j][2] * rs + bq[2], acc[i][j][3] * rs + bq[3])};
        if (n < 768) *(uint2*)(Pp + n) = v;
        else if (n < 1024) *(uint2*)(Zp + (n - 768)) = v;
        else if (n < 2320) *(uint2*)(Pp + (n - 256)) = v;
      }
    } else if (MODE == EP_RES1 || MODE == EP_RES2) {
      float* xo = xrow(p, m);
      const bool emit = (MODE == EP_RES1) || (l < 3);
      bf16_t* hb = (bf16_t*)(p.ws + OFF_HB) + (size_t)m * 1024;
      float4 xv[4];
#pragma unroll
      for (int j = 0; j < 4; ++j) xv[j] = *(const float4*)(xo + n0 + wc * 64 + j * 16 + fq * 4);
      float ssq = 0.f;
#pragma unroll
      for (int j = 0; j < 4; ++j) {
        const int n = n0 + wc * 64 + j * 16 + fq * 4;
        const f32x4 gq = *(const LAS f32x4*)(cst + 256 + wc * 64 + j * 16 + fq * 4), mq = *(const LAS f32x4*)(cst + 512 + wc * 64 + j * 16 + fq * 4);
        const float4 gv = {gq[0], gq[1], gq[2], gq[3]}, mv = {mq[0], mq[1], mq[2], mq[3]};
        xv[j].x += gv.x * acc[i][j][0]; xv[j].y += gv.y * acc[i][j][1]; xv[j].z += gv.z * acc[i][j][2]; xv[j].w += gv.w * acc[i][j][3];
        *(float4*)(xo + n) = xv[j];
        if (emit) {
          ssq += xv[j].x * xv[j].x + xv[j].y * xv[j].y + xv[j].z * xv[j].z + xv[j].w * xv[j].w;
          *(uint2*)(hb + n) = uint2{pk(xv[j].x * mv.x, xv[j].y * mv.y), pk(xv[j].z * mv.z, xv[j].w * mv.w)};
        }
      }
      if (emit) {
        ssq += __shfl_xor(ssq, 16);
        ssq += __shfl_xor(ssq, 32);
        if (fq == 0) unsafeAtomicAdd((float*)(p.ws + (MODE == EP_RES1 ? OFF_RSS2 : OFF_RSS1)) + m, ssq);
      }
    } else if (MODE == EP_GU) {
      bf16_t* hp = (bf16_t*)(p.ws + OFF_HM) + (size_t)m * HID;
      const float rs = rsqrtf(cst[wr * 128 + i * 16 + fr] * (1.f / 1024.f) + EPS);
#pragma unroll
      for (int jj = 0; jj < 2; ++jj) {
        const int hcol = ((n0 + wc * 64) >> 1) + jj * 16 + fq * 4;
        const f32x4 bg = *(const LAS f32x4*)(cst + 256 + wc * 64 + (2 * jj) * 16 + fq * 4), bu = *(const LAS f32x4*)(cst + 256 + wc * 64 + (2 * jj + 1) * 16 + fq * 4);
        const float bgv[4] = {bg[0], bg[1], bg[2], bg[3]}, buv[4] = {bu[0], bu[1], bu[2], bu[3]};
        float o[4];
#pragma unroll
        for (int r = 0; r < 4; ++r) o[r] = silu_f(acc[i][2 * jj][r] * rs + bgv[r]) * (acc[i][2 * jj + 1][r] * rs + buv[r]);
        uint2 v = {pk(o[0], o[1]), pk(o[2], o[3])};
        *(uint2*)(hp + hcol) = v;
      }
    } else if (MODE == EP_DUMMY) {
      bf16_t* dp = (bf16_t*)(p.ws + OFF_DN + (size_t)40 * 1024 * 1024) + (size_t)m * 1024;
#pragma unroll
      for (int j = 0; j < 4; ++j) {
        const int n = n0 + wc * 64 + j * 16 + fq * 4;
        *(uint2*)(dp + n) = uint2{pk(acc[i][j][0], acc[i][j][1]), pk(acc[i][j][2], acc[i][j][3])};
      }
    } else {
      bf16_t* Y = (bf16_t*)(p.ws + OFF_YMIX);
      const float scale = (MODE == EP_FT) ? (1.f / 512.f) : (1.f / 128.f);
#pragma unroll
      for (int j = 0; j < 4; ++j) {
        const int n = n0 + wc * 64 + j * 16 + fq * 4;
        const int b = n >> 8;
        const size_t row = (size_t)b * TB + (MODE == EP_FT ? LC : 0) + m;
        uint2 v = {pk(acc[i][j][0] * scale, acc[i][j][1] * scale), pk(acc[i][j][2] * scale, acc[i][j][3] * scale)};
        *(uint2*)(Y + row * 1024 + 768 + (n & 255)) = v;
      }
    }
  }
}

constexpr int G8_TILE_B = 256 * 64 * 2, G8_STAGE_B = 2 * G8_TILE_B;
#define G8_STAGE(Ab_, Bb_, buf, kt)                                                                                                            \
  do {                                                                                                                                        \
    _Pragma("unroll") for (int i = 0; i < 4; ++i) {                                                                                           \
      __builtin_amdgcn_global_load_lds((const unsigned*)((Ab_) + offA[i] + (kt) * 64), (LAS unsigned*)(lds + (buf) * G8_STAGE_B + wid * 1024 + i * 8192), 16, 0, 0);               \
      __builtin_amdgcn_global_load_lds((const unsigned*)((Bb_) + offB[i] + (kt) * 64), (LAS unsigned*)(lds + (buf) * G8_STAGE_B + G8_TILE_B + wid * 1024 + i * 8192), 16, 0, 0);   \
    }                                                                                                                                         \
  } while (0)
#define G8_COMPUTE(buf)                                                                                                                       \
  do {                                                                                                                                        \
    const LAS char* sa = lds + (buf) * G8_STAGE_B;                                                                                            \
    const LAS char* sb = sa + G8_TILE_B;                                                                                                      \
    _Pragma("unroll") for (int ks = 0; ks < 2; ++ks) {                                                                                        \
      bf16x8 bfr[4];                                                                                                                          \
      _Pragma("unroll") for (int j = 0; j < 4; ++j) bfr[j] = *(const LAS bf16x8*)(sb + lds_byte(wc * 64 + j * 16 + fr, ks * 32 + fq * 8));    \
      bf16x8 a_cur = *(const LAS bf16x8*)(sa + lds_byte(wr * 128 + fr, ks * 32 + fq * 8));                                                    \
      _Pragma("unroll") for (int i = 0; i < 8; ++i) {                                                                                         \
        bf16x8 a_nxt = a_cur;                                                                                                                 \
        if (i < 7) a_nxt = *(const LAS bf16x8*)(sa + lds_byte(wr * 128 + (i + 1) * 16 + fr, ks * 32 + fq * 8));          \
        _Pragma("unroll") for (int j = 0; j < 4; ++j) acc[i][j] = MFMA16(bfr[j], a_cur, acc[i][j]);                                           \
        __builtin_amdgcn_sched_group_barrier(0x100, 1, 0);                                                                                    \
        __builtin_amdgcn_sched_group_barrier(0x008, 4, 0);                                                                                    \
        a_cur = a_nxt;                                                                                                                        \
      }                                                                                                                                       \
    }                                                                                                                                         \
  } while (0)
#define G8_SETUP()                                                                                                                            \
  const int tid = ltid_full(), wid = tid >> 6, lane = tid & 63;                                                                               \
  const int wr = wid >> 2, wc = wid & 3, fr = lane & 15, fq = lane >> 4;                                                                      \
  int offA[4], offB[4];                                                                                                                       \
  _Pragma("unroll") for (int i = 0; i < 4; ++i) {                                                                                             \
    int R, C;                                                                                                                                 \
    stage_rc(wid * 1024 + i * 8192 + lane * 16, R, C);                                                                                        \
    offA[i] = R * lda + C;                                                                                                                    \
    offB[i] = R * ldb + C;                                                                                                                    \
  }

template <int MODE>
DI void gemm8(const Params& p, int l, const bf16_t* A, int lda, const bf16_t* Bt, int ldb, int K, int m0, int n0, LAS char* lds) {
  G8_SETUP();
  f32x4 acc[8][4];
#pragma unroll
  for (int i = 0; i < 8; ++i)
#pragma unroll
    for (int j = 0; j < 4; ++j) acc[i][j] = f32x4{0.f, 0.f, 0.f, 0.f};
  const bf16_t* Ab = A + (size_t)m0 * lda;
  const bf16_t* Bb = Bt + (size_t)n0 * ldb;
  const int nt = K >> 6;
  G8_STAGE(Ab, Bb, 0, 0);
  WAIT_V(0);
  __syncthreads();
  for (int t = 0; t < nt; ++t) {
    const int cur = t & 1;
    if (t + 1 < nt) G8_STAGE(Ab, Bb, cur ^ 1, t + 1);
    G8_COMPUTE(cur);
    WAIT_V(0);
    __syncthreads();
  }
  gemm_epilogue<MODE>(p, l, acc, m0, n0, wr, wc, fr, fq, (const LAS float*)(lds + 131072));
}

struct GTile { int m0, n0, kb, nk, atomic; };
template <int MODE>
DI bool gemm_next_tile(int k, int nM, int nN, int Kit, GTile& g, bool skipctx = false) {
  const int ntl = nM * nN, per = ntl >> 3;
  const int nb8 = gridDim.x >> 3, xcd = blockIdx.x & 7, j = blockIdx.x >> 3;
  const int R = per / nb8, rem = per - R * nb8;
  int loc;
  g.kb = 0; g.nk = Kit; g.atomic = 0;
  if (k < R) loc = k * nb8 + j;
  else if (k == R && rem > 0) {
    int S = 1;
    if (false) { S = nb8 / rem; while (S > 1 && (Kit % S)) --S; }
    if (j >= rem * S) return false;
    loc = R * nb8 + j / S;
    if (S > 1) { g.nk = Kit / S; g.kb = (j % S) * g.nk; g.atomic = 1; }
  } else return false;
  const int L = xcd * per + loc;
  const int nig = 8 * nN, gid = L / nig, fm = gid * 8, gsz = (nM - fm) < 8 ? (nM - fm) : 8;
  int pm = fm + ((L % nig) % gsz);
  if (skipctx) pm += pm / 16 + 1;
  g.m0 = pm * 256;
  g.n0 = ((L % nig) / gsz) * 256;
  return true;
}

template <int MODE>
DI void gemm_phase(const Params& p, int l, const bf16_t* A, int lda, const bf16_t* Bt, int ldb, int K, int nM, int nN, LAS char* lds, bool skipctx = false) {
  G8_SETUP();
  const int Kit = K >> 6;
  GTile cur, nxt;
  bool have = gemm_next_tile<MODE>(0, nM, nN, Kit, cur, skipctx);
  if (have) G8_STAGE(A + (size_t)cur.m0 * lda, Bt + (size_t)cur.n0 * ldb, 0, cur.kb);
  for (int k = 0; have; ++k) {
    const bool hn = gemm_next_tile<MODE>(k + 1, nM, nN, Kit, nxt, skipctx);
    f32x4 acc[8][4];
#pragma unroll
    for (int i = 0; i < 8; ++i)
#pragma unroll
      for (int j = 0; j < 4; ++j) acc[i][j] = f32x4{0.f, 0.f, 0.f, 0.f};
    const bf16_t* Ab = A + (size_t)cur.m0 * lda;
    const bf16_t* Bb = Bt + (size_t)cur.n0 * ldb;
    LAS float* cst = (LAS float*)(lds + 131072 + (k & 1) * 4096);
    if (MODE == EP_P || MODE == EP_GU) {
      const float* rss = (const float*)(p.ws + (MODE == EP_P ? OFF_RSS1 : OFF_RSS2));
      const float* bias = (const float*)(p.ws + (MODE == EP_P ? OFF_BIAS1 : OFF_BIAS2)) + ((size_t)(l * 9 + bidx_of(cur.m0))) * (MODE == EP_P ? 2560 : 5632);
      cst[tid] = tid < 256 ? rss[cur.m0 + tid] : bias[cur.n0 + tid - 256];
    }
    if (MODE == EP_RES1 || MODE == EP_RES2) {
      const float* mrow = modrow(p, l, cur.m0);
      const int c = cur.n0 + (tid & 255);
      if (tid < 256) cst[256 + tid] = mrow[(MODE == EP_RES1 ? 2048 : 5120) + c];
      else {
        const float* ng = (MODE == EP_RES1) ? p.norm2_g + l * 1024 : p.norm1_g + (l < 3 ? l + 1 : 0) * 1024;
        const float* nsc = (MODE == EP_RES1) ? mrow + 4096 : modrow(p, l < 3 ? l + 1 : 0, cur.m0) + 1024;
        cst[256 + tid] = ng[c] * (1.f + nsc[c]);
      }
    }
    WAIT_V(0);
    __syncthreads();
    for (int t = 0; t < cur.nk; ++t) {
      const int cb = t & 1;
      if (t + 1 < cur.nk) G8_STAGE(Ab, Bb, cb ^ 1, cur.kb + t + 1);
      G8_COMPUTE(cb);
      WAIT_V(0);
      __syncthreads();
    }
    if (hn) G8_STAGE(A + (size_t)nxt.m0 * lda, Bt + (size_t)nxt.n0 * ldb, 0, nxt.kb);
    gemm_epilogue<MODE>(p, l, acc, cur.m0, cur.n0, wr, wc, fr, fq, cst);
    cur = nxt;
    have = hn;
  }
}

template <int MODE>
DI void gemm_epilogue8(const Params& p, int l, const f32x4 (&acc)[2][2][4][2], int m0, int n0, int wr, int wc, int fr, int fq, const LAS float* cst, bool half) {
#pragma unroll
  for (int ai = 0; ai < 2; ++ai)
#pragma unroll
    for (int mm = 0; mm < 4; ++mm) {
      if (ai == 1 && half) continue;
      const int rl = ai * 128 + wr * 64 + mm * 16 + fr;
      const int m = m0 + rl;
      if (MODE == EP_P) {
        bf16_t* Pp = (bf16_t*)(p.ws + OFF_P) + (size_t)m * PW;
        bf16_t* Zp = (bf16_t*)(p.ws + OFF_Z) + (size_t)m * 256;
        const float rs = rsqrtf(cst[rl] * (1.f / 1024.f) + EPS);
#pragma unroll
        for (int bj = 0; bj < 2; ++bj)
#pragma unroll
          for (int nn = 0; nn < 2; ++nn) {
            const int cl = bj * 128 + wc * 32 + nn * 16 + fq * 4, n = n0 + cl;
            const f32x4 bq = *(const LAS f32x4*)(cst + 256 + cl);
            const f32x4& a = acc[ai][bj][mm][nn];
            uint2 v = {pk(a[0] * rs + bq[0], a[1] * rs + bq[1]), pk(a[2] * rs + bq[2], a[3] * rs + bq[3])};
            if (n < 768) *(uint2*)(Pp + n) = v;
            else if (n < 1024) *(uint2*)(Zp + (n - 768)) = v;
            else if (n < 2320) *(uint2*)(Pp + (n - 256)) = v;
          }
      } else if (MODE == EP_RES1 || MODE == EP_RES2) {
        float* xo = xrow(p, m);
        const bool emit = (MODE == EP_RES1) || (l < 3);
        bf16_t* hb = (bf16_t*)(p.ws + OFF_HB) + (size_t)m * 1024;
        float4 xv[4];
#pragma unroll
        for (int q4 = 0; q4 < 4; ++q4) xv[q4] = *(const float4*)(xo + n0 + (q4 >> 1) * 128 + wc * 32 + (q4 & 1) * 16 + fq * 4);
        float ssq = 0.f;
#pragma unroll
        for (int q4 = 0; q4 < 4; ++q4) {
          const int cl = (q4 >> 1) * 128 + wc * 32 + (q4 & 1) * 16 + fq * 4, n = n0 + cl;
          const f32x4 gq = *(const LAS f32x4*)(cst + 256 + cl), mq = *(const LAS f32x4*)(cst + 512 + cl);
          const f32x4& a = acc[ai][q4 >> 1][mm][q4 & 1];
          xv[q4].x += gq[0] * a[0]; xv[q4].y += gq[1] * a[1]; xv[q4].z += gq[2] * a[2]; xv[q4].w += gq[3] * a[3];
          *(float4*)(xo + n) = xv[q4];
          if (emit) {
            ssq += xv[q4].x * xv[q4].x + xv[q4].y * xv[q4].y + xv[q4].z * xv[q4].z + xv[q4].w * xv[q4].w;
            *(uint2*)(hb + n) = uint2{pk(xv[q4].x * mq[0], xv[q4].y * mq[1]), pk(xv[q4].z * mq[2], xv[q4].w * mq[3])};
          }
        }
        if (emit) {
          ssq += __shfl_xor(ssq, 16);
          ssq += __shfl_xor(ssq, 32);
          if (fq == 0) unsafeAtomicAdd((float*)(p.ws + (MODE == EP_RES1 ? OFF_RSS2 : OFF_RSS1)) + m, ssq);
        }
      } else if (MODE == EP_GU) {
        bf16_t* hp = (bf16_t*)(p.ws + OFF_HM) + (size_t)m * HID;
        const float rs = rsqrtf(cst[rl] * (1.f / 1024.f) + EPS);
#pragma unroll
        for (int bj = 0; bj < 2; ++bj) {
          const int cl = bj * 128 + wc * 32 + fq * 4;
          const int hcol = ((n0 + bj * 128 + wc * 32) >> 1) + fq * 4;
          const f32x4 bg = *(const LAS f32x4*)(cst + 256 + cl), bu = *(const LAS f32x4*)(cst + 256 + cl + 16);
          const f32x4& ag = acc[ai][bj][mm][0];
          const f32x4& au = acc[ai][bj][mm][1];
          float o[4];
#pragma unroll
          for (int r = 0; r < 4; ++r) o[r] = silu_f(ag[r] * rs + bg[r]) * (au[r] * rs + bu[r]);
          *(uint2*)(hp + hcol) = uint2{pk(o[0], o[1]), pk(o[2], o[3])};
        }
      } else {
        bf16_t* dp = (bf16_t*)(p.ws + OFF_DN + (size_t)40 * 1024 * 1024) + (size_t)m * 1024;
#pragma unroll
        for (int q4 = 0; q4 < 4; ++q4) {
          const f32x4& a = acc[ai][q4 >> 1][mm][q4 & 1];
          *(uint2*)(dp + n0 + (q4 >> 1) * 128 + wc * 32 + (q4 & 1) * 16 + fq * 4) = uint2{pk(a[0], a[1]), pk(a[2], a[3])};
        }
      }
    }
}

DI bool next_tile8(int k, int nM, int nN, int Kit, GTile& g, int ctxmode) {
  if (ctxmode != 2) return gemm_next_tile<EP_P>(k, nM, nN, Kit, g, ctxmode == 1);
  if (gemm_next_tile<EP_P>(k, 128, nN, Kit, g, true)) return true;
  const int nb8 = gridDim.x >> 3, per = 16 * nN, R = per / nb8, kx = R + ((per - R * nb8) > 0 ? 1 : 0);
  const int j = blockIdx.x >> 3;
  if (k != kx || j >= 2 * nN) return false;
  const int u = (blockIdx.x & 7) * (2 * nN) + j;
  g.m0 = (blockIdx.x & 7) * 17 * 256 + ((j / nN) & 1) * 128;
  g.n0 = (j % nN) * 256;
  g.kb = 0; g.nk = Kit; g.atomic = 1;
  (void)u;
  return true;
}

template <int MODE>
DI void gemm_phase8(const Params& p, int l, const bf16_t* A, const bf16_t* Bt, int K, int nM, int nN, LAS char* lds, int ctxmode) {
  constexpr int HT = 128 * 64;
  const int tid = ltid_full(), wid = tid >> 6, lane = tid & 63;
  const int wr = wid >> 2, wc = wid & 3, fr = lane & 15, fq = lane >> 4;
  unsigned soff[2];
#pragma unroll
  for (int i = 0; i < 2; ++i) { int R, C; stage_rc(tid * 16 + i * 8192, R, C); soff[i] = (unsigned)(R * K + C) * 2u; }
#define P8_SA(b, h) (lds + (((b) * 2 + (h)) * HT) * 2)
#define P8_SB(b, h) (lds + ((4 + (b) * 2 + (h)) * HT) * 2)
#define P8_STAGE(P_, BASE_, br_, kt_)                                                                                                          \
  do {                                                                                                                                        \
    const unsigned long long _gi = (unsigned long long)((BASE_) + (size_t)(br_) * K + (size_t)(kt_) * 64);                                       \
    const char* _g = (const char*)(((unsigned long long)(unsigned)__builtin_amdgcn_readfirstlane((int)(_gi >> 32)) << 32) |                    \
                                   (unsigned)__builtin_amdgcn_readfirstlane((int)(unsigned)_gi));     \
    _Pragma("unroll") for (int _i = 0; _i < 2; ++_i)                                                                                          \
      __builtin_amdgcn_global_load_lds((const unsigned*)(_g + soff[_i]), (LAS unsigned*)((P_) + wid * 1024 + _i * 8192), 16, 0, 0);            \
  } while (0)
#define P8_LDA(dst, b, h)                                                                                                                     \
  _Pragma("unroll") for (int m_ = 0; m_ < 4; ++m_) _Pragma("unroll") for (int k_ = 0; k_ < 2; ++k_)                                           \
    dst[m_][k_] = *(const LAS bf16x8*)(P8_SA(b, h) + lds_byte(wr * 64 + m_ * 16 + fr, k_ * 32 + fq * 8))
#define P8_LDB(dst, b, h)                                                                                                                     \
  _Pragma("unroll") for (int n_ = 0; n_ < 2; ++n_) _Pragma("unroll") for (int k_ = 0; k_ < 2; ++k_)                                           \
    dst[n_][k_] = *(const LAS bf16x8*)(P8_SB(b, h) + lds_byte(wc * 32 + n_ * 16 + fr, k_ * 32 + fq * 8))
#define P8_MMA(ai, bj, At_, Bt_)                                                                                                              \
  do {                                                                                                                                        \
    __builtin_amdgcn_s_setprio(1);                                                                                                            \
    _Pragma("unroll") for (int m_ = 0; m_ < 4; ++m_) _Pragma("unroll") for (int n_ = 0; n_ < 2; ++n_) _Pragma("unroll") for (int k_ = 0; k_ < 2; ++k_) \
      acc[ai][bj][m_][n_] = MFMA16(Bt_[n_][k_], At_[m_][k_], acc[ai][bj][m_][n_]);                                                            \
    __builtin_amdgcn_s_setprio(0);                                                                                                            \
  } while (0)
#define P8_MMA_B1(ai, bj, At_, Bt_) do { if (!skipb1 && !((ai) == 1 && half)) P8_MMA(ai, bj, At_, Bt_); } while (0)
#define P8_MMA_A1(ai, bj, At_, Bt_) do { if (!half) P8_MMA(ai, bj, At_, Bt_); } while (0)
#define P8_WAIT_L(n) asm volatile("s_waitcnt lgkmcnt(%0)" ::"n"(n) : "memory")
#define P8_BAR __builtin_amdgcn_s_barrier()
#define P8_SCHED __builtin_amdgcn_sched_barrier(0)
  const int nt = K >> 6;
  GTile cur;
  for (int k = 0; next_tile8(k, nM, nN, nt, cur, ctxmode); ++k) {
    const int brow = cur.m0, bcol = cur.n0;
    const bool half = cur.atomic != 0;
    const bool skipb1 = (MODE == EP_P) && (bcol + 128 >= 2320);
    LAS float* cst = (LAS float*)(lds + 131072 + (k & 1) * 4096);
    if (MODE == EP_P || MODE == EP_GU) {
      const float* rss = (const float*)(p.ws + (MODE == EP_P ? OFF_RSS1 : OFF_RSS2));
      const float* bias = (const float*)(p.ws + (MODE == EP_P ? OFF_BIAS1 : OFF_BIAS2)) + ((size_t)(l * 9 + bidx_of(brow))) * (MODE == EP_P ? 2560 : 5632);
      cst[tid] = tid < 256 ? rss[brow + tid] : bias[bcol + tid - 256];
    }
    if (MODE == EP_RES1 || MODE == EP_RES2) {
      const float* mrow = modrow(p, l, brow);
      const int c = bcol + (tid & 255);
      if (tid < 256) cst[256 + tid] = mrow[(MODE == EP_RES1 ? 2048 : 5120) + c];
      else {
        const float* ng = (MODE == EP_RES1) ? p.norm2_g + l * 1024 : p.norm1_g + (l < 3 ? l + 1 : 0) * 1024;
        const float* nsc = (MODE == EP_RES1) ? mrow + 4096 : modrow(p, l < 3 ? l + 1 : 0, brow) + 1024;
        cst[256 + tid] = ng[c] * (1.f + nsc[c]);
      }
    }
    f32x4 acc[2][2][4][2];
#pragma unroll
    for (int a_ = 0; a_ < 2; ++a_)
#pragma unroll
      for (int b_ = 0; b_ < 2; ++b_)
#pragma unroll
        for (int m_ = 0; m_ < 4; ++m_)
#pragma unroll
          for (int n_ = 0; n_ < 2; ++n_) acc[a_][b_][m_][n_] = f32x4{0.f, 0.f, 0.f, 0.f};
    bf16x8 At[4][2], B0[2][2], B1[2][2];
    __syncthreads();
    P8_STAGE(P8_SB(0, 0), Bt, bcol, 0); P8_STAGE(P8_SA(0, 0), A, brow, 0);
    P8_STAGE(P8_SB(0, 1), Bt, bcol + 128, 0); P8_STAGE(P8_SA(0, 1), A, brow + 128, 0);
    if (wr == 1) P8_BAR;
    WAIT_V(4); P8_BAR;
    P8_STAGE(P8_SB(1, 0), Bt, bcol, 1); P8_STAGE(P8_SA(1, 0), A, brow, 1); P8_STAGE(P8_SB(1, 1), Bt, bcol + 128, 1);
    WAIT_V(6); P8_BAR;
    for (int t = 0; t < nt - 2; t += 2) {
      P8_LDB(B0, 0, 0); P8_SCHED; P8_LDA(At, 0, 0); P8_STAGE(P8_SA(1, 1), A, brow + 128, t + 1);
      P8_WAIT_L(8); P8_BAR; P8_WAIT_L(0); P8_MMA(0, 0, At, B0); P8_BAR; P8_SCHED;
      P8_LDB(B1, 0, 1); P8_STAGE(P8_SB(0, 0), Bt, bcol, t + 2);
      P8_BAR; P8_WAIT_L(0); P8_MMA_B1(0, 1, At, B1); P8_BAR;
      P8_LDA(At, 0, 1); P8_STAGE(P8_SA(0, 0), A, brow, t + 2);
      P8_BAR; P8_WAIT_L(0); P8_MMA_A1(1, 0, At, B0); P8_BAR; P8_SCHED;
      P8_STAGE(P8_SB(0, 1), Bt, bcol + 128, t + 2);
      WAIT_V(6); P8_BAR; P8_MMA_B1(1, 1, At, B1); P8_BAR;
      P8_LDB(B0, 1, 0); P8_SCHED; P8_LDA(At, 1, 0); P8_STAGE(P8_SA(0, 1), A, brow + 128, t + 2);
      P8_WAIT_L(8); P8_BAR; P8_WAIT_L(0); P8_MMA(0, 0, At, B0); P8_BAR; P8_SCHED;
      P8_LDB(B1, 1, 1); P8_STAGE(P8_SB(1, 0), Bt, bcol, t + 3);
      P8_BAR; P8_WAIT_L(0); P8_MMA_B1(0, 1, At, B1); P8_BAR;
      P8_LDA(At, 1, 1); P8_STAGE(P8_SA(1, 0), A, brow, t + 3);
      P8_BAR; P8_WAIT_L(0); P8_MMA_A1(1, 0, At, B0); P8_BAR; P8_SCHED;
      P8_STAGE(P8_SB(1, 1), Bt, bcol + 128, t + 3);
      WAIT_V(6); P8_BAR; P8_MMA_B1(1, 1, At, B1); P8_BAR;
    }
    { P8_LDB(B0, 0, 0); P8_LDA(At, 0, 0); P8_STAGE(P8_SA(1, 1), A, brow + 128, nt - 1);
      P8_BAR; P8_WAIT_L(0); P8_MMA(0, 0, At, B0); P8_BAR;
      P8_LDB(B1, 0, 1); P8_BAR; P8_WAIT_L(0); P8_MMA_B1(0, 1, At, B1); P8_BAR;
      P8_LDA(At, 0, 1); WAIT_V(4); P8_BAR; P8_WAIT_L(0); P8_MMA_A1(1, 0, At, B0); P8_MMA_B1(1, 1, At, B1); P8_BAR; }
    { P8_LDB(B0, 1, 0); P8_LDA(At, 1, 0); WAIT_V(2); P8_BAR; P8_WAIT_L(0); P8_MMA(0, 0, At, B0); P8_BAR;
      P8_LDB(B1, 1, 1); WAIT_V(0); P8_BAR; P8_WAIT_L(0); P8_MMA_B1(0, 1, At, B1); P8_BAR;
      P8_LDA(At, 1, 1); P8_BAR; P8_WAIT_L(0); P8_MMA_A1(1, 0, At, B0); P8_MMA_B1(1, 1, At, B1); P8_BAR; }
    if (wr == 0) P8_BAR;
    gemm_epilogue8<MODE>(p, l, acc, brow, bcol, wr, wc, fr, fq, cst, half);
  }
}

template <bool BIAS>
DI void wconv_tile(const float* src0, const float* src1, int N, int K, bf16_t* dst, int kind, int kt, int nt, char* smem, const float* shvec = nullptr, float* bias = nullptr, int npad = 0) {
  float* tile = (float*)smem;
  const int tid = ltid();
  __syncthreads();
  {
    const int nn = tid & 63, kk0 = tid >> 6;
    const int R = nt * 64 + nn;
    const float* src = src0;
    int col = R;
    bool ok = true;
    if (kind == 1) {
      const int grp = R >> 5, up = (R >> 4) & 1;
      col = grp * 16 + (R & 15);
      src = up ? src1 : src0;
    } else ok = R < N;
    float wv[16];
#pragma unroll
    for (int i = 0; i < 16; ++i) wv[i] = ok ? src[(size_t)(kt * 64 + kk0 + i * 4) * N + col] : 0.f;
#pragma unroll
    for (int i = 0; i < 16; ++i) tile[(kk0 + i * 4) * 65 + nn] = wv[i];
    if (BIAS) {
      float* svs = tile + 64 * 65;
      for (int o = tid; o < 9 * 64; o += 256) svs[o] = shvec[(size_t)(o >> 6) * 6144 + kt * 64 + (o & 63)];
    }
  }
  __syncthreads();
  {
    const int rr = tid >> 2, kc = (tid & 3) * 16;
    unsigned o[8];
#pragma unroll
    for (int e = 0; e < 8; ++e) o[e] = pk(tile[(kc + 2 * e) * 65 + rr], tile[(kc + 2 * e + 1) * 65 + rr]);
    bf16_t* d = dst + (size_t)(nt * 64 + rr) * K + kt * 64 + kc;
    *(uint4*)d = uint4{o[0], o[1], o[2], o[3]};
    *(uint4*)(d + 8) = uint4{o[4], o[5], o[6], o[7]};
  }
  if (BIAS) {
    for (int o = tid; o < 9 * 64; o += 256) {
      const int bq = o >> 6, nn = o & 63;
      const float* sv = tile + 64 * 65 + bq * 64;
      float a = 0.f;
#pragma unroll 8
      for (int kk = 0; kk < 64; ++kk) a += sv[kk] * tile[kk * 65 + nn];
      unsafeAtomicAdd(bias + (size_t)bq * npad + nt * 64 + nn, a);
    }
  }
}

DI void mod_item(const Params& p, int item, char* smem) {
  const int l = item / 96, cgp = item % 96;
  float* sc = (float*)smem;
  float* red = sc + 9 * 1024;
  const int tid = ltid();
  __syncthreads();
  for (int i = tid; i < 9 * 1024; i += 256) {
    const int r = i >> 10, k = i & 1023;
    const float v = r < 8 ? p.c[r * 1024 + k] : p.c_ctx[k];
    sc[i] = silu_f(v);
  }
  __syncthreads();
  const int kq = tid >> 6, cc = tid & 63, col = cgp * 64 + cc;
  float acc[9];
#pragma unroll
  for (int r = 0; r < 9; ++r) acc[r] = 0.f;
  const float* wp = p.w_ada + (size_t)l * 1024 * 6144 + col;
#pragma unroll 8
  for (int k = kq * 256; k < kq * 256 + 256; ++k) {
    const float wv = wp[(size_t)k * 6144];
#pragma unroll
    for (int r = 0; r < 9; ++r) acc[r] += sc[r * 1024 + k] * wv;
  }
#pragma unroll
  for (int r = 0; r < 9; ++r) red[(kq * 9 + r) * 64 + cc] = acc[r];
  __syncthreads();
  for (int i = tid; i < 9 * 64; i += 256) {
    const int r = i >> 6, c2 = i & 63;
    const float s = red[(0 * 9 + r) * 64 + c2] + red[(1 * 9 + r) * 64 + c2] + red[(2 * 9 + r) * 64 + c2] + red[(3 * 9 + r) * 64 + c2];
    ((float*)(p.ws + OFF_MOD))[((size_t)(l * 9 + r)) * 6144 + cgp * 64 + c2] = s + p.b_ada[l * 6144 + cgp * 64 + c2];
  }
}

DI void phase0(const Params& p, char* smem) {
  const int tid = ltid(), hf = ltid_full() >> 8;
  constexpr int N_MOD_IT = 384, N_ROPE = 512, N_CS = 32, N_ADC = 512, N_AD = 4160;
  constexpr int TOT = N_MOD_IT + N_ROPE + N_CS + N_ADC + N_AD;
  if (blockIdx.x == 0 && hf == 0 && tid < 64) ((int*)(p.ws + OFF_CTR))[tid] = 0;
  for (int i = blockIdx.x * 512 + ltid_full(); i < 4 * 9 * (2560 + 5632); i += gridDim.x * 512) ((float*)(p.ws + OFF_BIAS1))[i] = 0.f;
  for (int pi = blockIdx.x; pi < TOT / 2; pi += gridDim.x) {
    int i = pi * 2 + hf;
    if (i < N_MOD_IT) { mod_item(p, i, smem + hf * HALF_SMEM); continue; }
    i -= N_MOD_IT;
    if (i < N_ROPE) {
      const int e = i * 256 + tid;
      const int pos = e >> 5, f = e & 31;
      const float pv = (f < 16) ? (float)(pos >> 6) : (float)(pos & 63);
      const float invf = powf(10000.f, -(float)(f & 15) / 16.f);
      const float ang = pv * invf;
      float s, c;
      sincosf(ang, &s, &c);
      ((float*)(p.ws + OFF_ROPEC))[e] = c;
      ((float*)(p.ws + OFF_ROPES))[e] = s;
      continue;
    }
    i -= N_ROPE;
    if (i < N_CS) {
      const int e = i * 256 + tid;
      const int r = e >> 6, n2 = e & 63;
      const int idx = ((r & 63) * n2) & 63;
      float s, c;
      sincospif((float)idx / 32.f, &s, &c);
      ((bf16_t*)(p.ws + OFF_CS64))[e] = f2bf(r < 64 ? c : s);
      continue;
    }
    i -= N_CS;
    if (i < N_ADC) {
      const int e = i * 256 + tid;
      const int k1 = e >> 9, cc = e & 511, n1 = cc & 255;
      const int idx = (k1 * n1) & 255;
      float s, c;
      sincospif((float)idx / 128.f, &s, &c);
      ((bf16_t*)(p.ws + OFF_ADFTC))[e] = f2bf(cc < 256 ? c : -s);
      continue;
    }
    i -= N_ADC;
    if (i < N_AD) {
      const size_t e0 = (size_t)i * 4096 + (size_t)tid * 16;
      const int k1 = (int)(e0 / 4160), c0 = (int)(e0 % 4160);
      unsigned o[8];
#pragma unroll
      for (int e = 0; e < 8; ++e) {
        float v[2];
#pragma unroll
        for (int h = 0; h < 2; ++h) {
          const int cc = c0 + 2 * e + h;
          const int n1 = cc < 2112 ? cc : cc - 2112;
          const int idx = (k1 * n1) & 4095;
          float sn, cs;
          sincospif((float)idx / 2048.f, &sn, &cs);
          v[h] = cc < 2112 ? (cc <= 2048 ? cs : 0.f) : -sn;
        }
        o[e] = pk(v[0], v[1]);
      }
      bf16_t* dd = (bf16_t*)(p.ws + OFF_ADFT) + e0;
      *(uint4*)dd = uint4{o[0], o[1], o[2], o[3]};
      *(uint4*)(dd + 8) = uint4{o[4], o[5], o[6], o[7]};
      continue;
    }
  }
}

DI void norm_item(const Params& p, int item) {
  const int tid = ltid();
  const int w = tid >> 6, lane = tid & 63;
  const int t = item * 4 + w;
  const float* xr = xrow_in(p, t);
  const float* md = modrow(p, 0, t);
  const float* g = p.norm1_g;
  float4 v[4];
  float ss = 0.f;
#pragma unroll
  for (int j = 0; j < 4; ++j) {
    v[j] = *(const float4*)(xr + j * 256 + lane * 4);
    ss += v[j].x * v[j].x + v[j].y * v[j].y + v[j].z * v[j].z + v[j].w * v[j].w;
  }
#pragma unroll
  for (int off = 32; off >= 1; off >>= 1) ss += __shfl_xor(ss, off);
  if (lane == 0) ((float*)(p.ws + OFF_RSS1))[t] = ss;
  float* xo = xrow(p, t);
  bf16_t* hb = (bf16_t*)(p.ws + OFF_HB) + (size_t)t * 1024;
#pragma unroll
  for (int j = 0; j < 4; ++j) {
    const int c = j * 256 + lane * 4;
    *(float4*)(xo + c) = v[j];
    const float4 gg = *(const float4*)(g + c), sc = *(const float4*)(md + 1024 + c);
    *(uint2*)(hb + c) = uint2{pk(v[j].x * gg.x * (1.f + sc.x), v[j].y * gg.y * (1.f + sc.y)), pk(v[j].z * gg.z * (1.f + sc.z), v[j].w * gg.w * (1.f + sc.w))};
  }
}

DI void aprep_item(const Params& p, int l, int item, char* smem) {
  const int b = item / NCH, c = item % NCH;
  const int tok0 = b * TB + c * 64;
  const bool isctx = c < 4;
  int tid_ = ltid();
  const int tid = tid_, lane = tid & 63, w = tid >> 6;
  const bf16_t* P = (const bf16_t*)(p.ws + OFF_P);
  for (int it = 0; it < 12; ++it) {
    const int task = it * 64 + (tid >> 2);
    const int cq = tid & 3;
    const int type = task / 384, rem = task % 384, hr = rem >> 6, tk = rem & 63;
    const int t = tok0 + tk;
    const int pcol = (type ? 1296 : 784) + hr * 64;
    const bf16_t* src = P + (size_t)t * PW + pcol;
    const uint4 u1 = *(const uint4*)(src + cq * 8), u2 = *(const uint4*)(src + 32 + cq * 8);
    float a[8], bb[8];
    a[0] = bflo(u1.x); a[1] = bfhi(u1.x); a[2] = bflo(u1.y); a[3] = bfhi(u1.y); a[4] = bflo(u1.z); a[5] = bfhi(u1.z); a[6] = bflo(u1.w); a[7] = bfhi(u1.w);
    bb[0] = bflo(u2.x); bb[1] = bfhi(u2.x); bb[2] = bflo(u2.y); bb[3] = bfhi(u2.y); bb[4] = bflo(u2.z); bb[5] = bfhi(u2.z); bb[6] = bflo(u2.w); bb[7] = bfhi(u2.w);
    float ss = 0.f;
#pragma unroll
    for (int e = 0; e < 8; ++e) ss += a[e] * a[e] + bb[e] * bb[e];
    ss += __shfl_xor(ss, 1);
    ss += __shfl_xor(ss, 2);
    const float rs = rsqrtf(ss * (1.f / 64.f) + EPS);
    const float* gn = (type ? (hr < 4 ? p.wa_qn : p.wa_kn) : (hr < 4 ? p.ga_qn : p.ga_kn)) + l * 64;
    const float qs = hr < 4 ? 0.125f * LOG2E : 1.f;
    float o1[8], o2[8];
#pragma unroll
    for (int e = 0; e < 8; ++e) {
      a[e] = a[e] * rs * gn[cq * 8 + e];
      bb[e] = bb[e] * rs * gn[32 + cq * 8 + e];
    }
    if (!isctx) {
      const int pos = c * 64 + tk - LC;
      const float* rc = (const float*)(p.ws + OFF_ROPEC) + pos * 32 + cq * 8;
      const float* rsn = (const float*)(p.ws + OFF_ROPES) + pos * 32 + cq * 8;
#pragma unroll
      for (int e = 0; e < 8; ++e) {
        const float cs = rc[e], sn = rsn[e];
        o1[e] = (a[e] * cs - bb[e] * sn) * qs;
        o2[e] = (a[e] * sn + bb[e] * cs) * qs;
      }
    } else {
#pragma unroll
      for (int e = 0; e < 8; ++e) { o1[e] = a[e] * qs; o2[e] = bb[e] * qs; }
    }
    bf16_t* dst = hr < 4 ? (bf16_t*)(p.ws + OFF_QA) + ((size_t)type * T + t) * 256 + hr * 64
                         : (bf16_t*)(p.ws + OFF_KA) + ((size_t)type * T + t) * 128 + (hr - 4) * 64;
    *(uint4*)(dst + cq * 8) = uint4{pk(o1[0], o1[1]), pk(o1[2], o1[3]), pk(o1[4], o1[5]), pk(o1[6], o1[7])};
    *(uint4*)(dst + 32 + cq * 8) = uint4{pk(o2[0], o2[1]), pk(o2[2], o2[3]), pk(o2[4], o2[5]), pk(o2[6], o2[7])};
  }
  {
    bf16_t* sT = (bf16_t*)smem;
#pragma unroll 1
    for (int type = 0; type < 2; ++type) {
      const int vcol = (type ? 1296 : 784) + 384;
      __syncthreads();
#pragma unroll
      for (int i = 0; i < 4; ++i) {
        const int q = tid + i * 256, tk = q >> 4, ch = q & 15;
        *(uint4*)(sT + tk * 136 + ch * 8) = *(const uint4*)(P + (size_t)(tok0 + tk) * PW + vcol + ch * 8);
      }
      __syncthreads();
      const int kd = tid & 127, th = tid >> 7;
      bf16_t* dst = (bf16_t*)(p.ws + OFF_VT) + (((size_t)(type * NB + b) * 128 + kd)) * TB + c * 64 + th * 32;
#pragma unroll
      for (int j0 = 0; j0 < 32; j0 += 8) {
        unsigned o[4];
#pragma unroll
        for (int e = 0; e < 4; ++e) {
          const unsigned lo = sT[(th * 32 + j0 + 2 * e) * 136 + kd], hi = sT[(th * 32 + j0 + 2 * e + 1) * 136 + kd];
          o[e] = lo | (hi << 16);
        }
        *(uint4*)(dst + j0) = uint4{o[0], o[1], o[2], o[3]};
      }
    }
  }
  {
    const int g = w, lr = lane & 15, lq = lane >> 4;
    const bf16_t* CS = (const bf16_t*)(p.ws + OFF_CS64);
    const int cl = c - 4;
    if (isctx || cl <= 32) {
#pragma unroll 1
      for (int nh = 0; nh < 2; ++nh) {
      bf16x8 bs[2][2], bd[2][2];
#pragma unroll
      for (int ntl = 0; ntl < 2; ++ntl) {
        const int nt = nh * 2 + ntl;
        const int n1 = cl * 64 + nt * 16 + lr;
        const bool mir = !isctx && n1 >= 1 && n1 <= 2047;
        const bool zero = !isctx && n1 > 2048;
#pragma unroll
        for (int ks = 0; ks < 2; ++ks) {
          const int coff = 1808 + g * 64 + ks * 32 + lq * 8;
          uint4 a = *(const uint4*)(P + (size_t)(tok0 + nt * 16 + lr) * PW + coff);
          uint4 m = {0u, 0u, 0u, 0u};
          if (mir) m = *(const uint4*)(P + (size_t)(b * TB + LC + 4096 - n1) * PW + coff);
          if (zero) a = uint4{0u, 0u, 0u, 0u};
          const unsigned ua[4] = {a.x, a.y, a.z, a.w}, um[4] = {m.x, m.y, m.z, m.w};
          unsigned os[4], od[4];
#pragma unroll
          for (int e = 0; e < 4; ++e) {
            const float a0 = bflo(ua[e]), a1 = bfhi(ua[e]), m0 = bflo(um[e]), m1 = bfhi(um[e]);
            os[e] = pk(a0 + m0, a1 + m1);
            od[e] = pk(a0 - m0, a1 - m1);
          }
          bs[ntl][ks] = __builtin_bit_cast(bf16x8, uint4{os[0], os[1], os[2], os[3]});
          bd[ntl][ks] = __builtin_bit_cast(bf16x8, uint4{od[0], od[1], od[2], od[3]});
        }
      }
#pragma unroll 1
      for (int mt = 0; mt < 8; ++mt) {
        bf16x8 af[2];
#pragma unroll
        for (int ks = 0; ks < 2; ++ks) af[ks] = *(const bf16x8*)(CS + (mt * 16 + lr) * 64 + ks * 32 + lq * 8);
#pragma unroll
        for (int ntl = 0; ntl < 2; ++ntl) {
          const int nt = nh * 2 + ntl;
          f32x4 acc = {0.f, 0.f, 0.f, 0.f};
          const bool sinpart = mt >= 4;
          acc = MFMA16(af[0], (sinpart && !isctx) ? bd[ntl][0] : bs[ntl][0], acc);
          acc = MFMA16(af[1], (sinpart && !isctx) ? bd[ntl][1] : bs[ntl][1], acc);
#pragma unroll
          for (int r = 0; r < 4; ++r) {
            const int k2row = mt * 16 + lq * 4 + r, k2 = k2row & 63, part = k2row >> 6;
            const int tk = c * 64 + nt * 16 + lr;
            if (isctx) ((bf16_t*)(p.ws + OFF_BTFTC))[((size_t)(b * 256 + g * 64 + k2)) * 512 + part * 256 + tk] = f2bf(acc[r]);
            else {
              const int n1 = tk - LC;
              if (part == 0 || n1 < 2048) ((bf16_t*)(p.ws + OFF_BTFT))[((size_t)(b * 256 + g * 64 + k2)) * 4160 + part * 2112 + n1] = f2bf(acc[r]);
            }
          }
        }
      }
      }
    }
  }
}

DI int dn_step(int c, int d) { return c < 4 ? (d ? 3 - c : c) : 4 + (d ? 67 - c : c - 4); }

DI void dnprep_item(const Params& p, int l, int item, char* smem, char* dsm0) {
  const int b = item / (4 * NCH), h = (item / NCH) & 3, c = item % NCH;
  bf16_t* qb = (bf16_t*)smem;
  bf16_t* kb = qb + 64 * 72;
  float* kf = (float*)(smem + 18432);
  float* vf = kf + 4096;
  float* Am = kf;
  int tid_ = ltid();
  const int tid = tid_, lane = tid & 63, w = tid >> 6, lr = lane & 15, lq = lane >> 4;
  const int tok0 = b * TB + c * 64;
  const bool isctx = c < 4;
  const int sbeg = isctx ? b * TB : b * TB + LC, send = isctx ? b * TB + LC : (b + 1) * TB;
  const bf16_t* P = (const bf16_t*)(p.ws + OFF_P);
  const int tau = tid >> 2, cq = tid & 3;
  const int t = tok0 + tau;
  float qv[16], kv[16], vv[16];
  __syncthreads();
#pragma unroll
  for (int part = 0; part < 3; ++part) {
    const int col = part * 256 + h * 64 + cq * 16;
    const float* cw = p.conv_w + (size_t)l * 3 * 768 + col;
    const bool hasp = t - 1 >= sbeg, hasn = t + 1 < send;
    const u32x4 z4 = {0u, 0u, 0u, 0u};
    const u32x4 a1l = *(const u32x4*)(P + (size_t)t * PW + col), a1h = *(const u32x4*)(P + (size_t)t * PW + col + 8);
    u32x4 a0l = z4, a0h = z4, a2l = z4, a2h = z4;
    if (hasp) { a0l = *(const u32x4*)(P + (size_t)(t - 1) * PW + col); a0h = *(const u32x4*)(P + (size_t)(t - 1) * PW + col + 8); }
    if (hasn) { a2l = *(const u32x4*)(P + (size_t)(t + 1) * PW + col); a2h = *(const u32x4*)(P + (size_t)(t + 1) * PW + col + 8); }
#pragma unroll
    for (int e = 0; e < 16; ++e) {
      const unsigned w0 = e < 8 ? a0l[(e & 7) >> 1] : a0h[(e & 7) >> 1];
      const unsigned w1 = e < 8 ? a1l[(e & 7) >> 1] : a1h[(e & 7) >> 1];
      const unsigned w2 = e < 8 ? a2l[(e & 7) >> 1] : a2h[(e & 7) >> 1];
      const float x0 = (e & 1) ? bfhi(w0) : bflo(w0);
      const float x1 = (e & 1) ? bfhi(w1) : bflo(w1);
      const float x2 = (e & 1) ? bfhi(w2) : bflo(w2);
      const float y = x0 * cw[e] + x1 * cw[768 + e] + x2 * cw[1536 + e];
      const float sv = silu_f(y);
      if (part == 0) qv[e] = sv; else if (part == 1) kv[e] = sv; else vv[e] = sv;
    }
    asm volatile("" ::: "memory");
  }
  {
    float sq = 0.f, sk = 0.f;
#pragma unroll
    for (int e = 0; e < 16; ++e) { sq += qv[e] * qv[e]; sk += kv[e] * kv[e]; }
    sq += __shfl_xor(sq, 1); sq += __shfl_xor(sq, 2);
    sk += __shfl_xor(sk, 1); sk += __shfl_xor(sk, 2);
    const float rq = rsqrtf(sq + EPS) * 0.125f, rk = rsqrtf(sk + EPS);
#pragma unroll
    for (int e = 0; e < 16; ++e) { qv[e] *= rq; kv[e] *= rk; }
  }
  float* gl = (float*)(dsm0 + (ltid_full() >> 8) * HALF_SMEM + 18432 + 32768);
  float* bl = gl + 128;
  float* gc = bl + 128;
  float* bd = gc + 128;
  if (tid < 128) {
    const int d = tid >> 6, i = tid & 63, ta = d ? 63 - i : i;
    const bf16_t* pr = P + (size_t)(tok0 + ta) * PW + 768;
    const float a = bf2f(pr[d * 4 + h]), bb = bf2f(pr[8 + d * 4 + h]);
    const float xx = a + p.dt_bias[l * 8 + d * 4 + h];
    const float ex = __expf(xx);
    const float sp = xx > 20.f ? xx : (ex < 0.03f ? ex * (1.f - ex * (0.5f - ex * (1.f / 3.f - 0.25f * ex))) : __logf(1.f + ex));
    float v = -__expf(p.A_log[l * 8 + d * 4 + h]) * sp;
#pragma unroll
    for (int off = 1; off < 64; off <<= 1) {
      const float tq = __shfl_up(v, off);
      if (i >= off) v += tq;
    }
    gc[d * 64 + i] = v;
    bd[d * 64 + i] = 1.f / (1.f + __expf(-bb));
  }
  {
#pragma unroll
    for (int e = 0; e < 16; e += 4) {
      *(uint2*)(qb + tau * 72 + cq * 16 + e) = uint2{pk(qv[e], qv[e + 1]), pk(qv[e + 2], qv[e + 3])};
      *(uint2*)(kb + tau * 72 + cq * 16 + e) = uint2{pk(kv[e], kv[e + 1]), pk(kv[e + 2], kv[e + 3])};
      *(float4*)(kf + tau * 64 + cq * 16 + e) = float4{kv[e], kv[e + 1], kv[e + 2], kv[e + 3]};
      *(float4*)(vf + tau * 64 + cq * 16 + e) = float4{vv[e], vv[e + 1], vv[e + 2], vv[e + 3]};
    }
  }
  __syncthreads();
#pragma unroll
  for (int d = 0; d < 2; ++d) {
    const int i = d ? 63 - tau : tau;
    const int cb = ((b * 4 + h) * 2 + d) * NCH + dn_step(c, d);
    bf16_t* base = (bf16_t*)(p.ws + OFF_DN + (size_t)cb * SZ_CB);
    const float eg = __expf(gc[d * 64 + i]);
    bf16_t* qd = base + 4096 + i * 64;
#pragma unroll
    for (int q4 = 0; q4 < 4; ++q4) {
      const int pos = (cq >> 1) * 32 + q4 * 8 + (cq & 1) * 4;
      *(uint2*)(qd + pos) = uint2{pk(qv[q4 * 4] * eg, qv[q4 * 4 + 1] * eg), pk(qv[q4 * 4 + 2] * eg, qv[q4 * 4 + 3] * eg)};
    }
  }
#pragma unroll
  for (int d = 0; d < 2; ++d) {
    const int cb = ((b * 4 + h) * 2 + d) * NCH + dn_step(c, d);
    bf16_t* kt = (bf16_t*)(p.ws + OFF_DN + (size_t)cb * SZ_CB) + 3 * 4096 + tau * 64 + cq * 16;
    const float gl63 = gc[d * 64 + 63];
    unsigned o[8];
#pragma unroll
    for (int e2 = 0; e2 < 8; ++e2) {
      float vals[2];
#pragma unroll
      for (int hq = 0; hq < 2; ++hq) {
        const int e = e2 * 2 + hq;
        const int i = (2 * (cq >> 1) + ((e >> 2) & 1)) * 16 + ((((cq & 1) << 1) | (e >> 3)) << 2) + (e & 3);
        const int ta = d ? 63 - i : i;
        vals[hq] = kf[ta * 64 + tau] * __expf(gl63 - gc[d * 64 + i]);
      }
      o[e2] = pk(vals[0], vals[1]);
    }
    *(uint4*)kt = uint4{o[0], o[1], o[2], o[3]};
    *(uint4*)(kt + 8) = uint4{o[4], o[5], o[6], o[7]};
  }
  if (tid < 128) {
    const int d = tid >> 6;
    const int cb = ((b * 4 + h) * 2 + d) * NCH + dn_step(c, d);
    ((float*)(p.ws + OFF_GEND))[(size_t)cb * 64 + (tid & 63)] = __expf(gc[d * 64 + 63]);
  }
  f32x4 KK[4], QK[4];
  {
    bf16x8 ak[2], aq[2];
#pragma unroll
    for (int ks = 0; ks < 2; ++ks) {
      ak[ks] = *(const bf16x8*)(kb + (w * 16 + lr) * 72 + ks * 32 + lq * 8);
      aq[ks] = *(const bf16x8*)(qb + (w * 16 + lr) * 72 + ks * 32 + lq * 8);
    }
#pragma unroll
    for (int nt = 0; nt < 4; ++nt) {
      KK[nt] = f32x4{0.f, 0.f, 0.f, 0.f};
      QK[nt] = f32x4{0.f, 0.f, 0.f, 0.f};
#pragma unroll
      for (int ks = 0; ks < 2; ++ks) {
        const bf16x8 bk = *(const bf16x8*)(kb + (nt * 16 + lr) * 72 + ks * 32 + lq * 8);
        KK[nt] = MFMA16(ak[ks], bk, KK[nt]);
        QK[nt] = MFMA16(aq[ks], bk, QK[nt]);
      }
    }
  }
  const int sd = w >> 1, half = w & 1;
  float xs[64];
#pragma unroll
  for (int i = 0; i < 64; ++i) {
    const int ta = sd ? 63 - i : i;
    const float bt = bd[sd * 64 + i];
    xs[i] = half ? kf[ta * 64 + lane] * bt * __expf(gc[sd * 64 + i]) : vf[ta * 64 + lane] * bt;
    if ((i & 7) == 7) asm volatile("" ::: "memory");
  }
  __syncthreads();
#pragma unroll
  for (int d = 0; d < 2; ++d) {
    const int cb = ((b * 4 + h) * 2 + d) * NCH + dn_step(c, d);
    bf16_t* inb = (bf16_t*)(p.ws + OFF_DN + (size_t)cb * SZ_CB) + 2 * 4096;
#pragma unroll
    for (int nt = 0; nt < 4; ++nt)
#pragma unroll
      for (int r = 0; r < 4; ++r) {
        const int ti = w * 16 + lq * 4 + r, tj = nt * 16 + lr;
        const int i = d ? 63 - ti : ti, j = d ? 63 - tj : tj;
        const float dec = (i >= j) ? __expf(gc[d * 64 + i] - gc[d * 64 + j]) : 0.f;
        Am[d * 4096 + i * 64 + j] = (i > j) ? bd[d * 64 + i] * KK[nt][r] * dec : 0.f;
        inb[i * 64 + permk(j)] = f2bf(QK[nt][r] * dec);
        if (r == 3) asm volatile("" ::: "memory");
      }
  }
  __syncthreads();
  {
    const float* Ad = Am + sd * 4096;
    f32x4 an[16];
    an[0] = *(const f32x4*)(Ad + 1 * 64);
#pragma unroll
    for (int i = 1; i < 64; ++i) {
      f32x4 ac[16];
#pragma unroll
      for (int j4 = 0; j4 <= (i - 1) / 4; ++j4) ac[j4] = an[j4];
      if (i + 1 < 64) {
#pragma unroll
        for (int j4 = 0; j4 <= i / 4; ++j4) an[j4] = *(const f32x4*)(Ad + (i + 1) * 64 + j4 * 4);
      }
      float sacc = xs[i];
#pragma unroll
      for (int j4 = 0; j4 <= (i - 1) / 4; ++j4) {
        sacc -= ac[j4][0] * xs[j4 * 4];
        sacc -= ac[j4][1] * xs[j4 * 4 + 1];
        sacc -= ac[j4][2] * xs[j4 * 4 + 2];
        sacc -= ac[j4][3] * xs[j4 * 4 + 3];
      }
      xs[i] = sacc;
      asm volatile("" ::: "memory");
    }
    const int cb = ((b * 4 + h) * 2 + sd) * NCH + dn_step(c, sd);
    bf16_t* base = (bf16_t*)(p.ws + OFF_DN + (size_t)cb * SZ_CB);
    if (half == 0) {
      bf16_t* U = base + 4 * 4096;
#pragma unroll
      for (int i4 = 0; i4 < 16; ++i4) {
        const int mt = i4 >> 2, q4 = i4 & 3;
        *(uint2*)(U + ((((mt * 4 + (lane >> 4)) * 4 + q4) * 16 + (lane & 15)) << 2)) = uint2{pk(xs[i4 * 4], xs[i4 * 4 + 1]), pk(xs[i4 * 4 + 2], xs[i4 * 4 + 3])};
      }
    } else {
      bf16_t* Wn = base;
      const int pc = permk(lane);
#pragma unroll
      for (int i = 0; i < 64; ++i) Wn[i * 64 + pc] = f2bf(-xs[i]);
    }
  }
}

DI bf16x8 pack8(const f32x4& a, const f32x4& b) {
  uint4 u = {pk(a[0], a[1]), pk(a[2], a[3]), pk(b[0], b[1]), pk(b[2], b[3])};
  return __builtin_bit_cast(bf16x8, u);
}

DI void dnscan_item(const Params& p, int item, LAS char* lb) {
  const int b = item >> 3, h = (item >> 1) & 3, d = item & 1;
  int tid_ = ltid();
  const int lane = tid_ & 63, w = tid_ >> 6, lr = lane & 15, lq = lane >> 4;
  f32x4 S[4];
#pragma unroll
  for (int mt = 0; mt < 4; ++mt) S[mt] = f32x4{0.f, 0.f, 0.f, 0.f};
  const int cb0 = ((b * 4 + h) * 2 + d) * NCH;
  unsigned pfacc = 0u;
  int soff[8];
#pragma unroll
  for (int i = 0; i < 8; ++i) {
    const int j = w * 512 + i * 64 + lane, jj = j & 511, row = jj >> 3, ch = jj & 7;
    soff[i] = (j >> 9) * 4096 + row * 64 + ((ch ^ (row & 7)) << 3);
  }
#define SC_STAGE(buf, step)                                                                                                                   \
  do {                                                                                                                                        \
    const bf16_t* gb_ = (const bf16_t*)(p.ws + OFF_DN + (size_t)(cb0 + (step)) * SZ_CB);                                                       \
    _Pragma("unroll") for (int i = 0; i < 8; ++i)                                                                                             \
      __builtin_amdgcn_global_load_lds((const unsigned*)(gb_ + soff[i]), (LAS unsigned*)(lb + (buf) * 32768 + (w * 512 + i * 64) * 16), 16, 0, 0); \
  } while (0)
  int foff[4][2];
#pragma unroll
  for (int mt = 0; mt < 4; ++mt)
#pragma unroll
    for (int ks = 0; ks < 2; ++ks) { const int row = mt * 16 + lr; foff[mt][ks] = row * 128 + (((ks * 4 + lq) ^ (row & 7)) << 4); }
  SC_STAGE(0, 0);
  uint2 uu[4];
  float ge;
  {
    const bf16_t* base = (const bf16_t*)(p.ws + OFF_DN + (size_t)cb0 * SZ_CB);
#pragma unroll
    for (int mt = 0; mt < 4; ++mt) uu[mt] = *(const uint2*)(base + 4 * 4096 + ((((mt * 4 + w) * 4 + lq) * 16 + lr) << 2));
    ge = ((const float*)(p.ws + OFF_GEND))[(size_t)cb0 * 64 + lane];
  }
  WAIT_V(0);
#pragma unroll 1
  for (int s = 0; s < NCH; ++s) {
    WAIT_V(8);
    __syncthreads();
    if (s + 1 < NCH) SC_STAGE((s + 1) & 1, s + 1);
    uint2 un[4] = {uu[0], uu[1], uu[2], uu[3]};
    float gn = ge;
    if (s + 1 < NCH) {
      const bf16_t* nb = (const bf16_t*)(p.ws + OFF_DN + (size_t)(cb0 + s + 1) * SZ_CB);
#pragma unroll
      for (int mt = 0; mt < 4; ++mt) un[mt] = *(const uint2*)(nb + 4 * 4096 + ((((mt * 4 + w) * 4 + lq) * 16 + lr) << 2));
      gn = ((const float*)(p.ws + OFF_GEND))[(size_t)(cb0 + s + 1) * 64 + lane];
    }
    unsigned pf0 = 0u, pf1 = 0u;
    if (s + 2 < NCH) {
      const unsigned* nb = (const unsigned*)(p.ws + OFF_DN + (size_t)(cb0 + s + 2) * SZ_CB);
      pf0 = nb[(w * 80 + lane) * 32];
      if (lane < 16) pf1 = nb[(w * 80 + 64 + lane) * 32];
    }
    const LAS char* sb = lb + (s & 1) * 32768;
    bf16x8 sB[2];
    sB[0] = pack8(S[0], S[1]);
    sB[1] = pack8(S[2], S[3]);
    f32x4 vn[4], o[4];
#pragma unroll
    for (int mt = 0; mt < 4; ++mt) {
      vn[mt] = f32x4{bflo(uu[mt].x), bfhi(uu[mt].x), bflo(uu[mt].y), bfhi(uu[mt].y)};
      o[mt] = f32x4{0.f, 0.f, 0.f, 0.f};
#pragma unroll
      for (int ks = 0; ks < 2; ++ks) {
        const bf16x8 aw = *(const LAS bf16x8*)(sb + foff[mt][ks]);
        const bf16x8 aq = *(const LAS bf16x8*)(sb + 8192 + foff[mt][ks]);
        vn[mt] = MFMA16(aw, sB[ks], vn[mt]);
        o[mt] = MFMA16(aq, sB[ks], o[mt]);
      }
    }
    bf16x8 vB[2];
    vB[0] = pack8(vn[0], vn[1]);
    vB[1] = pack8(vn[2], vn[3]);
#pragma unroll
    for (int mt = 0; mt < 4; ++mt) {
#pragma unroll
      for (int r = 0; r < 4; ++r) S[mt][r] *= ge;
#pragma unroll
      for (int ks = 0; ks < 2; ++ks) {
        const bf16x8 ai = *(const LAS bf16x8*)(sb + 16384 + foff[mt][ks]);
        const bf16x8 ak = *(const LAS bf16x8*)(sb + 24576 + foff[mt][ks]);
        o[mt] = MFMA16(ai, vB[ks], o[mt]);
        S[mt] = MFMA16(ak, vB[ks], S[mt]);
      }
    }
    pfacc ^= pf0 ^ pf1;
#pragma unroll
    for (int mt = 0; mt < 4; ++mt) uu[mt] = un[mt];
    ge = gn;
    int dl = d;
    asm volatile("" : "+v"(dl));
    float* Od = (float*)(p.ws + OFF_ODN) + (size_t)dl * T * 256;
    const int c = s < 4 ? (d ? 3 - s : s) : 4 + (d ? 67 - s : s - 4);
#pragma unroll
    for (int mt = 0; mt < 4; ++mt)
#pragma unroll
      for (int r = 0; r < 4; ++r) {
        const int i = mt * 16 + lq * 4 + r;
        const int ta = d ? 63 - i : i;
        Od[((size_t)(b * TB + c * 64 + ta)) * 256 + h * 64 + w * 16 + lr] = o[mt][r];
      }
  }
#undef SC_STAGE
  __syncthreads();
  if (pfacc == 0x9e3779b9u && ((const float*)(p.ws + OFF_GEND))[0] == 123.456f) ((float*)(p.ws + OFF_ODN))[0] = 0.f;
}

DI void attn_item(const Params& p, int l, int type, int b, int kvh, int qb, char* smem) {
  constexpr int KB = 64 * 64 * 2, VB = 64 * 72 * 2, SB = KB + VB;
  int tid_ = ltid();
  const int tid = tid_, lane = tid & 63, w = tid >> 6, lr = lane & 15, lq = lane >> 4;
  const int g = w >> 1, qh = kvh * 2 + g;
  const int qloc0 = qb * 64 + (w & 1) * 32;
  const bool isctx = qb < 4;
  const bf16_t* Qa = (const bf16_t*)(p.ws + OFF_QA) + ((size_t)type * T + (size_t)b * TB) * 256 + qh * 64;
  const bf16_t* Kg = (const bf16_t*)(p.ws + OFF_KA) + ((size_t)type * T + (size_t)b * TB) * 128 + kvh * 64;
  const bf16_t* Vg = (const bf16_t*)(p.ws + OFF_VT) + ((size_t)(type * NB + b) * 128 + kvh * 64) * TB;
  bf16x8 qf[2][2];
#pragma unroll
  for (int nt = 0; nt < 2; ++nt)
#pragma unroll
    for (int ks = 0; ks < 2; ++ks) qf[nt][ks] = *(const bf16x8*)(Qa + (size_t)(qloc0 + nt * 16 + lr) * 256 + ks * 32 + lq * 8);
  float neg_big;
  asm volatile("v_mov_b32 %0, 0xf149f2ca" : "=v"(neg_big));
  float mrun[2];
  f32x4 O[4][2], Ls[2];
  const bf16x8 ones8 = {(short)0x3F80, (short)0x3F80, (short)0x3F80, (short)0x3F80, (short)0x3F80, (short)0x3F80, (short)0x3F80, (short)0x3F80};
#pragma unroll
  for (int nt = 0; nt < 2; ++nt) {
    if (type == 1) { mrun[nt] = p.wa_sink[l * 4 + qh] * LOG2E; Ls[nt] = f32x4{1.f, 1.f, 1.f, 1.f}; }
    else { mrun[nt] = neg_big; Ls[nt] = f32x4{0.f, 0.f, 0.f, 0.f}; }
#pragma unroll
    for (int mt = 0; mt < 4; ++mt) O[mt][nt] = f32x4{0.f, 0.f, 0.f, 0.f};
  }
  const int n_lat_lo = (!isctx && type == 1) ? qb - 2 : 4;
  const int ntiles = isctx ? 4 : (type == 0 ? NCH : 9);
  const int lrow = tid >> 3, lch = tid & 7;
  u32x4 rk[2], rv[2];
#pragma unroll
  for (int i = 0; i < 2; ++i) {
    rk[i] = *(const u32x4*)(Kg + (size_t)(lrow + i * 32) * 128 + lch * 8);
    rv[i] = *(const u32x4*)(Vg + (size_t)(lrow + i * 32) * TB + lch * 8);
  }
#pragma unroll
  for (int i = 0; i < 2; ++i) {
    const int r = lrow + i * 32;
    *(u32x4*)(smem + r * 128 + ((lch ^ (r & 7)) << 4)) = rk[i];
    *(u32x4*)(smem + KB + r * 144 + lch * 16) = rv[i];
  }
  __syncthreads();
  for (int ti = 0; ti < ntiles; ++ti) {
    const int jraw = ti < 4 ? ti : n_lat_lo + (ti - 4);
    const bool tvalid = ti < 4 || (jraw >= 4 && jraw < NCH);
    const int jt = ti < 4 ? ti : (jraw < 4 ? 4 : (jraw > NCH - 1 ? NCH - 1 : jraw));
    const char* sK = smem + (ti & 1) * SB;
    const char* sV = sK + KB;
    if (ti + 1 < ntiles) {
      const int jn0 = (ti + 1) < 4 ? ti + 1 : n_lat_lo + (ti + 1 - 4);
      const int jn = (ti + 1) < 4 ? jn0 : (jn0 < 4 ? 4 : (jn0 > NCH - 1 ? NCH - 1 : jn0));
#pragma unroll
      for (int i = 0; i < 2; ++i) {
        rk[i] = *(const u32x4*)(Kg + (size_t)(jn * 64 + lrow + i * 32) * 128 + lch * 8);
        rv[i] = *(const u32x4*)(Vg + (size_t)(lrow + i * 32) * TB + jn * 64 + lch * 8);
      }
    }
    f32x4 sc[4][2];
#pragma unroll
    for (int mt = 0; mt < 4; ++mt) {
      const int r = mt * 16 + lr;
      const bf16x8 kf0 = *(const bf16x8*)(sK + r * 128 + ((lq ^ (r & 7)) << 4));
      const bf16x8 kf1 = *(const bf16x8*)(sK + r * 128 + (((4 + lq) ^ (r & 7)) << 4));
#pragma unroll
      for (int nt = 0; nt < 2; ++nt) {
        f32x4 a = {0.f, 0.f, 0.f, 0.f};
        a = MFMA16(kf0, qf[nt][0], a);
        a = MFMA16(kf1, qf[nt][1], a);
        sc[mt][nt] = a;
      }
    }
    const bool domask = (type == 1) && !isctx && (jt >= 4);
#pragma unroll
    for (int nt = 0; nt < 2; ++nt) {
      if (domask) {
#pragma unroll
        for (int mt = 0; mt < 4; ++mt)
#pragma unroll
          for (int r = 0; r < 4; ++r) {
            const int kpos = jt * 64 + mt * 16 + lq * 4 + r, qpos = qloc0 + nt * 16 + lr;
            const int df = qpos - kpos;
            if (df > 128 || df < -128 || !tvalid) sc[mt][nt][r] = neg_big;
          }
      }
      float mx = fmaxf(fmaxf(sc[0][nt][0], sc[0][nt][1]), fmaxf(sc[0][nt][2], sc[0][nt][3]));
#pragma unroll
      for (int mt = 1; mt < 4; ++mt) mx = fmaxf(mx, fmaxf(fmaxf(sc[mt][nt][0], sc[mt][nt][1]), fmaxf(sc[mt][nt][2], sc[mt][nt][3])));
      mx = fmaxf(mx, __shfl_xor(mx, 16));
      mx = fmaxf(mx, __shfl_xor(mx, 32));
      if (__builtin_amdgcn_ballot_w64(mx > mrun[nt] + 8.f) != 0ull) {
        const float mnew = fmaxf(mrun[nt], mx);
        const float alpha = __builtin_amdgcn_exp2f(mrun[nt] - mnew);
        mrun[nt] = mnew;
#pragma unroll
        for (int r = 0; r < 4; ++r) Ls[nt][r] *= alpha;
#pragma unroll
        for (int mt = 0; mt < 4; ++mt)
#pragma unroll
          for (int r = 0; r < 4; ++r) O[mt][nt][r] *= alpha;
      }
      const float mref = mrun[nt];
#pragma unroll
      for (int mt = 0; mt < 4; ++mt)
#pragma unroll
        for (int r = 0; r < 4; ++r) sc[mt][nt][r] = __builtin_amdgcn_exp2f(sc[mt][nt][r] - mref);
    }
    bf16x8 pB[2][2];
#pragma unroll
    for (int nt = 0; nt < 2; ++nt) {
      pB[nt][0] = pack8(sc[0][nt], sc[1][nt]);
      pB[nt][1] = pack8(sc[2][nt], sc[3][nt]);
      Ls[nt] = MFMA16(ones8, pB[nt][0], Ls[nt]);
      Ls[nt] = MFMA16(ones8, pB[nt][1], Ls[nt]);
    }
#pragma unroll
    for (int mt = 0; mt < 4; ++mt)
#pragma unroll
      for (int ks = 0; ks < 2; ++ks) {
        const bf16x4 v0 = *(const bf16x4*)(sV + (mt * 16 + lr) * 144 + ((2 * ks) * 16 + lq * 4) * 2);
        const bf16x4 v1 = *(const bf16x4*)(sV + (mt * 16 + lr) * 144 + ((2 * ks + 1) * 16 + lq * 4) * 2);
        const bf16x8 vfr = __builtin_shufflevector(v0, v1, 0, 1, 2, 3, 4, 5, 6, 7);
#pragma unroll
        for (int nt = 0; nt < 2; ++nt) O[mt][nt] = MFMA16(vfr, pB[nt][ks], O[mt][nt]);
      }
    if (ti + 1 < ntiles) {
      char* dK = smem + ((ti + 1) & 1) * SB;
#pragma unroll
      for (int i = 0; i < 2; ++i) {
        const int r = lrow + i * 32;
        *(u32x4*)(dK + r * 128 + ((lch ^ (r & 7)) << 4)) = rk[i];
        *(u32x4*)(dK + KB + r * 144 + lch * 16) = rv[i];
      }
    }
    __syncthreads();
  }
  bf16_t* Y = (bf16_t*)(p.ws + OFF_YMIX);
#pragma unroll
  for (int nt = 0; nt < 2; ++nt) {
    const float inv = 1.f / Ls[nt][0];
    const size_t row = (size_t)b * TB + qloc0 + nt * 16 + lr;
#pragma unroll
    for (int mt = 0; mt < 4; ++mt) {
      uint2 v = {pk(O[mt][nt][0] * inv, O[mt][nt][1] * inv), pk(O[mt][nt][2] * inv, O[mt][nt][3] * inv)};
      *(uint2*)(Y + row * 1024 + (type ? 512 : 256) + qh * 64 + mt * 16 + lq * 4) = v;
    }
  }
}

DI void dnmerge_item(const Params& p, int l, int item) {
  const int tid = ltid();
  const int w = tid >> 6, lane = tid & 63;
  const int t = item * 4 + w;
  const float* o0 = (const float*)(p.ws + OFF_ODN) + (size_t)t * 256 + lane * 4;
  const float* o1 = o0 + (size_t)T * 256;
  const float4 a = *(const float4*)o0, bq = *(const float4*)o1;
  float v[4] = {a.x + bq.x, a.y + bq.y, a.z + bq.z, a.w + bq.w};
  float ss = v[0] * v[0] + v[1] * v[1] + v[2] * v[2] + v[3] * v[3];
  ss += __shfl_xor(ss, 1); ss += __shfl_xor(ss, 2); ss += __shfl_xor(ss, 4); ss += __shfl_xor(ss, 8);
  const float rs = rsqrtf(ss * (1.f / 64.f) + EPS);
  const int dim = (lane & 15) * 4;
  const float4 gn = *(const float4*)(p.dn_norm_g + l * 64 + dim);
  const uint2 zz = *(const uint2*)((const bf16_t*)(p.ws + OFF_Z) + (size_t)t * 256 + lane * 4);
  const float z0 = bflo(zz.x), z1 = bfhi(zz.x), z2 = bflo(zz.y), z3 = bfhi(zz.y);
  const float y0 = v[0] * rs * gn.x * silu_f(z0), y1 = v[1] * rs * gn.y * silu_f(z1), y2 = v[2] * rs * gn.z * silu_f(z2), y3 = v[3] * rs * gn.w * silu_f(z3);
  *(uint2*)((bf16_t*)(p.ws + OFF_YMIX) + (size_t)t * 1024 + lane * 4) = uint2{pk(y0, y1), pk(y2, y3)};
  if (lane == 0) { ((float*)(p.ws + OFF_RSS1))[t] = 0.f; ((float*)(p.ws + OFF_RSS2))[t] = 0.f; }
}


#define XB_TMO      128
#define XB_XCNT(j)  (256  + 64 * (j))
#define XB_XSUB(j)  (1280 + 64 * (j))
#define XB_XGEN(j)  (2304 + 64 * (j))
#define XB_TOP      3328
#define XB_TOPGEN   3392
#define XCD_BAR_WORDS 3456
#define XB_SPIN_CAP (1u << 18)
DI unsigned xb_ld(unsigned* p) { return __hip_atomic_load(p, __ATOMIC_RELAXED, __HIP_MEMORY_SCOPE_AGENT); }
DI unsigned xb_add(unsigned* p, unsigned v) { return __hip_atomic_fetch_add(p, v, __ATOMIC_RELAXED, __HIP_MEMORY_SCOPE_AGENT); }
DI unsigned xb_xcc_id() { return (unsigned)__builtin_amdgcn_s_getreg((3 << 11) | 20) & 0xFu; }
#define XB_SPIN(cond, bar) do { unsigned _sp = 0; while (cond) { __builtin_amdgcn_s_sleep(1); \
    if ((++_sp & 255u) == 0u) { if (xb_ld(&(bar)[XB_TMO])) break; if (_sp > XB_SPIN_CAP) { atomicAdd(&(bar)[XB_TMO], 1u); break; } } } } while (0)
struct XcdBarrier { unsigned* bar; unsigned x; volatile LAS unsigned* st; };
DI XcdBarrier xcd_barrier_post(unsigned* bar, volatile LAS unsigned* st) {
  XcdBarrier b; b.bar = bar; b.x = xb_xcc_id(); b.st = st;
  if (threadIdx.x == 0) (void)xb_add(&bar[XB_XCNT(b.x)], 1u);
  return b;
}
DI void xcd_barrier_complete(unsigned* bar, unsigned x, unsigned& nloc, unsigned& nx) {
  const unsigned G = gridDim.x * gridDim.y * gridDim.z;
  unsigned sum, cnt, mine, sp = 0u;
  for (;;) {
    sum = 0u; cnt = 0u; mine = 0u;
#pragma unroll
    for (unsigned j = 0; j < 16; ++j) { const unsigned c = xb_ld(&bar[XB_XCNT(j)]); sum += c; cnt += (c > 0u) ? 1u : 0u; mine = (j == x) ? c : mine; }
    if (sum == G) break;
    __builtin_amdgcn_s_sleep(1);
    if ((++sp & 255u) == 0u) { if (xb_ld(&bar[XB_TMO])) break; if (sp > XB_SPIN_CAP) { atomicAdd(&bar[XB_TMO], 1u); break; } }
  }
  nloc = mine > 0u ? mine : 1u; nx = cnt > 0u ? cnt : 1u;
}
DI void xcd_barrier(const XcdBarrier& b) {
  asm volatile("s_waitcnt vmcnt(0)" ::: "memory");
  __syncthreads();
  if (ltid_full() == 0) {
    unsigned* bar = b.bar;
    asm volatile("" : "+s"(bar));
    __builtin_amdgcn_s_waitcnt(0);
    unsigned nloc = b.st[0], nx = b.st[1];
    if (nloc == 0u) { xcd_barrier_complete(bar, b.x, nloc, nx); b.st[0] = nloc; b.st[1] = nx; }
    const unsigned old = xb_add(&bar[XB_XSUB(b.x)], 1u);
    const unsigned gen = old / nloc;
    if (old + 1u == (gen + 1u) * nloc) {
      __builtin_amdgcn_fence(__ATOMIC_RELEASE, "agent");
      asm volatile("s_waitcnt vmcnt(0)" ::: "memory");
      const unsigned og = xb_add(&bar[XB_TOP], 1u);
      const unsigned tg = og / nx;
      if (og + 1u == (tg + 1u) * nx) xb_add(&bar[XB_TOPGEN], 1u);
      else XB_SPIN(xb_ld(&bar[XB_TOPGEN]) == tg, bar);
      __builtin_amdgcn_fence(__ATOMIC_ACQUIRE, "agent");
      xb_add(&bar[XB_XGEN(b.x)], 1u);
      asm volatile("s_waitcnt vmcnt(0)" ::: "memory");
    } else {
      XB_SPIN(xb_ld(&bar[XB_XGEN(b.x)]) == gen, bar);
      __builtin_amdgcn_fence(__ATOMIC_ACQUIRE, "agent");
      asm volatile("s_waitcnt vmcnt(0)" ::: "memory");
    }
  }
  __syncthreads();
}


DI Params load_params(const volatile LAS unsigned* sp) {
  Params q;
  unsigned long long* dst = (unsigned long long*)&q;
#pragma unroll
  for (int i = 0; i < (int)(sizeof(Params) / 8); ++i) {
    const unsigned lo = (unsigned)__builtin_amdgcn_readfirstlane((int)sp[2 * i]), hi = (unsigned)__builtin_amdgcn_readfirstlane((int)sp[2 * i + 1]);
    dst[i] = ((unsigned long long)hi << 32) | lo;
  }
  return q;
}
#define GSYNC() do { XcdBarrier xb_; xb_.bar = (unsigned*)(q.ws + OFF_BAR); xb_.x = xb_xcc_id(); xb_.st = (volatile LAS unsigned*)&xb_words; xcd_barrier(xb_); } while (0)
__global__ void __launch_bounds__(512, 2) mega(Params p) {
  extern __shared__ __attribute__((aligned(1024))) char dsm[];
  __shared__ uint4 xb_words;
  __shared__ int s_item;
  cg::grid_group grid = cg::this_grid();
  __shared__ unsigned sparams[sizeof(Params) / 4];
  if (threadIdx.x == 0) xb_words = make_uint4(0u, 0u, 0u, 0u);
  if (threadIdx.x < sizeof(Params) / 4) sparams[threadIdx.x] = ((const unsigned*)&p)[threadIdx.x];
  __syncthreads();
  (void)xcd_barrier_post((unsigned*)(p.ws + OFF_BAR), (volatile LAS unsigned*)&xb_words);
  const int nblk = gridDim.x, bid = blockIdx.x;
  LAS char* lds = (LAS char*)dsm;
  phase0(p, dsm);
#if EXP == 6
  __syncthreads();
  phase0(p, dsm);
#endif
  if (p.ws == nullptr) grid.sync();
  { const Params q0 = load_params((const volatile LAS unsigned*)sparams); XcdBarrier xb_; xb_.bar = (unsigned*)(q0.ws + OFF_BAR); xb_.x = xb_xcc_id(); xb_.st = (volatile LAS unsigned*)&xb_words; xcd_barrier(xb_); }
  for (int l = 0; l < 4; ++l) {
    Params q = load_params((const volatile LAS unsigned*)sparams);
#define RELAUNDER() q = load_params((const volatile LAS unsigned*)sparams)
#define Hb ((const bf16_t*)(q.ws + OFF_HB))
    RELAUNDER();
    if (l == 0) {
      { const int hf = ltid_full() >> 8; char* smem = dsm + hf * HALF_SMEM; (void)smem;
      for (int pi = bid; pi < (T / 4 + 16 * 40) / 2; pi += nblk) {
        const int it = pi * 2 + hf;
        if (it < T / 4) norm_item(q, it);
        else { const int j = it - T / 4; wconv_tile<true>(q.w_in, nullptr, 2320, 1024, (bf16_t*)(q.ws + OFF_WIN), 0, j % 16, j / 16, smem, (const float*)(q.ws + OFF_MOD), (float*)(q.ws + OFF_BIAS1), 2560); }
      }
      }
      GSYNC();
    }
    RELAUNDER();
    gemm_phase8<EP_P>(q, l, Hb, (const bf16_t*)(q.ws + OFF_WIN), 1024, 136, 10, lds, 2);
#if EXP == 1
    gemm_phase<EP_P>(q, l, Hb, 1024, (const bf16_t*)(q.ws + OFF_WIN), 1024, 1024, 136, 10, lds);
#endif
    GSYNC();
    RELAUNDER();
    {
      int* ctrc = (int*)(q.ws + OFF_CTR) + 8 + l;
      constexpr int NPAIR = (NB * 4 * NCH + NB * NCH) / 2;
      while (true) {
        __syncthreads();
        if (ltid_full() == 0) s_item = atomicAdd(ctrc, 1);
        __syncthreads();
        const int pi = s_item;
        if (pi >= NPAIR) break;
        const int hf = ltid_full() >> 8; char* smem = dsm + hf * HALF_SMEM;
        const int it = pi * 2 + hf;
        if (it < NB * 4 * NCH) dnprep_item(q, l, it, smem, dsm);
        else aprep_item(q, l, it - NB * 4 * NCH, smem);
      }
    }
    GSYNC();
    RELAUNDER();
    {
    {
#if EXP == 2
      for (int rep = 0; rep < 2; ++rep) {
      int* ctr = (int*)(q.ws + OFF_CTR) + l + rep * 8;
#else
      {
      int* ctr = (int*)(q.ws + OFF_CTR) + l;
#endif
      constexpr int N_SCAN = 32, N_FT = 128, N_FTC = 8, N_GA = 512, N_WA = 512, N_CTXA = 64;
      constexpr int N_WO = 16 * 16 / 2, N_GU = 16 * 88 / 2, N_WD = 44 * 16 / 2, N_WI = 16 * 40 / 2;
      const int n_ctxa = l < 3 ? N_CTXA : 0;
      const int TOT = N_SCAN + N_FT + N_FTC + N_GA + N_WA + n_ctxa + N_WO + N_GU + N_WD + (l < 3 ? N_WI : 0);
      while (true) {
        __syncthreads();
        if (ltid_full() == 0) s_item = atomicAdd(ctr, 1);
        __syncthreads();
        int it = s_item;
        if (it >= TOT) break;
        const int hf = ltid_full() >> 8; char* smem = dsm + hf * HALF_SMEM;
        if (it < N_SCAN) { dnscan_item(q, it * 2 + hf, lds + hf * 65536); continue; }
        it -= N_SCAN;
        if (it < N_FT) { gemm8<EP_FT>(q, l, (const bf16_t*)(q.ws + OFF_ADFT), 4160, (const bf16_t*)(q.ws + OFF_BTFT), 4160, 4160, (it >> 3) * 256, (it & 7) * 256, lds); continue; }
        it -= N_FT;
        if (it < N_FTC) { gemm8<EP_FTC>(q, l, (const bf16_t*)(q.ws + OFF_ADFTC), 512, (const bf16_t*)(q.ws + OFF_BTFTC), 512, 512, 0, it * 256, lds); continue; }
        it -= N_FTC;
        if (it < N_GA) { const int j = it * 2 + hf; attn_item(q, l, 0, j >> 7, (j >> 6) & 1, 4 + (j & 63), smem); continue; }
        it -= N_GA;
        if (it < N_WA) { const int j = it * 2 + hf; attn_item(q, l, 1, j >> 7, (j >> 6) & 1, 4 + (j & 63), smem); continue; }
        it -= N_WA;
        if (it < n_ctxa) { const int j = it * 2 + hf; const int type = j >> 6, r = j & 63; attn_item(q, l, type, r >> 3, (r >> 2) & 1, r & 3, smem); continue; }
        it -= n_ctxa;
        {
          int j = it * 2 + hf;
          if (j < 2 * N_WO) { wconv_tile<false>(q.w_out + (size_t)l * 1024 * 1024, nullptr, 1024, 1024, (bf16_t*)(q.ws + OFF_WOUT), 0, j % 16, j / 16, smem); continue; }
          j -= 2 * N_WO;
          if (j < 2 * N_GU) { wconv_tile<true>(q.w_gate + (size_t)l * 1024 * HID, q.w_up + (size_t)l * 1024 * HID, HID, 1024, (bf16_t*)(q.ws + OFF_WGU), 1, j % 16, j / 16, smem,
                                     (const float*)(q.ws + OFF_MOD) + (size_t)l * 9 * 6144 + 3072, (float*)(q.ws + OFF_BIAS2) + (size_t)l * 9 * 5632, 5632); continue; }
          j -= 2 * N_GU;
          if (j < 2 * N_WD) { wconv_tile<false>(q.w_down + (size_t)l * HID * 1024, nullptr, 1024, HID, (bf16_t*)(q.ws + OFF_WD), 0, j % 44, j / 44, smem); continue; }
          j -= 2 * N_WD;
          wconv_tile<true>(q.w_in + (size_t)(l + 1) * 1024 * 2320, nullptr, 2320, 1024, (bf16_t*)(q.ws + OFF_WIN), 0, j % 16, j / 16, smem,
                           (const float*)(q.ws + OFF_MOD) + (size_t)(l + 1) * 9 * 6144, (float*)(q.ws + OFF_BIAS1) + (size_t)(l + 1) * 9 * 2560, 2560);
        }
      }
      }
    }
    }
    GSYNC();
    RELAUNDER();
    { const int hf = ltid_full() >> 8; char* smem = dsm + hf * HALF_SMEM; (void)smem;
    {
      for (int pi = bid; pi < T / 8; pi += nblk) dnmerge_item(q, l, pi * 2 + hf);
    }
    }
    GSYNC();
    RELAUNDER();
#if EXP == 1
    gemm_phase<EP_DUMMY>(q, l, (const bf16_t*)(q.ws + OFF_YMIX), 1024, (const bf16_t*)(q.ws + OFF_WOUT), 1024, 1024, 136, 4, lds);
#endif
    gemm_phase8<EP_RES1>(q, l, (const bf16_t*)(q.ws + OFF_YMIX), (const bf16_t*)(q.ws + OFF_WOUT), 1024, l == 3 ? 128 : 136, 4, lds, l == 3 ? 1 : 2);
    GSYNC();
    RELAUNDER();
    gemm_phase8<EP_GU>(q, l, Hb, (const bf16_t*)(q.ws + OFF_WGU), 1024, l == 3 ? 128 : 136, 22, lds, l == 3 ? 1 : 0);
#if EXP == 1
    gemm_phase<EP_GU>(q, l, Hb, 1024, (const bf16_t*)(q.ws + OFF_WGU), 1024, 1024, l == 3 ? 128 : 136, 22, lds, l == 3);
#endif
    GSYNC();
    RELAUNDER();
#if EXP == 1
    gemm_phase<EP_DUMMY>(q, l, (const bf16_t*)(q.ws + OFF_HM), HID, (const bf16_t*)(q.ws + OFF_WD), HID, HID, 136, 4, lds);
#endif
    gemm_phase8<EP_RES2>(q, l, (const bf16_t*)(q.ws + OFF_HM), (const bf16_t*)(q.ws + OFF_WD), HID, l == 3 ? 128 : 136, 4, lds, l == 3 ? 1 : 2);
    GSYNC();
  }
}

#undef Hb
extern "C" void kernel_launch(void* const* d_in, const int* in_sizes, int n_in, void* d_out, int out_size, void* d_ws, size_t ws_size,
                              hipStream_t stream) {
  if (ws_size < WS_NEED) { fprintf(stderr, "workspace too small: %zu < %zu\n", ws_size, (size_t)WS_NEED); return; }
  static int grid_blocks = 0;
  if (!grid_blocks) {
    int dev = 0, cus = 0, per_cu = 0;
    (void)hipGetDevice(&dev);
    (void)hipDeviceGetAttribute(&cus, hipDeviceAttributeMultiprocessorCount, dev);
    if (hipFuncSetAttribute((const void*)mega, hipFuncAttributeMaxDynamicSharedMemorySize, LDS_BYTES) != hipSuccess) fprintf(stderr, "hipFuncSetAttribute failed\n");
    (void)hipOccupancyMaxActiveBlocksPerMultiprocessor(&per_cu, mega, 512, LDS_BYTES);
    if (per_cu < 1) { fprintf(stderr, "occupancy query returned %d\n", per_cu); per_cu = 1; }
    grid_blocks = (cus / 8) * 8;
  }
  Params p{};
  const float** pf = (const float**)&p;
  for (int i = 0; i < 22; ++i) pf[i] = (const float*)d_in[i];
  p.out = (float*)d_out;
  p.ws = (char*)d_ws;
  (void)hipMemsetAsync((char*)d_ws + OFF_BAR, 0, XCD_BAR_WORDS * 4, stream);
  void* args[] = {&p};
  hipError_t e = hipLaunchCooperativeKernel((void*)mega, dim3(grid_blocks), dim3(512), args, LDS_BYTES, stream);
  if (e != hipSuccess) fprintf(stderr, "cooperative launch failed: %s (grid %d)\n", hipGetErrorString(e), grid_blocks);
}
```

```cpp
#include <hip/hip_runtime.h>
#include <hip/hip_cooperative_groups.h>
#include <stdint.h>
#include <stdio.h>
namespace cg = cooperative_groups;

typedef unsigned short bf16_t;
typedef short bf16x8 __attribute__((ext_vector_type(8)));
typedef short bf16x4 __attribute__((ext_vector_type(4)));
typedef float f32x4 __attribute__((ext_vector_type(4)));
typedef unsigned u32x4 __attribute__((ext_vector_type(4)));
#define DI __device__ __forceinline__
#define MFMA16(a, b, c) __builtin_amdgcn_mfma_f32_16x16x32_bf16((a), (b), (c), 0, 0, 0)

constexpr int NB = 8, SEQ = 4096, LC = 256, TB = 4352, T = NB * TB, DM = 1024, PW = 2064, HID = 2816, NCH = 68;
constexpr int NIN_PAD = 2560;
constexpr float EPS = 1e-6f;
constexpr float LOG2E = 1.4426950408889634f;

constexpr size_t OFF_MOD = 0;
constexpr size_t OFF_ROPEC = 1u << 20;
constexpr size_t OFF_ROPES = OFF_ROPEC + 524288;
constexpr size_t OFF_CS64 = OFF_ROPES + 524288;
constexpr size_t OFF_ADFTC = OFF_CS64 + 16384;
constexpr size_t OFF_CTR = OFF_ADFTC + 262144;
constexpr size_t OFF_BAR = OFF_CTR + 4096;
constexpr size_t OFF_XC = 2621440;
constexpr size_t OFF_HB = OFF_XC + 8388608;
constexpr size_t SZ_HB = (size_t)T * 1024 * 2;
constexpr size_t OFF_QA = OFF_HB;
constexpr size_t OFF_KA = OFF_QA + (size_t)2 * T * 256 * 2;
constexpr size_t OFF_VT = OFF_KA + (size_t)2 * T * 128 * 2;
constexpr size_t OFF_P = OFF_HB + SZ_HB;
constexpr size_t SZ_P = (size_t)T * PW * 2;
constexpr size_t OFF_YMIX = OFF_P;
constexpr size_t OFF_ODN = OFF_P + SZ_HB;
constexpr size_t OFF_Z = OFF_P + SZ_P;
constexpr size_t OFF_BTFT = OFF_Z + (size_t)T * 256 * 2;
constexpr size_t OFF_BTFTC = OFF_BTFT + (size_t)2048 * 8192 * 2;
constexpr size_t OFF_HM = OFF_P;
constexpr size_t OFF_ADFT = OFF_BTFTC + (size_t)2048 * 512 * 2;
constexpr size_t OFF_RSS1 = OFF_ADFT + (size_t)4096 * 4160 * 2;
constexpr size_t OFF_RSS2 = OFF_RSS1 + (size_t)T * 4;
constexpr size_t OFF_BIAS1 = OFF_RSS2 + (size_t)T * 4;
constexpr size_t OFF_BIAS2 = OFF_BIAS1 + (size_t)4 * 9 * 2560 * 4;
constexpr size_t OFF_DN = OFF_ADFT + (size_t)4096 * 8192 * 2;
constexpr size_t SZ_CB = 40960;
constexpr int NCB = NB * 4 * 2 * NCH;
constexpr size_t OFF_GEND = OFF_DN + (size_t)NCB * SZ_CB;
constexpr size_t WS_NEED = OFF_GEND + (size_t)NCB * 64 * 4;
constexpr size_t OFF_WIN = OFF_BIAS2 + (size_t)4 * 9 * 5632 * 4;
constexpr size_t OFF_WOUT = OFF_WIN + (size_t)NIN_PAD * 1024 * 2;
constexpr size_t OFF_WGU = OFF_WOUT + (size_t)1024 * 1024 * 2;
constexpr size_t OFF_WD = OFF_WGU + (size_t)5632 * 1024 * 2;
static_assert(OFF_WD + (size_t)1024 * 2816 * 2 <= OFF_ADFT + (size_t)4096 * 8192 * 2, "weights overflow the ADFT region tail");
static_assert((size_t)T * HID * 2 <= OFF_ADFT - OFF_P, "Hm alias overflow");

struct Params {
  const float *x, *c, *ctx, *c_ctx, *norm1_g, *norm2_g, *w_ada, *b_ada, *w_in, *conv_w, *A_log, *dt_bias, *dn_norm_g,
      *ga_qn, *ga_kn, *wa_qn, *wa_kn, *wa_sink, *w_out, *w_gate, *w_up, *w_down;
  float* out;
  char* ws;
};

constexpr int HALF_SMEM = 53248;
constexpr int LDS_BYTES = 131072 + 8192;
#define LAS __attribute__((address_space(3)))
#define WAIT_V(n) asm volatile("s_waitcnt vmcnt(%0)" ::"n"(n) : "memory")

DI unsigned pk(float a, float b) {
  typedef __bf16 bf2 __attribute__((ext_vector_type(2)));
  typedef float f2 __attribute__((ext_vector_type(2)));
  f2 v = {a, b};
  bf2 r = __builtin_convertvector(v, bf2);
  return __builtin_bit_cast(unsigned, r);
}
DI bf16_t f2bf(float a) { return (bf16_t)(pk(a, 0.f) & 0xffffu); }
DI float bf2f(bf16_t h) { return __uint_as_float(((unsigned)h) << 16); }
DI float bflo(unsigned u) { return __uint_as_float(u << 16); }
DI float bfhi(unsigned u) { return __uint_as_float(u & 0xffff0000u); }
DI int ltid_full() { int t = threadIdx.x; asm volatile("" : "+v"(t)); return t; }
DI int ltid() { return ltid_full() & 255; }
DI float silu_f(float x) { return x * __builtin_amdgcn_rcpf(1.f + __expf(-x)); }
DI int permk(int x) { return ((x >> 5) << 5) + (((x >> 2) & 3) << 3) + (((x >> 4) & 1) << 2) + (x & 3); }

DI float* xrow(const Params& p, int t) {
  int b = t / TB, tb = t - b * TB;
  return tb < LC ? (float*)(p.ws + OFF_XC) + ((size_t)(b * LC + tb)) * DM : p.out + ((size_t)(b * SEQ + tb - LC)) * DM;
}
DI const float* xrow_in(const Params& p, int t) {
  int b = t / TB, tb = t - b * TB;
  return tb < LC ? p.ctx + ((size_t)(b * LC + tb)) * DM : p.x + ((size_t)(b * SEQ + tb - LC)) * DM;
}
DI int bidx_of(int t) { const int b = t / TB, tb = t - b * TB; return tb < LC ? 8 : b; }
DI const float* modrow(const Params& p, int l, int t) {
  int b = t / TB, tb = t - b * TB;
  int bi = tb < LC ? 8 : b;
  return (const float*)(p.ws + OFF_MOD) + ((size_t)(l * 9 + bi)) * 6144;
}

enum { EP_P = 0, EP_RES1 = 1, EP_GU = 2, EP_RES2 = 3, EP_FT = 4, EP_FTC = 5, EP_DUMMY = 6 };
#ifndef EXP
#define EXP 0
#endif

DI int lds_byte(int r, int c) {
  const int st = (r >> 4) * 2 + (c >> 5), ob = (r & 15) * 64 + (c & 31) * 2;
  return st * 1024 + (ob ^ (((ob >> 9) & 1) << 5));
}
DI void stage_rc(int b, int& R, int& C) {
  const int st = b >> 10, sb = b & 1023, swz = sb ^ (((sb >> 9) & 1) << 5);
  R = (st >> 1) * 16 + swz / 64;
  C = (st & 1) * 32 + (swz % 64) / 2;
}

template <int MODE>
DI void gemm_epilogue(const Params& p, int l, const f32x4 (&acc)[8][4], int m0, int n0, int wr, int wc, int fr, int fq, const LAS float* cst) {
#pragma unroll
  for (int i = 0; i < 8; ++i) {
    const int m = m0 + wr * 128 + i * 16 + fr;
    if (MODE == EP_P) {
      bf16_t* Pp = (bf16_t*)(p.ws + OFF_P) + (size_t)m * PW;
      bf16_t* Zp = (bf16_t*)(p.ws + OFF_Z) + (size_t)m * 256;
      const float rs = rsqrtf(cst[wr * 128 + i * 16 + fr] * (1.f / 1024.f) + EPS);
#pragma unroll
      for (int j = 0; j < 4; ++j) {
        const int n = n0 + wc * 64 + j * 16 + fq * 4;
        const f32x4 bq = *(const LAS f32x4*)(cst + 256 + wc * 64 + j * 16 + fq * 4);
        uint2 v = {pk(acc[i][j][0] * rs + bq[0], acc[i][j][1] * rs + bq[1]), pk(acc[i][j][2] * rs + bq[2], acc[i][j][3] * rs + bq[3])};
        if (n < 768) *(uint2*)(Pp + n) = v;
        else if (n < 1024) *(uint2*)(Zp + (n - 768)) = v;
        else if (n < 2320) *(uint2*)(Pp + (n - 256)) = v;
      }
    } else if (MODE == EP_RES1 || MODE == EP_RES2) {
      float* xo = xrow(p, m);
      const bool emit = (MODE == EP_RES1) || (l < 3);
      bf16_t* hb = (bf16_t*)(p.ws + OFF_HB) + (size_t)m * 1024;
      float4 xv[4];
#pragma unroll
      for (int j = 0; j < 4; ++j) xv[j] = *(const float4*)(xo + n0 + wc * 64 + j * 16 + fq * 4);
      float ssq = 0.f;
#pragma unroll
      for (int j = 0; j < 4; ++j) {
        const int n = n0 + wc * 64 + j * 16 + fq * 4;
        const f32x4 gq = *(const LAS f32x4*)(cst + 256 + wc * 64 + j * 16 + fq * 4), mq = *(const LAS f32x4*)(cst + 512 + wc * 64 + j * 16 + fq * 4);
        const float4 gv = {gq[0], gq[1], gq[2], gq[3]}, mv = {mq[0], mq[1], mq[2], mq[3]};
        xv[j].x += gv.x * acc[i][j][0]; xv[j].y += gv.y * acc[i][j][1]; xv[j].z += gv.z * acc[i][j][2]; xv[j].w += gv.w * acc[i][j][3];
        *(float4*)(xo + n) = xv[j];
        if (emit) {
          ssq += xv[j].x * xv[j].x + xv[j].y * xv[j].y + xv[j].z * xv[j].z + xv[j].w * xv[j].w;
          *(uint2*)(hb + n) = uint2{pk(xv[j].x * mv.x, xv[j].y * mv.y), pk(xv[j].z * mv.z, xv[j].w * mv.w)};
        }
      }
      if (emit) {
        ssq += __shfl_xor(ssq, 16);
        ssq += __shfl_xor(ssq, 32);
        if (fq == 0) unsafeAtomicAdd((float*)(p.ws + (MODE == EP_RES1 ? OFF_RSS2 : OFF_RSS1)) + m, ssq);
      }
    } else if (MODE == EP_GU) {
      bf16_t* hp = (bf16_t*)(p.ws + OFF_HM) + (size_t)m * HID;
      const float rs = rsqrtf(cst[wr * 128 + i * 16 + fr] * (1.f / 1024.f) + EPS);
#pragma unroll
      for (int jj = 0; jj < 2; ++jj) {
        const int hcol = ((n0 + wc * 64) >> 1) + jj * 16 + fq * 4;
        const f32x4 bg = *(const LAS f32x4*)(cst + 256 + wc * 64 + (2 * jj) * 16 + fq * 4), bu = *(const LAS f32x4*)(cst + 256 + wc * 64 + (2 * jj + 1) * 16 + fq * 4);
        const float bgv[4] = {bg[0], bg[1], bg[2], bg[3]}, buv[4] = {bu[0], bu[1], bu[2], bu[3]};
        float o[4];
#pragma unroll
        for (int r = 0; r < 4; ++r) o[r] = silu_f(acc[i][2 * jj][r] * rs + bgv[r]) * (acc[i][2 * jj + 1][r] * rs + buv[r]);
        uint2 v = {pk(o[0], o[1]), pk(o[2], o[3])};
        *(uint2*)(hp + hcol) = v;
      }
    } else if (MODE == EP_DUMMY) {
      bf16_t* dp = (bf16_t*)(p.ws + OFF_DN + (size_t)40 * 1024 * 1024) + (size_t)m * 1024;
#pragma unroll
      for (int j = 0; j < 4; ++j) {
        const int n = n0 + wc * 64 + j * 16 + fq * 4;
        *(uint2*)(dp + n) = uint2{pk(acc[i][j][0], acc[i][j][1]), pk(acc[i][j][2], acc[i][j][3])};
      }
    } else {
      bf16_t* Y = (bf16_t*)(p.ws + OFF_YMIX);
      const float scale = (MODE == EP_FT) ? (1.f / 512.f) : (1.f / 128.f);
#pragma unroll
      for (int j = 0; j < 4; ++j) {
        const int n = n0 + wc * 64 + j * 16 + fq * 4;
        const int b = n >> 8;
        const size_t row = (size_t)b * TB + (MODE == EP_FT ? LC : 0) + m;
        uint2 v = {pk(acc[i][j][0] * scale, acc[i][j][1] * scale), pk(acc[i][j][2] * scale, acc[i][j][3] * scale)};
        *(uint2*)(Y + row * 1024 + 768 + (n & 255)) = v;
      }
    }
  }
}

constexpr int G8_TILE_B = 256 * 64 * 2, G8_STAGE_B = 2 * G8_TILE_B;
#define G8_STAGE(Ab_, Bb_, buf, kt)                                                                                                            \
  do {                                                                                                                                        \
    _Pragma("unroll") for (int i = 0; i < 4; ++i) {                                                                                           \
      __builtin_amdgcn_global_load_lds((const unsigned*)((Ab_) + offA[i] + (kt) * 64), (LAS unsigned*)(lds + (buf) * G8_STAGE_B + wid * 1024 + i * 8192), 16, 0, 0);               \
      __builtin_amdgcn_global_load_lds((const unsigned*)((Bb_) + offB[i] + (kt) * 64), (LAS unsigned*)(lds + (buf) * G8_STAGE_B + G8_TILE_B + wid * 1024 + i * 8192), 16, 0, 0);   \
    }                                                                                                                                         \
  } while (0)
#define G8_COMPUTE(buf)                                                                                                                       \
  do {                                                                                                                                        \
    const LAS char* sa = lds + (buf) * G8_STAGE_B;                                                                                            \
    const LAS char* sb = sa + G8_TILE_B;                                                                                                      \
    _Pragma("unroll") for (int ks = 0; ks < 2; ++ks) {                                                                                        \
      bf16x8 bfr[4];                                                                                                                          \
      _Pragma("unroll") for (int j = 0; j < 4; ++j) bfr[j] = *(const LAS bf16x8*)(sb + lds_byte(wc * 64 + j * 16 + fr, ks * 32 + fq * 8));    \
      bf16x8 a_cur = *(const LAS bf16x8*)(sa + lds_byte(wr * 128 + fr, ks * 32 + fq * 8));                                                    \
      _Pragma("unroll") for (int i = 0; i < 8; ++i) {                                                                                         \
        bf16x8 a_nxt = a_cur;                                                                                                                 \
        if (i < 7) a_nxt = *(const LAS bf16x8*)(sa + lds_byte(wr * 128 + (i + 1) * 16 + fr, ks * 32 + fq * 8));          \
        _Pragma("unroll") for (int j = 0; j < 4; ++j) acc[i][j] = MFMA16(bfr[j], a_cur, acc[i][j]);                                           \
        __builtin_amdgcn_sched_group_barrier(0x100, 1, 0);                                                                                    \
        __builtin_amdgcn_sched_group_barrier(0x008, 4, 0);                                                                                    \
        a_cur = a_nxt;                                                                                                                        \
      }                                                                                                                                       \
    }                                                                                                                                         \
  } while (0)
#define G8_SETUP()                                                                                                                            \
  const int tid = ltid_full(), wid = tid >> 6, lane = tid & 63;                                                                               \
  const int wr = wid >> 2, wc = wid & 3, fr = lane & 15, fq = lane >> 4;                                                                      \
  int offA[4], offB[4];                                                                                                                       \
  _Pragma("unroll") for (int i = 0; i < 4; ++i) {                                                                                             \
    int R, C;                                                                                                                                 \
    stage_rc(wid * 1024 + i * 8192 + lane * 16, R, C);                                                                                        \
    offA[i] = R * lda + C;                                                                                                                    \
    offB[i] = R * ldb + C;                                                                                                                    \
  }

template <int MODE>
DI void gemm8(const Params& p, int l, const bf16_t* A, int lda, const bf16_t* Bt, int ldb, int K, int m0, int n0, LAS char* lds) {
  G8_SETUP();
  f32x4 acc[8][4];
#pragma unroll
  for (int i = 0; i < 8; ++i)
#pragma unroll
    for (int j = 0; j < 4; ++j) acc[i][j] = f32x4{0.f, 0.f, 0.f, 0.f};
  const bf16_t* Ab = A + (size_t)m0 * lda;
  const bf16_t* Bb = Bt + (size_t)n0 * ldb;
  const int nt = K >> 6;
  G8_STAGE(Ab, Bb, 0, 0);
  WAIT_V(0);
  __syncthreads();
  for (int t = 0; t < nt; ++t) {
    const int cur = t & 1;
    if (t + 1 < nt) G8_STAGE(Ab, Bb, cur ^ 1, t + 1);
    G8_COMPUTE(cur);
    WAIT_V(0);
    __syncthreads();
  }
  gemm_epilogue<MODE>(p, l, acc, m0, n0, wr, wc, fr, fq, (const LAS float*)(lds + 131072));
}

struct GTile { int m0, n0, kb, nk, atomic; };
template <int MODE>
DI bool gemm_next_tile(int k, int nM, int nN, int Kit, GTile& g, bool skipctx = false) {
  const int ntl = nM * nN, per = ntl >> 3;
  const int nb8 = gridDim.x >> 3, xcd = blockIdx.x & 7, j = blockIdx.x >> 3;
  const int R = per / nb8, rem = per - R * nb8;
  int loc;
  g.kb = 0; g.nk = Kit; g.atomic = 0;
  if (k < R) loc = k * nb8 + j;
  else if (k == R && rem > 0) {
    int S = 1;
    if (false) { S = nb8 / rem; while (S > 1 && (Kit % S)) --S; }
    if (j >= rem * S) return false;
    loc = R * nb8 + j / S;
    if (S > 1) { g.nk = Kit / S; g.kb = (j % S) * g.nk; g.atomic = 1; }
  } else return false;
  const int L = xcd * per + loc;
  const int nig = 8 * nN, gid = L / nig, fm = gid * 8, gsz = (nM - fm) < 8 ? (nM - fm) : 8;
  int pm = fm + ((L % nig) % gsz);
  if (skipctx) pm += pm / 16 + 1;
  g.m0 = pm * 256;
  g.n0 = ((L % nig) / gsz) * 256;
  return true;
}

template <int MODE>
DI void gemm_phase(const Params& p, int l, const bf16_t* A, int lda, const bf16_t* Bt, int ldb, int K, int nM, int nN, LAS char* lds, bool skipctx = false) {
  G8_SETUP();
  const int Kit = K >> 6;
  GTile cur, nxt;
  bool have = gemm_next_tile<MODE>(0, nM, nN, Kit, cur, skipctx);
  if (have) G8_STAGE(A + (size_t)cur.m0 * lda, Bt + (size_t)cur.n0 * ldb, 0, cur.kb);
  for (int k = 0; have; ++k) {
    const bool hn = gemm_next_tile<MODE>(k + 1, nM, nN, Kit, nxt, skipctx);
    f32x4 acc[8][4];
#pragma unroll
    for (int i = 0; i < 8; ++i)
#pragma unroll
      for (int j = 0; j < 4; ++j) acc[i][j] = f32x4{0.f, 0.f, 0.f, 0.f};
    const bf16_t* Ab = A + (size_t)cur.m0 * lda;
    const bf16_t* Bb = Bt + (size_t)cur.n0 * ldb;
    LAS float* cst = (LAS float*)(lds + 131072 + (k & 1) * 4096);
    if (MODE == EP_P || MODE == EP_GU) {
      const float* rss = (const float*)(p.ws + (MODE == EP_P ? OFF_RSS1 : OFF_RSS2));
      const float* bias = (const float*)(p.ws + (MODE == EP_P ? OFF_BIAS1 : OFF_BIAS2)) + ((size_t)(l * 9 + bidx_of(cur.m0))) * (MODE == EP_P ? 2560 : 5632);
      cst[tid] = tid < 256 ? rss[cur.m0 + tid] : bias[cur.n0 + tid - 256];
    }
    if (MODE == EP_RES1 || MODE == EP_RES2) {
      const float* mrow = modrow(p, l, cur.m0);
      const int c = cur.n0 + (tid & 255);
      if (tid < 256) cst[256 + tid] = mrow[(MODE == EP_RES1 ? 2048 : 5120) + c];
      else {
        const float* ng = (MODE == EP_RES1) ? p.norm2_g + l * 1024 : p.norm1_g + (l < 3 ? l + 1 : 0) * 1024;
        const float* nsc = (MODE == EP_RES1) ? mrow + 4096 : modrow(p, l < 3 ? l + 1 : 0, cur.m0) + 1024;
        cst[256 + tid] = ng[c] * (1.f + nsc[c]);
      }
    }
    WAIT_V(0);
    __syncthreads();
    for (int t = 0; t < cur.nk; ++t) {
      const int cb = t & 1;
      if (t + 1 < cur.nk) G8_STAGE(Ab, Bb, cb ^ 1, cur.kb + t + 1);
      G8_COMPUTE(cb);
      WAIT_V(0);
      __syncthreads();
    }
    if (hn) G8_STAGE(A + (size_t)nxt.m0 * lda, Bt + (size_t)nxt.n0 * ldb, 0, nxt.kb);
    gemm_epilogue<MODE>(p, l, acc, cur.m0, cur.n0, wr, wc, fr, fq, cst);
    cur = nxt;
    have = hn;
  }
}

template <int MODE>
DI void gemm_epilogue8(const Params& p, int l, const f32x4 (&acc)[2][2][4][2], int m0, int n0, int wr, int wc, int fr, int fq, const LAS float* cst, bool half) {
#pragma unroll
  for (int ai = 0; ai < 2; ++ai)
#pragma unroll
    for (int mm = 0; mm < 4; ++mm) {
      if (ai == 1 && half) continue;
      const int rl = ai * 128 + wr * 64 + mm * 16 + fr;
      const int m = m0 + rl;
      if (MODE == EP_P) {
        bf16_t* Pp = (bf16_t*)(p.ws + OFF_P) + (size_t)m * PW;
        bf16_t* Zp = (bf16_t*)(p.ws + OFF_Z) + (size_t)m * 256;
        const float rs = rsqrtf(cst[rl] * (1.f / 1024.f) + EPS);
#pragma unroll
        for (int bj = 0; bj < 2; ++bj)
#pragma unroll
          for (int nn = 0; nn < 2; ++nn) {
            const int cl = bj * 128 + wc * 32 + nn * 16 + fq * 4, n = n0 + cl;
            const f32x4 bq = *(const LAS f32x4*)(cst + 256 + cl);
            const f32x4& a = acc[ai][bj][mm][nn];
            uint2 v = {pk(a[0] * rs + bq[0], a[1] * rs + bq[1]), pk(a[2] * rs + bq[2], a[3] * rs + bq[3])};
            if (n < 768) *(uint2*)(Pp + n) = v;
            else if (n < 1024) *(uint2*)(Zp + (n - 768)) = v;
            else if (n < 2320) *(uint2*)(Pp + (n - 256)) = v;
          }
      } else if (MODE == EP_RES1 || MODE == EP_RES2) {
        float* xo = xrow(p, m);
        const bool emit = (MODE == EP_RES1) || (l < 3);
        bf16_t* hb = (bf16_t*)(p.ws + OFF_HB) + (size_t)m * 1024;
        float4 xv[4];
#pragma unroll
        for (int q4 = 0; q4 < 4; ++q4) xv[q4] = *(const float4*)(xo + n0 + (q4 >> 1) * 128 + wc * 32 + (q4 & 1) * 16 + fq * 4);
        float ssq = 0.f;
#pragma unroll
        for (int q4 = 0; q4 < 4; ++q4) {
          const int cl = (q4 >> 1) * 128 + wc * 32 + (q4 & 1) * 16 + fq * 4, n = n0 + cl;
          const f32x4 gq = *(const LAS f32x4*)(cst + 256 + cl), mq = *(const LAS f32x4*)(cst + 512 + cl);
          const f32x4& a = acc[ai][q4 >> 1][mm][q4 & 1];
          xv[q4].x += gq[0] * a[0]; xv[q4].y += gq[1] * a[1]; xv[q4].z += gq[2] * a[2]; xv[q4].w += gq[3] * a[3];
          *(float4*)(xo + n) = xv[q4];
          if (emit) {
            ssq += xv[q4].x * xv[q4].x + xv[q4].y * xv[q4].y + xv[q4].z * xv[q4].z + xv[q4].w * xv[q4].w;
            *(uint2*)(hb + n) = uint2{pk(xv[q4].x * mq[0], xv[q4].y * mq[1]), pk(xv[q4].z * mq[2], xv[q4].w * mq[3])};
          }
        }
        if (emit) {
          ssq += __shfl_xor(ssq, 16);
          ssq += __shfl_xor(ssq, 32);
          if (fq == 0) unsafeAtomicAdd((float*)(p.ws + (MODE == EP_RES1 ? OFF_RSS2 : OFF_RSS1)) + m, ssq);
        }
      } else if (MODE == EP_GU) {
        bf16_t* hp = (bf16_t*)(p.ws + OFF_HM) + (size_t)m * HID;
        const float rs = rsqrtf(cst[rl] * (1.f / 1024.f) + EPS);
#pragma unroll
        for (int bj = 0; bj < 2; ++bj) {
          const int cl = bj * 128 + wc * 32 + fq * 4;
          const int hcol = ((n0 + bj * 128 + wc * 32) >> 1) + fq * 4;
          const f32x4 bg = *(const LAS f32x4*)(cst + 256 + cl), bu = *(const LAS f32x4*)(cst + 256 + cl + 16);
          const f32x4& ag = acc[ai][bj][mm][0];
          const f32x4& au = acc[ai][bj][mm][1];
          float o[4];
#pragma unroll
          for (int r = 0; r < 4; ++r) o[r] = silu_f(ag[r] * rs + bg[r]) * (au[r] * rs + bu[r]);
          *(uint2*)(hp + hcol) = uint2{pk(o[0], o[1]), pk(o[2], o[3])};
        }
      } else {
        bf16_t* dp = (bf16_t*)(p.ws + OFF_DN + (size_t)40 * 1024 * 1024) + (size_t)m * 1024;
#pragma unroll
        for (int q4 = 0; q4 < 4; ++q4) {
          const f32x4& a = acc[ai][q4 >> 1][mm][q4 & 1];
          *(uint2*)(dp + n0 + (q4 >> 1) * 128 + wc * 32 + (q4 & 1) * 16 + fq * 4) = uint2{pk(a[0], a[1]), pk(a[2], a[3])};
        }
      }
    }
}

DI bool next_tile8(int k, int nM, int nN, int Kit, GTile& g, int ctxmode) {
  if (ctxmode != 2) return gemm_next_tile<EP_P>(k, nM, nN, Kit, g, ctxmode == 1);
  if (gemm_next_tile<EP_P>(k, 128, nN, Kit, g, true)) return true;
  const int nb8 = gridDim.x >> 3, per = 16 * nN, R = per / nb8, kx = R + ((per - R * nb8) > 0 ? 1 : 0);
  const int j = blockIdx.x >> 3;
  if (k != kx || j >= 2 * nN) return false;
  const int u = (blockIdx.x & 7) * (2 * nN) + j;
  g.m0 = (blockIdx.x & 7) * 17 * 256 + ((j / nN) & 1) * 128;
  g.n0 = (j % nN) * 256;
  g.kb = 0; g.nk = Kit; g.atomic = 1;
  (void)u;
  return true;
}

template <int MODE>
DI void gemm_phase8(const Params& p, int l, const bf16_t* A, const bf16_t* Bt, int K, int nM, int nN, LAS char* lds, int ctxmode) {
  constexpr int HT = 128 * 64;
  const int tid = ltid_full(), wid = tid >> 6, lane = tid & 63;
  const int wr = wid >> 2, wc = wid & 3, fr = lane & 15, fq = lane >> 4;
  unsigned soff[2];
#pragma unroll
  for (int i = 0; i < 2; ++i) { int R, C; stage_rc(tid * 16 + i * 8192, R, C); soff[i] = (unsigned)(R * K + C) * 2u; }
#define P8_SA(b, h) (lds + (((b) * 2 + (h)) * HT) * 2)
#define P8_SB(b, h) (lds + ((4 + (b) * 2 + (h)) * HT) * 2)
#define P8_STAGE(P_, BASE_, br_, kt_)                                                                                                          \
  do {                                                                                                                                        \
    const unsigned long long _gi = (unsigned long long)((BASE_) + (size_t)(br_) * K + (size_t)(kt_) * 64);                                       \
    const char* _g = (const char*)(((unsigned long long)(unsigned)__builtin_amdgcn_readfirstlane((int)(_gi >> 32)) << 32) |                    \
                                   (unsigned)__builtin_amdgcn_readfirstlane((int)(unsigned)_gi));     \
    _Pragma("unroll") for (int _i = 0; _i < 2; ++_i)                                                                                          \
      __builtin_amdgcn_global_load_lds((const unsigned*)(_g + soff[_i]), (LAS unsigned*)((P_) + wid * 1024 + _i * 8192), 16, 0, 0);            \
  } while (0)
#define P8_LDA(dst, b, h)                                                                                                                     \
  _Pragma("unroll") for (int m_ = 0; m_ < 4; ++m_) _Pragma("unroll") for (int k_ = 0; k_ < 2; ++k_)                                           \
    dst[m_][k_] = *(const LAS bf16x8*)(P8_SA(b, h) + lds_byte(wr * 64 + m_ * 16 + fr, k_ * 32 + fq * 8))
#define P8_LDB(dst, b, h)                                                                                                                     \
  _Pragma("unroll") for (int n_ = 0; n_ < 2; ++n_) _Pragma("unroll") for (int k_ = 0; k_ < 2; ++k_)                                           \
    dst[n_][k_] = *(const LAS bf16x8*)(P8_SB(b, h) + lds_byte(wc * 32 + n_ * 16 + fr, k_ * 32 + fq * 8))
#define P8_MMA(ai, bj, At_, Bt_)                                                                                                              \
  do {                                                                                                                                        \
    __builtin_amdgcn_s_setprio(1);                                                                                                            \
    _Pragma("unroll") for (int m_ = 0; m_ < 4; ++m_) _Pragma("unroll") for (int n_ = 0; n_ < 2; ++n_) _Pragma("unroll") for (int k_ = 0; k_ < 2; ++k_) \
      acc[ai][bj][m_][n_] = MFMA16(Bt_[n_][k_], At_[m_][k_], acc[ai][bj][m_][n_]);                                                            \
    __builtin_amdgcn_s_setprio(0);                                                                                                            \
  } while (0)
#define P8_MMA_B1(ai, bj, At_, Bt_) do { if (!skipb1 && !((ai) == 1 && half)) P8_MMA(ai, bj, At_, Bt_); } while (0)
#define P8_MMA_A1(ai, bj, At_, Bt_) do { if (!half) P8_MMA(ai, bj, At_, Bt_); } while (0)
#define P8_WAIT_L(n) asm volatile("s_waitcnt lgkmcnt(%0)" ::"n"(n) : "memory")
#define P8_BAR __builtin_amdgcn_s_barrier()
#define P8_SCHED __builtin_amdgcn_sched_barrier(0)
  const int nt = K >> 6;
  GTile cur;
  for (int k = 0; next_tile8(k, nM, nN, nt, cur, ctxmode); ++k) {
    const int brow = cur.m0, bcol = cur.n0;
    const bool half = cur.atomic != 0;
    const bool skipb1 = (MODE == EP_P) && (bcol + 128 >= 2320);
    LAS float* cst = (LAS float*)(lds + 131072 + (k & 1) * 4096);
    if (MODE == EP_P || MODE == EP_GU) {
      const float* rss = (const float*)(p.ws + (MODE == EP_P ? OFF_RSS1 : OFF_RSS2));
      const float* bias = (const float*)(p.ws + (MODE == EP_P ? OFF_BIAS1 : OFF_BIAS2)) + ((size_t)(l * 9 + bidx_of(brow))) * (MODE == EP_P ? 2560 : 5632);
      cst[tid] = tid < 256 ? rss[brow + tid] : bias[bcol + tid - 256];
    }
    if (MODE == EP_RES1 || MODE == EP_RES2) {
      const float* mrow = modrow(p, l, brow);
      const int c = bcol + (tid & 255);
      if (tid < 256) cst[256 + tid] = mrow[(MODE == EP_RES1 ? 2048 : 5120) + c];
      else {
        const float* ng = (MODE == EP_RES1) ? p.norm2_g + l * 1024 : p.norm1_g + (l < 3 ? l + 1 : 0) * 1024;
        const float* nsc = (MODE == EP_RES1) ? mrow + 4096 : modrow(p, l < 3 ? l + 1 : 0, brow) + 1024;
        cst[256 + tid] = ng[c] * (1.f + nsc[c]);
      }
    }
    f32x4 acc[2][2][4][2];
#pragma unroll
    for (int a_ = 0; a_ < 2; ++a_)
#pragma unroll
      for (int b_ = 0; b_ < 2; ++b_)
#pragma unroll
        for (int m_ = 0; m_ < 4; ++m_)
#pragma unroll
          for (int n_ = 0; n_ < 2; ++n_) acc[a_][b_][m_][n_] = f32x4{0.f, 0.f, 0.f, 0.f};
    bf16x8 At[4][2], B0[2][2], B1[2][2];
    __syncthreads();
    P8_STAGE(P8_SB(0, 0), Bt, bcol, 0); P8_STAGE(P8_SA(0, 0), A, brow, 0);
    P8_STAGE(P8_SB(0, 1), Bt, bcol + 128, 0); P8_STAGE(P8_SA(0, 1), A, brow + 128, 0);
    if (wr == 1) P8_BAR;
    WAIT_V(4); P8_BAR;
    P8_STAGE(P8_SB(1, 0), Bt, bcol, 1); P8_STAGE(P8_SA(1, 0), A, brow, 1); P8_STAGE(P8_SB(1, 1), Bt, bcol + 128, 1);
    WAIT_V(6); P8_BAR;
    for (int t = 0; t < nt - 2; t += 2) {
      P8_LDB(B0, 0, 0); P8_SCHED; P8_LDA(At, 0, 0); P8_STAGE(P8_SA(1, 1), A, brow + 128, t + 1);
      P8_WAIT_L(8); P8_BAR; P8_WAIT_L(0); P8_MMA(0, 0, At, B0); P8_BAR; P8_SCHED;
      P8_LDB(B1, 0, 1); P8_STAGE(P8_SB(0, 0), Bt, bcol, t + 2);
      P8_BAR; P8_WAIT_L(0); P8_MMA_B1(0, 1, At, B1); P8_BAR;
      P8_LDA(At, 0, 1); P8_STAGE(P8_SA(0, 0), A, brow, t + 2);
      P8_BAR; P8_WAIT_L(0); P8_MMA_A1(1, 0, At, B0); P8_BAR; P8_SCHED;
      P8_STAGE(P8_SB(0, 1), Bt, bcol + 128, t + 2);
      WAIT_V(6); P8_BAR; P8_MMA_B1(1, 1, At, B1); P8_BAR;
      P8_LDB(B0, 1, 0); P8_SCHED; P8_LDA(At, 1, 0); P8_STAGE(P8_SA(0, 1), A, brow + 128, t + 2);
      P8_WAIT_L(8); P8_BAR; P8_WAIT_L(0); P8_MMA(0, 0, At, B0); P8_BAR; P8_SCHED;
      P8_LDB(B1, 1, 1); P8_STAGE(P8_SB(1, 0), Bt, bcol, t + 3);
      P8_BAR; P8_WAIT_L(0); P8_MMA_B1(0, 1, At, B1); P8_BAR;
      P8_LDA(At, 1, 1); P8_STAGE(P8_SA(1, 0), A, brow, t + 3);
      P8_BAR; P8_WAIT_L(0); P8_MMA_A1(1, 0, At, B0); P8_BAR; P8_SCHED;
      P8_STAGE(P8_SB(1, 1), Bt, bcol + 128, t + 3);
      WAIT_V(6); P8_BAR; P8_MMA_B1(1, 1, At, B1); P8_BAR;
    }
    { P8_LDB(B0, 0, 0); P8_LDA(At, 0, 0); P8_STAGE(P8_SA(1, 1), A, brow + 128, nt - 1);
      P8_BAR; P8_WAIT_L(0); P8_MMA(0, 0, At, B0); P8_BAR;
      P8_LDB(B1, 0, 1); P8_BAR; P8_WAIT_L(0); P8_MMA_B1(0, 1, At, B1); P8_BAR;
      P8_LDA(At, 0, 1); WAIT_V(4); P8_BAR; P8_WAIT_L(0); P8_MMA_A1(1, 0, At, B0); P8_MMA_B1(1, 1, At, B1); P8_BAR; }
    { P8_LDB(B0, 1, 0); P8_LDA(At, 1, 0); WAIT_V(2); P8_BAR; P8_WAIT_L(0); P8_MMA(0, 0, At, B0); P8_BAR;
      P8_LDB(B1, 1, 1); WAIT_V(0); P8_BAR; P8_WAIT_L(0); P8_MMA_B1(0, 1, At, B1); P8_BAR;
      P8_LDA(At, 1, 1); P8_BAR; P8_WAIT_L(0); P8_MMA_A1(1, 0, At, B0); P8_MMA_B1(1, 1, At, B1); P8_BAR; }
    if (wr == 0) P8_BAR;
    gemm_epilogue8<MODE>(p, l, acc, brow, bcol, wr, wc, fr, fq, cst, half);
  }
}

template <bool BIAS>
DI void wconv_tile(const float* src0, const float* src1, int N, int K, bf16_t* dst, int kind, int kt, int nt, char* smem, const float* shvec = nullptr, float* bias = nullptr, int npad = 0) {
  float* tile = (float*)smem;
  const int tid = ltid();
  __syncthreads();
  {
    const int nn = tid & 63, kk0 = tid >> 6;
    const int R = nt * 64 + nn;
    const float* src = src0;
    int col = R;
    bool ok = true;
    if (kind == 1) {
      const int grp = R >> 5, up = (R >> 4) & 1;
      col = grp * 16 + (R & 15);
      src = up ? src1 : src0;
    } else ok = R < N;
    float wv[16];
#pragma unroll
    for (int i = 0; i < 16; ++i) wv[i] = ok ? src[(size_t)(kt * 64 + kk0 + i * 4) * N + col] : 0.f;
#pragma unroll
    for (int i = 0; i < 16; ++i) tile[(kk0 + i * 4) * 65 + nn] = wv[i];
    if (BIAS) {
      float* svs = tile + 64 * 65;
      for (int o = tid; o < 9 * 64; o += 256) svs[o] = shvec[(size_t)(o >> 6) * 6144 + kt * 64 + (o & 63)];
    }
  }
  __syncthreads();
  {
    const int rr = tid >> 2, kc = (tid & 3) * 16;
    unsigned o[8];
#pragma unroll
    for (int e = 0; e < 8; ++e) o[e] = pk(tile[(kc + 2 * e) * 65 + rr], tile[(kc + 2 * e + 1) * 65 + rr]);
    bf16_t* d = dst + (size_t)(nt * 64 + rr) * K + kt * 64 + kc;
    *(uint4*)d = uint4{o[0], o[1], o[2], o[3]};
    *(uint4*)(d + 8) = uint4{o[4], o[5], o[6], o[7]};
  }
  if (BIAS) {
    for (int o = tid; o < 9 * 64; o += 256) {
      const int bq = o >> 6, nn = o & 63;
      const float* sv = tile + 64 * 65 + bq * 64;
      float a = 0.f;
#pragma unroll 8
      for (int kk = 0; kk < 64; ++kk) a += sv[kk] * tile[kk * 65 + nn];
      unsafeAtomicAdd(bias + (size_t)bq * npad + nt * 64 + nn, a);
    }
  }
}

DI void mod_item(const Params& p, int item, char* smem) {
  const int l = item / 96, cgp = item % 96;
  float* sc = (float*)smem;
  float* red = sc + 9 * 1024;
  const int tid = ltid();
  __syncthreads();
  for (int i = tid; i < 9 * 1024; i += 256) {
    const int r = i >> 10, k = i & 1023;
    const float v = r < 8 ? p.c[r * 1024 + k] : p.c_ctx[k];
    sc[i] = silu_f(v);
  }
  __syncthreads();
  const int kq = tid >> 6, cc = tid & 63, col = cgp * 64 + cc;
  float acc[9];
#pragma unroll
  for (int r = 0; r < 9; ++r) acc[r] = 0.f;
  const float* wp = p.w_ada + (size_t)l * 1024 * 6144 + col;
#pragma unroll 8
  for (int k = kq * 256; k < kq * 256 + 256; ++k) {
    const float wv = wp[(size_t)k * 6144];
#pragma unroll
    for (int r = 0; r < 9; ++r) acc[r] += sc[r * 1024 + k] * wv;
  }
#pragma unroll
  for (int r = 0; r < 9; ++r) red[(kq * 9 + r) * 64 + cc] = acc[r];
  __syncthreads();
  for (int i = tid; i < 9 * 64; i += 256) {
    const int r = i >> 6, c2 = i & 63;
    const float s = red[(0 * 9 + r) * 64 + c2] + red[(1 * 9 + r) * 64 + c2] + red[(2 * 9 + r) * 64 + c2] + red[(3 * 9 + r) * 64 + c2];
    ((float*)(p.ws + OFF_MOD))[((size_t)(l * 9 + r)) * 6144 + cgp * 64 + c2] = s + p.b_ada[l * 6144 + cgp * 64 + c2];
  }
}

DI void phase0(const Params& p, char* smem) {
  const int tid = ltid(), hf = ltid_full() >> 8;
  constexpr int N_MOD_IT = 384, N_ROPE = 512, N_CS = 32, N_ADC = 512, N_AD = 4160;
  constexpr int TOT = N_MOD_IT + N_ROPE + N_CS + N_ADC + N_AD;
  if (blockIdx.x == 0 && hf == 0 && tid < 64) ((int*)(p.ws + OFF_CTR))[tid] = 0;
  for (int i = blockIdx.x * 512 + ltid_full(); i < 4 * 9 * (2560 + 5632); i += gridDim.x * 512) ((float*)(p.ws + OFF_BIAS1))[i] = 0.f;
  for (int pi = blockIdx.x; pi < TOT / 2; pi += gridDim.x) {
    int i = pi * 2 + hf;
    if (i < N_MOD_IT) { mod_item(p, i, smem + hf * HALF_SMEM); continue; }
    i -= N_MOD_IT;
    if (i < N_ROPE) {
      const int e = i * 256 + tid;
      const int pos = e >> 5, f = e & 31;
      const float pv = (f < 16) ? (float)(pos >> 6) : (float)(pos & 63);
      const float invf = powf(10000.f, -(float)(f & 15) / 16.f);
      const float ang = pv * invf;
      float s, c;
      sincosf(ang, &s, &c);
      ((float*)(p.ws + OFF_ROPEC))[e] = c;
      ((float*)(p.ws + OFF_ROPES))[e] = s;
      continue;
    }
    i -= N_ROPE;
    if (i < N_CS) {
      const int e = i * 256 + tid;
      const int r = e >> 6, n2 = e & 63;
      const int idx = ((r & 63) * n2) & 63;
      float s, c;
      sincospif((float)idx / 32.f, &s, &c);
      ((bf16_t*)(p.ws + OFF_CS64))[e] = f2bf(r < 64 ? c : s);
      continue;
    }
    i -= N_CS;
    if (i < N_ADC) {
      const int e = i * 256 + tid;
      const int k1 = e >> 9, cc = e & 511, n1 = cc & 255;
      const int idx = (k1 * n1) & 255;
      float s, c;
      sincospif((float)idx / 128.f, &s, &c);
      ((bf16_t*)(p.ws + OFF_ADFTC))[e] = f2bf(cc < 256 ? c : -s);
      continue;
    }
    i -= N_ADC;
    if (i < N_AD) {
      const size_t e0 = (size_t)i * 4096 + (size_t)tid * 16;
      const int k1 = (int)(e0 / 4160), c0 = (int)(e0 % 4160);
      unsigned o[8];
#pragma unroll
      for (int e = 0; e < 8; ++e) {
        float v[2];
#pragma unroll
        for (int h = 0; h < 2; ++h) {
          const int cc = c0 + 2 * e + h;
          const int n1 = cc < 2112 ? cc : cc - 2112;
          const int idx = (k1 * n1) & 4095;
          float sn, cs;
          sincospif((float)idx / 2048.f, &sn, &cs);
          v[h] = cc < 2112 ? (cc <= 2048 ? cs : 0.f) : -sn;
        }
        o[e] = pk(v[0], v[1]);
      }
      bf16_t* dd = (bf16_t*)(p.ws + OFF_ADFT) + e0;
      *(uint4*)dd = uint4{o[0], o[1], o[2], o[3]};
      *(uint4*)(dd + 8) = uint4{o[4], o[5], o[6], o[7]};
      continue;
    }
  }
}

DI void norm_item(const Params& p, int item) {
  const int tid = ltid();
  const int w = tid >> 6, lane = tid & 63;
  const int t = item * 4 + w;
  const float* xr = xrow_in(p, t);
  const float* md = modrow(p, 0, t);
  const float* g = p.norm1_g;
  float4 v[4];
  float ss = 0.f;
#pragma unroll
  for (int j = 0; j < 4; ++j) {
    v[j] = *(const float4*)(xr + j * 256 + lane * 4);
    ss += v[j].x * v[j].x + v[j].y * v[j].y + v[j].z * v[j].z + v[j].w * v[j].w;
  }
#pragma unroll
  for (int off = 32; off >= 1; off >>= 1) ss += __shfl_xor(ss, off);
  if (lane == 0) ((float*)(p.ws + OFF_RSS1))[t] = ss;
  float* xo = xrow(p, t);
  bf16_t* hb = (bf16_t*)(p.ws + OFF_HB) + (size_t)t * 1024;
#pragma unroll
  for (int j = 0; j < 4; ++j) {
    const int c = j * 256 + lane * 4;
    *(float4*)(xo + c) = v[j];
    const float4 gg = *(const float4*)(g + c), sc = *(const float4*)(md + 1024 + c);
    *(uint2*)(hb + c) = uint2{pk(v[j].x * gg.x * (1.f + sc.x), v[j].y * gg.y * (1.f + sc.y)), pk(v[j].z * gg.z * (1.f + sc.z), v[j].w * gg.w * (1.f + sc.w))};
  }
}

DI void aprep_item(const Params& p, int l, int item, char* smem) {
  const int b = item / NCH, c = item % NCH;
  const int tok0 = b * TB + c * 64;
  const bool isctx = c < 4;
  int tid_ = ltid();
  const int tid = tid_, lane = tid & 63, w = tid >> 6;
  const bf16_t* P = (const bf16_t*)(p.ws + OFF_P);
  for (int it = 0; it < 12; ++it) {
    const int task = it * 64 + (tid >> 2);
    const int cq = tid & 3;
    const int type = task / 384, rem = task % 384, hr = rem >> 6, tk = rem & 63;
    const int t = tok0 + tk;
    const int pcol = (type ? 1296 : 784) + hr * 64;
    const bf16_t* src = P + (size_t)t * PW + pcol;
    const uint4 u1 = *(const uint4*)(src + cq * 8), u2 = *(const uint4*)(src + 32 + cq * 8);
    float a[8], bb[8];
    a[0] = bflo(u1.x); a[1] = bfhi(u1.x); a[2] = bflo(u1.y); a[3] = bfhi(u1.y); a[4] = bflo(u1.z); a[5] = bfhi(u1.z); a[6] = bflo(u1.w); a[7] = bfhi(u1.w);
    bb[0] = bflo(u2.x); bb[1] = bfhi(u2.x); bb[2] = bflo(u2.y); bb[3] = bfhi(u2.y); bb[4] = bflo(u2.z); bb[5] = bfhi(u2.z); bb[6] = bflo(u2.w); bb[7] = bfhi(u2.w);
    float ss = 0.f;
#pragma unroll
    for (int e = 0; e < 8; ++e) ss += a[e] * a[e] + bb[e] * bb[e];
    ss += __shfl_xor(ss, 1);
    ss += __shfl_xor(ss, 2);
    const float rs = rsqrtf(ss * (1.f / 64.f) + EPS);
    const float* gn = (type ? (hr < 4 ? p.wa_qn : p.wa_kn) : (hr < 4 ? p.ga_qn : p.ga_kn)) + l * 64;
    const float qs = hr < 4 ? 0.125f * LOG2E : 1.f;
    float o1[8], o2[8];
#pragma unroll
    for (int e = 0; e < 8; ++e) {
      a[e] = a[e] * rs * gn[cq * 8 + e];
      bb[e] = bb[e] * rs * gn[32 + cq * 8 + e];
    }
    if (!isctx) {
      const int pos = c * 64 + tk - LC;
      const float* rc = (const float*)(p.ws + OFF_ROPEC) + pos * 32 + cq * 8;
      const float* rsn = (const float*)(p.ws + OFF_ROPES) + pos * 32 + cq * 8;
#pragma unroll
      for (int e = 0; e < 8; ++e) {
        const float cs = rc[e], sn = rsn[e];
        o1[e] = (a[e] * cs - bb[e] * sn) * qs;
        o2[e] = (a[e] * sn + bb[e] * cs) * qs;
      }
    } else {
#pragma unroll
      for (int e = 0; e < 8; ++e) { o1[e] = a[e] * qs; o2[e] = bb[e] * qs; }
    }
    bf16_t* dst = hr < 4 ? (bf16_t*)(p.ws + OFF_QA) + ((size_t)type * T + t) * 256 + hr * 64
                         : (bf16_t*)(p.ws + OFF_KA) + ((size_t)type * T + t) * 128 + (hr - 4) * 64;
    *(uint4*)(dst + cq * 8) = uint4{pk(o1[0], o1[1]), pk(o1[2], o1[3]), pk(o1[4], o1[5]), pk(o1[6], o1[7])};
    *(uint4*)(dst + 32 + cq * 8) = uint4{pk(o2[0], o2[1]), pk(o2[2], o2[3]), pk(o2[4], o2[5]), pk(o2[6], o2[7])};
  }
  {
    bf16_t* sT = (bf16_t*)smem;
#pragma unroll 1
    for (int type = 0; type < 2; ++type) {
      const int vcol = (type ? 1296 : 784) + 384;
      __syncthreads();
#pragma unroll
      for (int i = 0; i < 4; ++i) {
        const int q = tid + i * 256, tk = q >> 4, ch = q & 15;
        *(uint4*)(sT + tk * 136 + ch * 8) = *(const uint4*)(P + (size_t)(tok0 + tk) * PW + vcol + ch * 8);
      }
      __syncthreads();
      const int kd = tid & 127, th = tid >> 7;
      bf16_t* dst = (bf16_t*)(p.ws + OFF_VT) + (((size_t)(type * NB + b) * 128 + kd)) * TB + c * 64 + th * 32;
#pragma unroll
      for (int j0 = 0; j0 < 32; j0 += 8) {
        unsigned o[4];
#pragma unroll
        for (int e = 0; e < 4; ++e) {
          const unsigned lo = sT[(th * 32 + j0 + 2 * e) * 136 + kd], hi = sT[(th * 32 + j0 + 2 * e + 1) * 136 + kd];
          o[e] = lo | (hi << 16);
        }
        *(uint4*)(dst + j0) = uint4{o[0], o[1], o[2], o[3]};
      }
    }
  }
  {
    const int g = w, lr = lane & 15, lq = lane >> 4;
    const bf16_t* CS = (const bf16_t*)(p.ws + OFF_CS64);
    const int cl = c - 4;
    if (isctx || cl <= 32) {
#pragma unroll 1
      for (int nh = 0; nh < 2; ++nh) {
      bf16x8 bs[2][2], bd[2][2];
#pragma unroll
      for (int ntl = 0; ntl < 2; ++ntl) {
        const int nt = nh * 2 + ntl;
        const int n1 = cl * 64 + nt * 16 + lr;
        const bool mir = !isctx && n1 >= 1 && n1 <= 2047;
        const bool zero = !isctx && n1 > 2048;
#pragma unroll
        for (int ks = 0; ks < 2; ++ks) {
          const int coff = 1808 + g * 64 + ks * 32 + lq * 8;
          uint4 a = *(const uint4*)(P + (size_t)(tok0 + nt * 16 + lr) * PW + coff);
          uint4 m = {0u, 0u, 0u, 0u};
          if (mir) m = *(const uint4*)(P + (size_t)(b * TB + LC + 4096 - n1) * PW + coff);
          if (zero) a = uint4{0u, 0u, 0u, 0u};
          const unsigned ua[4] = {a.x, a.y, a.z, a.w}, um[4] = {m.x, m.y, m.z, m.w};
          unsigned os[4], od[4];
#pragma unroll
          for (int e = 0; e < 4; ++e) {
            const float a0 = bflo(ua[e]), a1 = bfhi(ua[e]), m0 = bflo(um[e]), m1 = bfhi(um[e]);
            os[e] = pk(a0 + m0, a1 + m1);
            od[e] = pk(a0 - m0, a1 - m1);
          }
          bs[ntl][ks] = __builtin_bit_cast(bf16x8, uint4{os[0], os[1], os[2], os[3]});
          bd[ntl][ks] = __builtin_bit_cast(bf16x8, uint4{od[0], od[1], od[2], od[3]});
        }
      }
#pragma unroll 1
      for (int mt = 0; mt < 8; ++mt) {
        bf16x8 af[2];
#pragma unroll
        for (int ks = 0; ks < 2; ++ks) af[ks] = *(const bf16x8*)(CS + (mt * 16 + lr) * 64 + ks * 32 + lq * 8);
#pragma unroll
        for (int ntl = 0; ntl < 2; ++ntl) {
          const int nt = nh * 2 + ntl;
          f32x4 acc = {0.f, 0.f, 0.f, 0.f};
          const bool sinpart = mt >= 4;
          acc = MFMA16(af[0], (sinpart && !isctx) ? bd[ntl][0] : bs[ntl][0], acc);
          acc = MFMA16(af[1], (sinpart && !isctx) ? bd[ntl][1] : bs[ntl][1], acc);
#pragma unroll
          for (int r = 0; r < 4; ++r) {
            const int k2row = mt * 16 + lq * 4 + r, k2 = k2row & 63, part = k2row >> 6;
            const int tk = c * 64 + nt * 16 + lr;
            if (isctx) ((bf16_t*)(p.ws + OFF_BTFTC))[((size_t)(b * 256 + g * 64 + k2)) * 512 + part * 256 + tk] = f2bf(acc[r]);
            else {
              const int n1 = tk - LC;
              if (part == 0 || n1 < 2048) ((bf16_t*)(p.ws + OFF_BTFT))[((size_t)(b * 256 + g * 64 + k2)) * 4160 + part * 2112 + n1] = f2bf(acc[r]);
            }
          }
        }
      }
      }
    }
  }
}

DI int dn_step(int c, int d) { return c < 4 ? (d ? 3 - c : c) : 4 + (d ? 67 - c : c - 4); }

DI void dnprep_item(const Params& p, int l, int item, char* smem, char* dsm0) {
  const int b = item / (4 * NCH), h = (item / NCH) & 3, c = item % NCH;
  bf16_t* qb = (bf16_t*)smem;
  bf16_t* kb = qb + 64 * 72;
  float* kf = (float*)(smem + 18432);
  float* vf = kf + 4096;
  float* Am = kf;
  int tid_ = ltid();
  const int tid = tid_, lane = tid & 63, w = tid >> 6, lr = lane & 15, lq = lane >> 4;
  const int tok0 = b * TB + c * 64;
  const bool isctx = c < 4;
  const int sbeg = isctx ? b * TB : b * TB + LC, send = isctx ? b * TB + LC : (b + 1) * TB;
  const bf16_t* P = (const bf16_t*)(p.ws + OFF_P);
  const int tau = tid >> 2, cq = tid & 3;
  const int t = tok0 + tau;
  float qv[16], kv[16], vv[16];
  __syncthreads();
#pragma unroll
  for (int part = 0; part < 3; ++part) {
    const int col = part * 256 + h * 64 + cq * 16;
    const float* cw = p.conv_w + (size_t)l * 3 * 768 + col;
    const bool hasp = t - 1 >= sbeg, hasn = t + 1 < send;
    const u32x4 z4 = {0u, 0u, 0u, 0u};
    const u32x4 a1l = *(const u32x4*)(P + (size_t)t * PW + col), a1h = *(const u32x4*)(P + (size_t)t * PW + col + 8);
    u32x4 a0l = z4, a0h = z4, a2l = z4, a2h = z4;
    if (hasp) { a0l = *(const u32x4*)(P + (size_t)(t - 1) * PW + col); a0h = *(const u32x4*)(P + (size_t)(t - 1) * PW + col + 8); }
    if (hasn) { a2l = *(const u32x4*)(P + (size_t)(t + 1) * PW + col); a2h = *(const u32x4*)(P + (size_t)(t + 1) * PW + col + 8); }
#pragma unroll
    for (int e = 0; e < 16; ++e) {
      const unsigned w0 = e < 8 ? a0l[(e & 7) >> 1] : a0h[(e & 7) >> 1];
      const unsigned w1 = e < 8 ? a1l[(e & 7) >> 1] : a1h[(e & 7) >> 1];
      const unsigned w2 = e < 8 ? a2l[(e & 7) >> 1] : a2h[(e & 7) >> 1];
      const float x0 = (e & 1) ? bfhi(w0) : bflo(w0);
      const float x1 = (e & 1) ? bfhi(w1) : bflo(w1);
      const float x2 = (e & 1) ? bfhi(w2) : bflo(w2);
      const float y = x0 * cw[e] + x1 * cw[768 + e] + x2 * cw[1536 + e];
      const float sv = silu_f(y);
      if (part == 0) qv[e] = sv; else if (part == 1) kv[e] = sv; else vv[e] = sv;
    }
    asm volatile("" ::: "memory");
  }
  {
    float sq = 0.f, sk = 0.f;
#pragma unroll
    for (int e = 0; e < 16; ++e) { sq += qv[e] * qv[e]; sk += kv[e] * kv[e]; }
    sq += __shfl_xor(sq, 1); sq += __shfl_xor(sq, 2);
    sk += __shfl_xor(sk, 1); sk += __shfl_xor(sk, 2);
    const float rq = rsqrtf(sq + EPS) * 0.125f, rk = rsqrtf(sk + EPS);
#pragma unroll
    for (int e = 0; e < 16; ++e) { qv[e] *= rq; kv[e] *= rk; }
  }
  float* gl = (float*)(dsm0 + (ltid_full() >> 8) * HALF_SMEM + 18432 + 32768);
  float* bl = gl + 128;
  float* gc = bl + 128;
  float* bd = gc + 128;
  if (tid < 128) {
    const int d = tid >> 6, i = tid & 63, ta = d ? 63 - i : i;
    const bf16_t* pr = P + (size_t)(tok0 + ta) * PW + 768;
    const float a = bf2f(pr[d * 4 + h]), bb = bf2f(pr[8 + d * 4 + h]);
    const float xx = a + p.dt_bias[l * 8 + d * 4 + h];
    const float ex = __expf(xx);
    const float sp = xx > 20.f ? xx : (ex < 0.03f ? ex * (1.f - ex * (0.5f - ex * (1.f / 3.f - 0.25f * ex))) : __logf(1.f + ex));
    float v = -__expf(p.A_log[l * 8 + d * 4 + h]) * sp;
#pragma unroll
    for (int off = 1; off < 64; off <<= 1) {
      const float tq = __shfl_up(v, off);
      if (i >= off) v += tq;
    }
    gc[d * 64 + i] = v;
    bd[d * 64 + i] = 1.f / (1.f + __expf(-bb));
  }
  {
#pragma unroll
    for (int e = 0; e < 16; e += 4) {
      *(uint2*)(qb + tau * 72 + cq * 16 + e) = uint2{pk(qv[e], qv[e + 1]), pk(qv[e + 2], qv[e + 3])};
      *(uint2*)(kb + tau * 72 + cq * 16 + e) = uint2{pk(kv[e], kv[e + 1]), pk(kv[e + 2], kv[e + 3])};
      *(float4*)(kf + tau * 64 + cq * 16 + e) = float4{kv[e], kv[e + 1], kv[e + 2], kv[e + 3]};
      *(float4*)(vf + tau * 64 + cq * 16 + e) = float4{vv[e], vv[e + 1], vv[e + 2], vv[e + 3]};
    }
  }
  __syncthreads();
#pragma unroll
  for (int d = 0; d < 2; ++d) {
    const int i = d ? 63 - tau : tau;
    const int cb = ((b * 4 + h) * 2 + d) * NCH + dn_step(c, d);
    bf16_t* base = (bf16_t*)(p.ws + OFF_DN + (size_t)cb * SZ_CB);
    const float eg = __expf(gc[d * 64 + i]);
    bf16_t* qd = base + 4096 + i * 64;
#pragma unroll
    for (int q4 = 0; q4 < 4; ++q4) {
      const int pos = (cq >> 1) * 32 + q4 * 8 + (cq & 1) * 4;
      *(uint2*)(qd + pos) = uint2{pk(qv[q4 * 4] * eg, qv[q4 * 4 + 1] * eg), pk(qv[q4 * 4 + 2] * eg, qv[q4 * 4 + 3] * eg)};
    }
  }
#pragma unroll
  for (int d = 0; d < 2; ++d) {
    const int cb = ((b * 4 + h) * 2 + d) * NCH + dn_step(c, d);
    bf16_t* kt = (bf16_t*)(p.ws + OFF_DN + (size_t)cb * SZ_CB) + 3 * 4096 + tau * 64 + cq * 16;
    const float gl63 = gc[d * 64 + 63];
    unsigned o[8];
#pragma unroll
    for (int e2 = 0; e2 < 8; ++e2) {
      float vals[2];
#pragma unroll
      for (int hq = 0; hq < 2; ++hq) {
        const int e = e2 * 2 + hq;
        const int i = (2 * (cq >> 1) + ((e >> 2) & 1)) * 16 + ((((cq & 1) << 1) | (e >> 3)) << 2) + (e & 3);
        const int ta = d ? 63 - i : i;
        vals[hq] = kf[ta * 64 + tau] * __expf(gl63 - gc[d * 64 + i]);
      }
      o[e2] = pk(vals[0], vals[1]);
    }
    *(uint4*)kt = uint4{o[0], o[1], o[2], o[3]};
    *(uint4*)(kt + 8) = uint4{o[4], o[5], o[6], o[7]};
  }
  if (tid < 128) {
    const int d = tid >> 6;
    const int cb = ((b * 4 + h) * 2 + d) * NCH + dn_step(c, d);
    ((float*)(p.ws + OFF_GEND))[(size_t)cb * 64 + (tid & 63)] = __expf(gc[d * 64 + 63]);
  }
  f32x4 KK[4], QK[4];
  {
    bf16x8 ak[2], aq[2];
#pragma unroll
    for (int ks = 0; ks < 2; ++ks) {
      ak[ks] = *(const bf16x8*)(kb + (w * 16 + lr) * 72 + ks * 32 + lq * 8);
      aq[ks] = *(const bf16x8*)(qb + (w * 16 + lr) * 72 + ks * 32 + lq * 8);
    }
#pragma unroll
    for (int nt = 0; nt < 4; ++nt) {
      KK[nt] = f32x4{0.f, 0.f, 0.f, 0.f};
      QK[nt] = f32x4{0.f, 0.f, 0.f, 0.f};
#pragma unroll
      for (int ks = 0; ks < 2; ++ks) {
        const bf16x8 bk = *(const bf16x8*)(kb + (nt * 16 + lr) * 72 + ks * 32 + lq * 8);
        KK[nt] = MFMA16(ak[ks], bk, KK[nt]);
        QK[nt] = MFMA16(aq[ks], bk, QK[nt]);
      }
    }
  }
  const int sd = w >> 1, half = w & 1;
  float xs[64];
#pragma unroll
  for (int i = 0; i < 64; ++i) {
    const int ta = sd ? 63 - i : i;
    const float bt = bd[sd * 64 + i];
    xs[i] = half ? kf[ta * 64 + lane] * bt * __expf(gc[sd * 64 + i]) : vf[ta * 64 + lane] * bt;
    if ((i & 7) == 7) asm volatile("" ::: "memory");
  }
  __syncthreads();
#pragma unroll
  for (int d = 0; d < 2; ++d) {
    const int cb = ((b * 4 + h) * 2 + d) * NCH + dn_step(c, d);
    bf16_t* inb = (bf16_t*)(p.ws + OFF_DN + (size_t)cb * SZ_CB) + 2 * 4096;
#pragma unroll
    for (int nt = 0; nt < 4; ++nt)
#pragma unroll
      for (int r = 0; r < 4; ++r) {
        const int ti = w * 16 + lq * 4 + r, tj = nt * 16 + lr;
        const int i = d ? 63 - ti : ti, j = d ? 63 - tj : tj;
        const float dec = (i >= j) ? __expf(gc[d * 64 + i] - gc[d * 64 + j]) : 0.f;
        Am[d * 4096 + i * 64 + j] = (i > j) ? bd[d * 64 + i] * KK[nt][r] * dec : 0.f;
        inb[i * 64 + permk(j)] = f2bf(QK[nt][r] * dec);
        if (r == 3) asm volatile("" ::: "memory");
      }
  }
  __syncthreads();
  {
    const float* Ad = Am + sd * 4096;
    f32x4 an[16];
    an[0] = *(const f32x4*)(Ad + 1 * 64);
#pragma unroll
    for (int i = 1; i < 64; ++i) {
      f32x4 ac[16];
#pragma unroll
      for (int j4 = 0; j4 <= (i - 1) / 4; ++j4) ac[j4] = an[j4];
      if (i + 1 < 64) {
#pragma unroll
        for (int j4 = 0; j4 <= i / 4; ++j4) an[j4] = *(const f32x4*)(Ad + (i + 1) * 64 + j4 * 4);
      }
      float sacc = xs[i];
#pragma unroll
      for (int j4 = 0; j4 <= (i - 1) / 4; ++j4) {
        sacc -= ac[j4][0] * xs[j4 * 4];
        sacc -= ac[j4][1] * xs[j4 * 4 + 1];
        sacc -= ac[j4][2] * xs[j4 * 4 + 2];
        sacc -= ac[j4][3] * xs[j4 * 4 + 3];
      }
      xs[i] = sacc;
      asm volatile("" ::: "memory");
    }
    const int cb = ((b * 4 + h) * 2 + sd) * NCH + dn_step(c, sd);
    bf16_t* base = (bf16_t*)(p.ws + OFF_DN + (size_t)cb * SZ_CB);
    if (half == 0) {
      bf16_t* U = base + 4 * 4096;
#pragma unroll
      for (int i4 = 0; i4 < 16; ++i4) {
        const int mt = i4 >> 2, q4 = i4 & 3;
        *(uint2*)(U + ((((mt * 4 + (lane >> 4)) * 4 + q4) * 16 + (lane & 15)) << 2)) = uint2{pk(xs[i4 * 4], xs[i4 * 4 + 1]), pk(xs[i4 * 4 + 2], xs[i4 * 4 + 3])};
      }
    } else {
      bf16_t* Wn = base;
      const int pc = permk(lane);
#pragma unroll
      for (int i = 0; i < 64; ++i) Wn[i * 64 + pc] = f2bf(-xs[i]);
    }
  }
}

DI bf16x8 pack8(const f32x4& a, const f32x4& b) {
  uint4 u = {pk(a[0], a[1]), pk(a[2], a[3]), pk(b[0], b[1]), pk(b[2], b[3])};
  return __builtin_bit_cast(bf16x8, u);
}

DI void dnscan_item(const Params& p, int item, LAS char* lb) {
  const int b = item >> 3, h = (item >> 1) & 3, d = item & 1;
  int tid_ = ltid();
  const int lane = tid_ & 63, w = tid_ >> 6, lr = lane & 15, lq = lane >> 4;
  f32x4 S[4];
#pragma unroll
  for (int mt = 0; mt < 4; ++mt) S[mt] = f32x4{0.f, 0.f, 0.f, 0.f};
  const int cb0 = ((b * 4 + h) * 2 + d) * NCH;
  unsigned pfacc = 0u;
  int soff[8];
#pragma unroll
  for (int i = 0; i < 8; ++i) {
    const int j = w * 512 + i * 64 + lane, jj = j & 511, row = jj >> 3, ch = jj & 7;
    soff[i] = (j >> 9) * 4096 + row * 64 + ((ch ^ (row & 7)) << 3);
  }
#define SC_STAGE(buf, step)                                                                                                                   \
  do {                                                                                                                                        \
    const bf16_t* gb_ = (const bf16_t*)(p.ws + OFF_DN + (size_t)(cb0 + (step)) * SZ_CB);                                                       \
    _Pragma("unroll") for (int i = 0; i < 8; ++i)                                                                                             \
      __builtin_amdgcn_global_load_lds((const unsigned*)(gb_ + soff[i]), (LAS unsigned*)(lb + (buf) * 32768 + (w * 512 + i * 64) * 16), 16, 0, 0); \
  } while (0)
  int foff[4][2];
#pragma unroll
  for (int mt = 0; mt < 4; ++mt)
#pragma unroll
    for (int ks = 0; ks < 2; ++ks) { const int row = mt * 16 + lr; foff[mt][ks] = row * 128 + (((ks * 4 + lq) ^ (row & 7)) << 4); }
  SC_STAGE(0, 0);
  uint2 uu[4];
  float ge;
  {
    const bf16_t* base = (const bf16_t*)(p.ws + OFF_DN + (size_t)cb0 * SZ_CB);
#pragma unroll
    for (int mt = 0; mt < 4; ++mt) uu[mt] = *(const uint2*)(base + 4 * 4096 + ((((mt * 4 + w) * 4 + lq) * 16 + lr) << 2));
    ge = ((const float*)(p.ws + OFF_GEND))[(size_t)cb0 * 64 + lane];
  }
  WAIT_V(0);
#pragma unroll 1
  for (int s = 0; s < NCH; ++s) {
    WAIT_V(8);
    __syncthreads();
    if (s + 1 < NCH) SC_STAGE((s + 1) & 1, s + 1);
    uint2 un[4] = {uu[0], uu[1], uu[2], uu[3]};
    float gn = ge;
    if (s + 1 < NCH) {
      const bf16_t* nb = (const bf16_t*)(p.ws + OFF_DN + (size_t)(cb0 + s + 1) * SZ_CB);
#pragma unroll
      for (int mt = 0; mt < 4; ++mt) un[mt] = *(const uint2*)(nb + 4 * 4096 + ((((mt * 4 + w) * 4 + lq) * 16 + lr) << 2));
      gn = ((const float*)(p.ws + OFF_GEND))[(size_t)(cb0 + s + 1) * 64 + lane];
    }
    unsigned pf0 = 0u, pf1 = 0u;
    if (s + 2 < NCH) {
      const unsigned* nb = (const unsigned*)(p.ws + OFF_DN + (size_t)(cb0 + s + 2) * SZ_CB);
      pf0 = nb[(w * 80 + lane) * 32];
      if (lane < 16) pf1 = nb[(w * 80 + 64 + lane) * 32];
    }
    const LAS char* sb = lb + (s & 1) * 32768;
    bf16x8 sB[2];
    sB[0] = pack8(S[0], S[1]);
    sB[1] = pack8(S[2], S[3]);
    f32x4 vn[4], o[4];
#pragma unroll
    for (int mt = 0; mt < 4; ++mt) {
      vn[mt] = f32x4{bflo(uu[mt].x), bfhi(uu[mt].x), bflo(uu[mt].y), bfhi(uu[mt].y)};
      o[mt] = f32x4{0.f, 0.f, 0.f, 0.f};
#pragma unroll
      for (int ks = 0; ks < 2; ++ks) {
        const bf16x8 aw = *(const LAS bf16x8*)(sb + foff[mt][ks]);
        const bf16x8 aq = *(const LAS bf16x8*)(sb + 8192 + foff[mt][ks]);
        vn[mt] = MFMA16(aw, sB[ks], vn[mt]);
        o[mt] = MFMA16(aq, sB[ks], o[mt]);
      }
    }
    bf16x8 vB[2];
    vB[0] = pack8(vn[0], vn[1]);
    vB[1] = pack8(vn[2], vn[3]);
#pragma unroll
    for (int mt = 0; mt < 4; ++mt) {
#pragma unroll
      for (int r = 0; r < 4; ++r) S[mt][r] *= ge;
#pragma unroll
      for (int ks = 0; ks < 2; ++ks) {
        const bf16x8 ai = *(const LAS bf16x8*)(sb + 16384 + foff[mt][ks]);
        const bf16x8 ak = *(const LAS bf16x8*)(sb + 24576 + foff[mt][ks]);
        o[mt] = MFMA16(ai, vB[ks], o[mt]);
        S[mt] = MFMA16(ak, vB[ks], S[mt]);
      }
    }
    pfacc ^= pf0 ^ pf1;
#pragma unroll
    for (int mt = 0; mt < 4; ++mt) uu[mt] = un[mt];
    ge = gn;
    int dl = d;
    asm volatile("" : "+v"(dl));
    float* Od = (float*)(p.ws + OFF_ODN) + (size_t)dl * T * 256;
    const int c = s < 4 ? (d ? 3 - s : s) : 4 + (d ? 67 - s : s - 4);
#pragma unroll
    for (int mt = 0; mt < 4; ++mt)
#pragma unroll
      for (int r = 0; r < 4; ++r) {
        const int i = mt * 16 + lq * 4 + r;
        const int ta = d ? 63 - i : i;
        Od[((size_t)(b * TB + c * 64 + ta)) * 256 + h * 64 + w * 16 + lr] = o[mt][r];
      }
  }
#undef SC_STAGE
  __syncthreads();
  if (pfacc == 0x9e3779b9u && ((const float*)(p.ws + OFF_GEND))[0] == 123.456f) ((float*)(p.ws + OFF_ODN))[0] = 0.f;
}

DI void attn_item(const Params& p, int l, int type, int b, int kvh, int qb, char* smem) {
  constexpr int KB = 64 * 64 * 2, VB = 64 * 72 * 2, SB = KB + VB;
  int tid_ = ltid();
  const int tid = tid_, lane = tid & 63, w = tid >> 6, lr = lane & 15, lq = lane >> 4;
  const int g = w >> 1, qh = kvh * 2 + g;
  const int qloc0 = qb * 64 + (w & 1) * 32;
  const bool isctx = qb < 4;
  const bf16_t* Qa = (const bf16_t*)(p.ws + OFF_QA) + ((size_t)type * T + (size_t)b * TB) * 256 + qh * 64;
  const bf16_t* Kg = (const bf16_t*)(p.ws + OFF_KA) + ((size_t)type * T + (size_t)b * TB) * 128 + kvh * 64;
  const bf16_t* Vg = (const bf16_t*)(p.ws + OFF_VT) + ((size_t)(type * NB + b) * 128 + kvh * 64) * TB;
  bf16x8 qf[2][2];
#pragma unroll
  for (int nt = 0; nt < 2; ++nt)
#pragma unroll
    for (int ks = 0; ks < 2; ++ks) qf[nt][ks] = *(const bf16x8*)(Qa + (size_t)(qloc0 + nt * 16 + lr) * 256 + ks * 32 + lq * 8);
  float neg_big;
  asm volatile("v_mov_b32 %0, 0xf149f2ca" : "=v"(neg_big));
  float mrun[2];
  f32x4 O[4][2], Ls[2];
  const bf16x8 ones8 = {(short)0x3F80, (short)0x3F80, (short)0x3F80, (short)0x3F80, (short)0x3F80, (short)0x3F80, (short)0x3F80, (short)0x3F80};
#pragma unroll
  for (int nt = 0; nt < 2; ++nt) {
    if (type == 1) { mrun[nt] = p.wa_sink[l * 4 + qh] * LOG2E; Ls[nt] = f32x4{1.f, 1.f, 1.f, 1.f}; }
    else { mrun[nt] = neg_big; Ls[nt] = f32x4{0.f, 0.f, 0.f, 0.f}; }
#pragma unroll
    for (int mt = 0; mt < 4; ++mt) O[mt][nt] = f32x4{0.f, 0.f, 0.f, 0.f};
  }
  const int n_lat_lo = (!isctx && type == 1) ? qb - 2 : 4;
  const int ntiles = isctx ? 4 : (type == 0 ? NCH : 9);
  const int lrow = tid >> 3, lch = tid & 7;
  u32x4 rk[2], rv[2];
#pragma unroll
  for (int i = 0; i < 2; ++i) {
    rk[i] = *(const u32x4*)(Kg + (size_t)(lrow + i * 32) * 128 + lch * 8);
    rv[i] = *(const u32x4*)(Vg + (size_t)(lrow + i * 32) * TB + lch * 8);
  }
#pragma unroll
  for (int i = 0; i < 2; ++i) {
    const int r = lrow + i * 32;
    *(u32x4*)(smem + r * 128 + ((lch ^ (r & 7)) << 4)) = rk[i];
    *(u32x4*)(smem + KB + r * 144 + lch * 16) = rv[i];
  }
  __syncthreads();
  for (int ti = 0; ti < ntiles; ++ti) {
    const int jraw = ti < 4 ? ti : n_lat_lo + (ti - 4);
    const bool tvalid = ti < 4 || (jraw >= 4 && jraw < NCH);
    const int jt = ti < 4 ? ti : (jraw < 4 ? 4 : (jraw > NCH - 1 ? NCH - 1 : jraw));
    const char* sK = smem + (ti & 1) * SB;
    const char* sV = sK + KB;
    if (ti + 1 < ntiles) {
      const int jn0 = (ti + 1) < 4 ? ti + 1 : n_lat_lo + (ti + 1 - 4);
      const int jn = (ti + 1) < 4 ? jn0 : (jn0 < 4 ? 4 : (jn0 > NCH - 1 ? NCH - 1 : jn0));
#pragma unroll
      for (int i = 0; i < 2; ++i) {
        rk[i] = *(const u32x4*)(Kg + (size_t)(jn * 64 + lrow + i * 32) * 128 + lch * 8);
        rv[i] = *(const u32x4*)(Vg + (size_t)(lrow + i * 32) * TB + jn * 64 + lch * 8);
      }
    }
    f32x4 sc[4][2];
    __builtin_amdgcn_s_setprio(1);
#pragma unroll
    for (int mt = 0; mt < 4; ++mt) {
      const int r = mt * 16 + lr;
      const bf16x8 kf0 = *(const bf16x8*)(sK + r * 128 + ((lq ^ (r & 7)) << 4));
      const bf16x8 kf1 = *(const bf16x8*)(sK + r * 128 + (((4 + lq) ^ (r & 7)) << 4));
#pragma unroll
      for (int nt = 0; nt < 2; ++nt) {
        f32x4 a = {0.f, 0.f, 0.f, 0.f};
        a = MFMA16(kf0, qf[nt][0], a);
        a = MFMA16(kf1, qf[nt][1], a);
        sc[mt][nt] = a;
      }
    }
    __builtin_amdgcn_s_setprio(0);
    const bool domask = (type == 1) && !isctx && (jt >= 4);
#pragma unroll
    for (int nt = 0; nt < 2; ++nt) {
      if (domask) {
#pragma unroll
        for (int mt = 0; mt < 4; ++mt)
#pragma unroll
          for (int r = 0; r < 4; ++r) {
            const int kpos = jt * 64 + mt * 16 + lq * 4 + r, qpos = qloc0 + nt * 16 + lr;
            const int df = qpos - kpos;
            if (df > 128 || df < -128 || !tvalid) sc[mt][nt][r] = neg_big;
          }
      }
      float mx = fmaxf(fmaxf(sc[0][nt][0], sc[0][nt][1]), fmaxf(sc[0][nt][2], sc[0][nt][3]));
#pragma unroll
      for (int mt = 1; mt < 4; ++mt) mx = fmaxf(mx, fmaxf(fmaxf(sc[mt][nt][0], sc[mt][nt][1]), fmaxf(sc[mt][nt][2], sc[mt][nt][3])));
      mx = fmaxf(mx, __shfl_xor(mx, 16));
      mx = fmaxf(mx, __shfl_xor(mx, 32));
      if (__builtin_amdgcn_ballot_w64(mx > mrun[nt] + 8.f) != 0ull) {
        const float mnew = fmaxf(mrun[nt], mx);
        const float alpha = __builtin_amdgcn_exp2f(mrun[nt] - mnew);
        mrun[nt] = mnew;
#pragma unroll
        for (int r = 0; r < 4; ++r) Ls[nt][r] *= alpha;
#pragma unroll
        for (int mt = 0; mt < 4; ++mt)
#pragma unroll
          for (int r = 0; r < 4; ++r) O[mt][nt][r] *= alpha;
      }
      const float mref = mrun[nt];
#pragma unroll
      for (int mt = 0; mt < 4; ++mt)
#pragma unroll
        for (int r = 0; r < 4; ++r) sc[mt][nt][r] = __builtin_amdgcn_exp2f(sc[mt][nt][r] - mref);
    }
    bf16x8 pB[2][2];
#pragma unroll
    for (int nt = 0; nt < 2; ++nt) {
      pB[nt][0] = pack8(sc[0][nt], sc[1][nt]);
      pB[nt][1] = pack8(sc[2][nt], sc[3][nt]);
      Ls[nt] = MFMA16(ones8, pB[nt][0], Ls[nt]);
      Ls[nt] = MFMA16(ones8, pB[nt][1], Ls[nt]);
    }
    __builtin_amdgcn_s_setprio(1);
#pragma unroll
    for (int mt = 0; mt < 4; ++mt)
#pragma unroll
      for (int ks = 0; ks < 2; ++ks) {
        const bf16x4 v0 = *(const bf16x4*)(sV + (mt * 16 + lr) * 144 + ((2 * ks) * 16 + lq * 4) * 2);
        const bf16x4 v1 = *(const bf16x4*)(sV + (mt * 16 + lr) * 144 + ((2 * ks + 1) * 16 + lq * 4) * 2);
        const bf16x8 vfr = __builtin_shufflevector(v0, v1, 0, 1, 2, 3, 4, 5, 6, 7);
#pragma unroll
        for (int nt = 0; nt < 2; ++nt) O[mt][nt] = MFMA16(vfr, pB[nt][ks], O[mt][nt]);
      }
    __builtin_amdgcn_s_setprio(0);
    if (ti + 1 < ntiles) {
      char* dK = smem + ((ti + 1) & 1) * SB;
#pragma unroll
      for (int i = 0; i < 2; ++i) {
        const int r = lrow + i * 32;
        *(u32x4*)(dK + r * 128 + ((lch ^ (r & 7)) << 4)) = rk[i];
        *(u32x4*)(dK + KB + r * 144 + lch * 16) = rv[i];
      }
    }
    __syncthreads();
  }
  bf16_t* Y = (bf16_t*)(p.ws + OFF_YMIX);
#pragma unroll
  for (int nt = 0; nt < 2; ++nt) {
    const float inv = 1.f / Ls[nt][0];
    const size_t row = (size_t)b * TB + qloc0 + nt * 16 + lr;
#pragma unroll
    for (int mt = 0; mt < 4; ++mt) {
      uint2 v = {pk(O[mt][nt][0] * inv, O[mt][nt][1] * inv), pk(O[mt][nt][2] * inv, O[mt][nt][3] * inv)};
      *(uint2*)(Y + row * 1024 + (type ? 512 : 256) + qh * 64 + mt * 16 + lq * 4) = v;
    }
  }
}

DI void dnmerge_item(const Params& p, int l, int item) {
  const int tid = ltid();
  const int w = tid >> 6, lane = tid & 63;
  const int t = item * 4 + w;
  const float* o0 = (const float*)(p.ws + OFF_ODN) + (size_t)t * 256 + lane * 4;
  const float* o1 = o0 + (size_t)T * 256;
  const float4 a = *(const float4*)o0, bq = *(const float4*)o1;
  float v[4] = {a.x + bq.x, a.y + bq.y, a.z + bq.z, a.w + bq.w};
  float ss = v[0] * v[0] + v[1] * v[1] + v[2] * v[2] + v[3] * v[3];
  ss += __shfl_xor(ss, 1); ss += __shfl_xor(ss, 2); ss += __shfl_xor(ss, 4); ss += __shfl_xor(ss, 8);
  const float rs = rsqrtf(ss * (1.f / 64.f) + EPS);
  const int dim = (lane & 15) * 4;
  const float4 gn = *(const float4*)(p.dn_norm_g + l * 64 + dim);
  const uint2 zz = *(const uint2*)((const bf16_t*)(p.ws + OFF_Z) + (size_t)t * 256 + lane * 4);
  const float z0 = bflo(zz.x), z1 = bfhi(zz.x), z2 = bflo(zz.y), z3 = bfhi(zz.y);
  const float y0 = v[0] * rs * gn.x * silu_f(z0), y1 = v[1] * rs * gn.y * silu_f(z1), y2 = v[2] * rs * gn.z * silu_f(z2), y3 = v[3] * rs * gn.w * silu_f(z3);
  *(uint2*)((bf16_t*)(p.ws + OFF_YMIX) + (size_t)t * 1024 + lane * 4) = uint2{pk(y0, y1), pk(y2, y3)};
  if (lane == 0) { ((float*)(p.ws + OFF_RSS1))[t] = 0.f; ((float*)(p.ws + OFF_RSS2))[t] = 0.f; }
}


#define XB_TMO      128
#define XB_XCNT(j)  (256  + 64 * (j))
#define XB_XSUB(j)  (1280 + 64 * (j))
#define XB_XGEN(j)  (2304 + 64 * (j))
#define XB_TOP      3328
#define XB_TOPGEN   3392
#define XCD_BAR_WORDS 3456
#define XB_SPIN_CAP (1u << 18)
DI unsigned xb_ld(unsigned* p) { return __hip_atomic_load(p, __ATOMIC_RELAXED, __HIP_MEMORY_SCOPE_AGENT); }
DI unsigned xb_add(unsigned* p, unsigned v) { return __hip_atomic_fetch_add(p, v, __ATOMIC_RELAXED, __HIP_MEMORY_SCOPE_AGENT); }
DI unsigned xb_xcc_id() { return (unsigned)__builtin_amdgcn_s_getreg((3 << 11) | 20) & 0xFu; }
#define XB_SPIN(cond, bar) do { unsigned _sp = 0; while (cond) { __builtin_amdgcn_s_sleep(1); \
    if ((++_sp & 255u) == 0u) { if (xb_ld(&(bar)[XB_TMO])) break; if (_sp > XB_SPIN_CAP) { atomicAdd(&(bar)[XB_TMO], 1u); break; } } } } while (0)
struct XcdBarrier { unsigned* bar; unsigned x; volatile LAS unsigned* st; };
DI XcdBarrier xcd_barrier_post(unsigned* bar, volatile LAS unsigned* st) {
  XcdBarrier b; b.bar = bar; b.x = xb_xcc_id(); b.st = st;
  if (threadIdx.x == 0) (void)xb_add(&bar[XB_XCNT(b.x)], 1u);
  return b;
}
DI void xcd_barrier_complete(unsigned* bar, unsigned x, unsigned& nloc, unsigned& nx) {
  const unsigned G = gridDim.x * gridDim.y * gridDim.z;
  unsigned sum, cnt, mine, sp = 0u;
  for (;;) {
    sum = 0u; cnt = 0u; mine = 0u;
#pragma unroll
    for (unsigned j = 0; j < 16; ++j) { const unsigned c = xb_ld(&bar[XB_XCNT(j)]); sum += c; cnt += (c > 0u) ? 1u : 0u; mine = (j == x) ? c : mine; }
    if (sum == G) break;
    __builtin_amdgcn_s_sleep(1);
    if ((++sp & 255u) == 0u) { if (xb_ld(&bar[XB_TMO])) break; if (sp > XB_SPIN_CAP) { atomicAdd(&bar[XB_TMO], 1u); break; } }
  }
  nloc = mine > 0u ? mine : 1u; nx = cnt > 0u ? cnt : 1u;
}
DI void xcd_barrier(const XcdBarrier& b) {
  asm volatile("s_waitcnt vmcnt(0)" ::: "memory");
  __syncthreads();
  if (ltid_full() == 0) {
    unsigned* bar = b.bar;
    asm volatile("" : "+s"(bar));
    __builtin_amdgcn_s_waitcnt(0);
    unsigned nloc = b.st[0], nx = b.st[1];
    if (nloc == 0u) { xcd_barrier_complete(bar, b.x, nloc, nx); b.st[0] = nloc; b.st[1] = nx; }
    const unsigned old = xb_add(&bar[XB_XSUB(b.x)], 1u);
    const unsigned gen = old / nloc;
    if (old + 1u == (gen + 1u) * nloc) {
      __builtin_amdgcn_fence(__ATOMIC_RELEASE, "agent");
      asm volatile("s_waitcnt vmcnt(0)" ::: "memory");
      const unsigned og = xb_add(&bar[XB_TOP], 1u);
      const unsigned tg = og / nx;
      if (og + 1u == (tg + 1u) * nx) xb_add(&bar[XB_TOPGEN], 1u);
      else XB_SPIN(xb_ld(&bar[XB_TOPGEN]) == tg, bar);
      __builtin_amdgcn_fence(__ATOMIC_ACQUIRE, "agent");
      xb_add(&bar[XB_XGEN(b.x)], 1u);
      asm volatile("s_waitcnt vmcnt(0)" ::: "memory");
    } else {
      XB_SPIN(xb_ld(&bar[XB_XGEN(b.x)]) == gen, bar);
      __builtin_amdgcn_fence(__ATOMIC_ACQUIRE, "agent");
      asm volatile("s_waitcnt vmcnt(0)" ::: "memory");
    }
  }
  __syncthreads();
}


DI Params load_params(const volatile LAS unsigned* sp) {
  Params q;
  unsigned long long* dst = (unsigned long long*)&q;
#pragma unroll
  for (int i = 0; i < (int)(sizeof(Params) / 8); ++i) {
    const unsigned lo = (unsigned)__builtin_amdgcn_readfirstlane((int)sp[2 * i]), hi = (unsigned)__builtin_amdgcn_readfirstlane((int)sp[2 * i + 1]);
    dst[i] = ((unsigned long long)hi << 32) | lo;
  }
  return q;
}
#define GSYNC() do { XcdBarrier xb_; xb_.bar = (unsigned*)(q.ws + OFF_BAR); xb_.x = xb_xcc_id(); xb_.st = (volatile LAS unsigned*)&xb_words; xcd_barrier(xb_); } while (0)
__global__ void __launch_bounds__(512, 2) mega(Params p) {
  extern __shared__ __attribute__((aligned(1024))) char dsm[];
  __shared__ uint4 xb_words;
  __shared__ int s_item;
  cg::grid_group grid = cg::this_grid();
  __shared__ unsigned sparams[sizeof(Params) / 4];
  if (threadIdx.x == 0) xb_words = make_uint4(0u, 0u, 0u, 0u);
  if (threadIdx.x < sizeof(Params) / 4) sparams[threadIdx.x] = ((const unsigned*)&p)[threadIdx.x];
  __syncthreads();
  (void)xcd_barrier_post((unsigned*)(p.ws + OFF_BAR), (volatile LAS unsigned*)&xb_words);
  const int nblk = gridDim.x, bid = blockIdx.x;
  LAS char* lds = (LAS char*)dsm;
  phase0(p, dsm);
#if EXP == 6
  __syncthreads();
  phase0(p, dsm);
#endif
  if (p.ws == nullptr) grid.sync();
  { const Params q0 = load_params((const volatile LAS unsigned*)sparams); XcdBarrier xb_; xb_.bar = (unsigned*)(q0.ws + OFF_BAR); xb_.x = xb_xcc_id(); xb_.st = (volatile LAS unsigned*)&xb_words; xcd_barrier(xb_); }
  for (int l = 0; l < 4; ++l) {
    Params q = load_params((const volatile LAS unsigned*)sparams);
#define RELAUNDER() q = load_params((const volatile LAS unsigned*)sparams)
#define Hb ((const bf16_t*)(q.ws + OFF_HB))
    RELAUNDER();
    if (l == 0) {
      { const int hf = ltid_full() >> 8; char* smem = dsm + hf * HALF_SMEM; (void)smem;
      for (int pi = bid; pi < (T / 4 + 16 * 40) / 2; pi += nblk) {
        const int it = pi * 2 + hf;
        if (it < T / 4) norm_item(q, it);
        else { const int j = it - T / 4; wconv_tile<true>(q.w_in, nullptr, 2320, 1024, (bf16_t*)(q.ws + OFF_WIN), 0, j % 16, j / 16, smem, (const float*)(q.ws + OFF_MOD), (float*)(q.ws + OFF_BIAS1), 2560); }
      }
      }
      GSYNC();
    }
    RELAUNDER();
    gemm_phase8<EP_P>(q, l, Hb, (const bf16_t*)(q.ws + OFF_WIN), 1024, 136, 10, lds, 2);
#if EXP == 1
    gemm_phase<EP_P>(q, l, Hb, 1024, (const bf16_t*)(q.ws + OFF_WIN), 1024, 1024, 136, 10, lds);
#endif
    GSYNC();
    RELAUNDER();
    {
      int* ctrc = (int*)(q.ws + OFF_CTR) + 8 + l;
      constexpr int NPAIR = (NB * 4 * NCH + NB * NCH) / 2;
      while (true) {
        __syncthreads();
        if (ltid_full() == 0) s_item = atomicAdd(ctrc, 1);
        __syncthreads();
        const int pi = s_item;
        if (pi >= NPAIR) break;
        const int hf = ltid_full() >> 8; char* smem = dsm + hf * HALF_SMEM;
        const int it = pi * 2 + hf;
        if (it < NB * 4 * NCH) dnprep_item(q, l, it, smem, dsm);
        else aprep_item(q, l, it - NB * 4 * NCH, smem);
      }
    }
    GSYNC();
    RELAUNDER();
    {
    {
#if EXP == 2
      for (int rep = 0; rep < 2; ++rep) {
      int* ctr = (int*)(q.ws + OFF_CTR) + l + rep * 8;
#else
      {
      int* ctr = (int*)(q.ws + OFF_CTR) + l;
#endif
      constexpr int N_SCAN = 32, N_FT = 128, N_FTC = 8, N_GA = 512, N_WA = 512, N_CTXA = 64;
      constexpr int N_WO = 16 * 16 / 2, N_GU = 16 * 88 / 2, N_WD = 44 * 16 / 2, N_WI = 16 * 40 / 2;
      const int n_ctxa = l < 3 ? N_CTXA : 0;
      const int TOT = N_SCAN + N_FT + N_FTC + N_GA + N_WA + n_ctxa + N_WO + N_GU + N_WD + (l < 3 ? N_WI : 0);
      while (true) {
        __syncthreads();
        if (ltid_full() == 0) s_item = atomicAdd(ctr, 1);
        __syncthreads();
        int it = s_item;
        if (it >= TOT) break;
        const int hf = ltid_full() >> 8; char* smem = dsm + hf * HALF_SMEM;
        if (it < N_SCAN) { dnscan_item(q, it * 2 + hf, lds + hf * 65536); continue; }
        it -= N_SCAN;
        if (it < N_FT) { gemm8<EP_FT>(q, l, (const bf16_t*)(q.ws + OFF_ADFT), 4160, (const bf16_t*)(q.ws + OFF_BTFT), 4160, 4160, (it >> 3) * 256, (it & 7) * 256, lds); continue; }
        it -= N_FT;
        if (it < N_FTC) { gemm8<EP_FTC>(q, l, (const bf16_t*)(q.ws + OFF_ADFTC), 512, (const bf16_t*)(q.ws + OFF_BTFTC), 512, 512, 0, it * 256, lds); continue; }
        it -= N_FTC;
        if (it < N_GA) { const int j = it * 2 + hf; attn_item(q, l, 0, j >> 7, (j >> 6) & 1, 4 + (j & 63), smem); continue; }
        it -= N_GA;
        if (it < N_WA) { const int j = it * 2 + hf; attn_item(q, l, 1, j >> 7, (j >> 6) & 1, 4 + (j & 63), smem); continue; }
        it -= N_WA;
        if (it < n_ctxa) { const int j = it * 2 + hf; const int type = j >> 6, r = j & 63; attn_item(q, l, type, r >> 3, (r >> 2) & 1, r & 3, smem); continue; }
        it -= n_ctxa;
        {
          int j = it * 2 + hf;
          if (j < 2 * N_WO) { wconv_tile<false>(q.w_out + (size_t)l * 1024 * 1024, nullptr, 1024, 1024, (bf16_t*)(q.ws + OFF_WOUT), 0, j % 16, j / 16, smem); continue; }
          j -= 2 * N_WO;
          if (j < 2 * N_GU) { wconv_tile<true>(q.w_gate + (size_t)l * 1024 * HID, q.w_up + (size_t)l * 1024 * HID, HID, 1024, (bf16_t*)(q.ws + OFF_WGU), 1, j % 16, j / 16, smem,
                                     (const float*)(q.ws + OFF_MOD) + (size_t)l * 9 * 6144 + 3072, (float*)(q.ws + OFF_BIAS2) + (size_t)l * 9 * 5632, 5632); continue; }
          j -= 2 * N_GU;
          if (j < 2 * N_WD) { wconv_tile<false>(q.w_down + (size_t)l * HID * 1024, nullptr, 1024, HID, (bf16_t*)(q.ws + OFF_WD), 0, j % 44, j / 44, smem); continue; }
          j -= 2 * N_WD;
          wconv_tile<true>(q.w_in + (size_t)(l + 1) * 1024 * 2320, nullptr, 2320, 1024, (bf16_t*)(q.ws + OFF_WIN), 0, j % 16, j / 16, smem,
                           (const float*)(q.ws + OFF_MOD) + (size_t)(l + 1) * 9 * 6144, (float*)(q.ws + OFF_BIAS1) + (size_t)(l + 1) * 9 * 2560, 2560);
        }
      }
      }
    }
    }
    GSYNC();
    RELAUNDER();
    { const int hf = ltid_full() >> 8; char* smem = dsm + hf * HALF_SMEM; (void)smem;
    {
      for (int pi = bid; pi < T / 8; pi += nblk) dnmerge_item(q, l, pi * 2 + hf);
    }
    }
    GSYNC();
    RELAUNDER();
#if EXP == 1
    gemm_phase<EP_DUMMY>(q, l, (const bf16_t*)(q.ws + OFF_YMIX), 1024, (const bf16_t*)(q.ws + OFF_WOUT), 1024, 1024, 136, 4, lds);
#endif
    gemm_phase8<EP_RES1>(q, l, (const bf16_t*)(q.ws + OFF_YMIX), (const bf16_t*)(q.ws + OFF_WOUT), 1024, l == 3 ? 128 : 136, 4, lds, l == 3 ? 1 : 2);
    GSYNC();
    RELAUNDER();
    gemm_phase8<EP_GU>(q, l, Hb, (const bf16_t*)(q.ws + OFF_WGU), 1024, l == 3 ? 128 : 136, 22, lds, l == 3 ? 1 : 0);
#if EXP == 1
    gemm_phase<EP_GU>(q, l, Hb, 1024, (const bf16_t*)(q.ws + OFF_WGU), 1024, 1024, l == 3 ? 128 : 136, 22, lds, l == 3);
#endif
    GSYNC();
    RELAUNDER();
#if EXP == 1
    gemm_phase<EP_DUMMY>(q, l, (const bf16_t*)(q.ws + OFF_HM), HID, (const bf16_t*)(q.ws + OFF_WD), HID, HID, 136, 4, lds);
#endif
    gemm_phase8<EP_RES2>(q, l, (const bf16_t*)(q.ws + OFF_HM), (const bf16_t*)(q.ws + OFF_WD), HID, l == 3 ? 128 : 136, 4, lds, l == 3 ? 1 : 2);
    GSYNC();
  }
}

#undef Hb
extern "C" void kernel_launch(void* const* d_in, const int* in_sizes, int n_in, void* d_out, int out_size, void* d_ws, size_t ws_size,
                              hipStream_t stream) {
  if (ws_size < WS_NEED) { fprintf(stderr, "workspace too small: %zu < %zu\n", ws_size, (size_t)WS_NEED); return; }
  static int grid_blocks = 0;
  if (!grid_blocks) {
    int dev = 0, cus = 0, per_cu = 0;
    (void)hipGetDevice(&dev);
    (void)hipDeviceGetAttribute(&cus, hipDeviceAttributeMultiprocessorCount, dev);
    if (hipFuncSetAttribute((const void*)mega, hipFuncAttributeMaxDynamicSharedMemorySize, LDS_BYTES) != hipSuccess) fprintf(stderr, "hipFuncSetAttribute failed\n");
    (void)hipOccupancyMaxActiveBlocksPerMultiprocessor(&per_cu, mega, 512, LDS_BYTES);
    if (per_cu < 1) { fprintf(stderr, "occupancy query returned %d\n", per_cu); per_cu = 1; }
    grid_blocks = (cus / 8) * 8;
  }
  Params p{};
  const float** pf = (const float**)&p;
  for (int i = 0; i < 22; ++i) pf[i] = (const float*)d_in[i];
  p.out = (float*)d_out;
  p.ws = (char*)d_ws;
  (void)hipMemsetAsync((char*)d_ws + OFF_BAR, 0, XCD_BAR_WORDS * 4, stream);
  void* args[] = {&p};
  hipError_t e = hipLaunchCooperativeKernel((void*)mega, dim3(grid_blocks), dim3(512), args, LDS_BYTES, stream);
  if (e != hipSuccess) fprintf(stderr, "cooperative launch failed: %s (grid %d)\n", hipGetErrorString(e), grid_blocks);
}
```

```cpp
#include <hip/hip_runtime.h>
#include <hip/hip_cooperative_groups.h>
#include <stdint.h>
#include <stdio.h>
namespace cg = cooperative_groups;

typedef unsigned short bf16_t;
typedef short bf16x8 __attribute__((ext_vector_type(8)));
typedef short bf16x4 __attribute__((ext_vector_type(4)));
typedef float f32x4 __attribute__((ext_vector_type(4)));
typedef unsigned u32x4 __attribute__((ext_vector_type(4)));
#define DI __device__ __forceinline__
#define MFMA16(a, b, c) __builtin_amdgcn_mfma_f32_16x16x32_bf16((a), (b), (c), 0, 0, 0)

constexpr int NB = 8, SEQ = 4096, LC = 256, TB = 4352, T = NB * TB, DM = 1024, PW = 2064, HID = 2816, NCH = 68;
constexpr int NIN_PAD = 2560;
constexpr float EPS = 1e-6f;
constexpr float LOG2E = 1.4426950408889634f;

constexpr size_t OFF_MOD = 0;
constexpr size_t OFF_ROPEC = 1u << 20;
constexpr size_t OFF_ROPES = OFF_ROPEC + 524288;
constexpr size_t OFF_CS64 = OFF_ROPES + 524288;
constexpr size_t OFF_ADFTC = OFF_CS64 + 16384;
constexpr size_t OFF_CTR = OFF_ADFTC + 262144;
constexpr size_t OFF_BAR = OFF_CTR + 4096;
constexpr size_t OFF_XC = 2621440;
constexpr size_t OFF_HB = OFF_XC + 8388608;
constexpr size_t SZ_HB = (size_t)T * 1024 * 2;
constexpr size_t OFF_QA = OFF_HB;
constexpr size_t OFF_KA = OFF_QA + (size_t)2 * T * 256 * 2;
constexpr size_t OFF_VT = OFF_KA + (size_t)2 * T * 128 * 2;
constexpr size_t OFF_P = OFF_HB + SZ_HB;
constexpr size_t SZ_P = (size_t)T * PW * 2;
constexpr size_t OFF_YMIX = OFF_P;
constexpr size_t OFF_ODN = OFF_P + SZ_HB;
constexpr size_t OFF_Z = OFF_P + SZ_P;
constexpr size_t OFF_BTFT = OFF_Z + (size_t)T * 256 * 2;
constexpr size_t OFF_BTFTC = OFF_BTFT + (size_t)2048 * 8192 * 2;
constexpr size_t OFF_HM = OFF_P;
constexpr size_t OFF_ADFT = OFF_BTFTC + (size_t)2048 * 512 * 2;
constexpr size_t OFF_RSS1 = OFF_ADFT + (size_t)4096 * 4160 * 2;
constexpr size_t OFF_RSS2 = OFF_RSS1 + (size_t)T * 4;
constexpr size_t OFF_BIAS1 = OFF_RSS2 + (size_t)T * 4;
constexpr size_t OFF_BIAS2 = OFF_BIAS1 + (size_t)4 * 9 * 2560 * 4;
constexpr size_t OFF_DN = OFF_ADFT + (size_t)4096 * 8192 * 2;
constexpr size_t SZ_CB = 40960;
constexpr int NCB = NB * 4 * 2 * NCH;
constexpr size_t OFF_GEND = OFF_DN + (size_t)NCB * SZ_CB;
constexpr size_t WS_NEED = OFF_GEND + (size_t)NCB * 64 * 4;
constexpr size_t OFF_WIN = OFF_BIAS2 + (size_t)4 * 9 * 5632 * 4;
constexpr size_t OFF_WOUT = OFF_WIN + (size_t)NIN_PAD * 1024 * 2;
constexpr size_t OFF_WGU = OFF_WOUT + (size_t)1024 * 1024 * 2;
constexpr size_t OFF_WD = OFF_WGU + (size_t)5632 * 1024 * 2;
static_assert(OFF_WD + (size_t)1024 * 2816 * 2 <= OFF_ADFT + (size_t)4096 * 8192 * 2, "weights overflow the ADFT region tail");
static_assert((size_t)T * HID * 2 <= OFF_ADFT - OFF_P, "Hm alias overflow");

struct Params {
  const float *x, *c, *ctx, *c_ctx, *norm1_g, *norm2_g, *w_ada, *b_ada, *w_in, *conv_w, *A_log, *dt_bias, *dn_norm_g,
      *ga_qn, *ga_kn, *wa_qn, *wa_kn, *wa_sink, *w_out, *w_gate, *w_up, *w_down;
  float* out;
  char* ws;
};

constexpr int HALF_SMEM = 53248;
constexpr int LDS_BYTES = 131072 + 8192;
#define LAS __attribute__((address_space(3)))
#define WAIT_V(n) asm volatile("s_waitcnt vmcnt(%0)" ::"n"(n) : "memory")

DI unsigned pk(float a, float b) {
  typedef __bf16 bf2 __attribute__((ext_vector_type(2)));
  typedef float f2 __attribute__((ext_vector_type(2)));
  f2 v = {a, b};
  bf2 r = __builtin_convertvector(v, bf2);
  return __builtin_bit_cast(unsigned, r);
}
DI bf16_t f2bf(float a) { return (bf16_t)(pk(a, 0.f) & 0xffffu); }
DI float bf2f(bf16_t h) { return __uint_as_float(((unsigned)h) << 16); }
DI float bflo(unsigned u) { return __uint_as_float(u << 16); }
DI float bfhi(unsigned u) { return __uint_as_float(u & 0xffff0000u); }
DI int ltid_full() { int t = threadIdx.x; asm volatile("" : "+v"(t)); return t; }
DI int ltid() { return ltid_full() & 255; }
DI float silu_f(float x) { return x * __builtin_amdgcn_rcpf(1.f + __expf(-x)); }
DI int permk(int x) { return ((x >> 5) << 5) + (((x >> 2) & 3) << 3) + (((x >> 4) & 1) << 2) + (x & 3); }

DI float* xrow(const Params& p, int t) {
  int b = t / TB, tb = t - b * TB;
  return tb < LC ? (float*)(p.ws + OFF_XC) + ((size_t)(b * LC + tb)) * DM : p.out + ((size_t)(b * SEQ + tb - LC)) * DM;
}
DI const float* xrow_in(const Params& p, int t) {
  int b = t / TB, tb = t - b * TB;
  return tb < LC ? p.ctx + ((size_t)(b * LC + tb)) * DM : p.x + ((size_t)(b * SEQ + tb - LC)) * DM;
}
DI int bidx_of(int t) { const int b = t / TB, tb = t - b * TB; return tb < LC ? 8 : b; }
DI const float* modrow(const Params& p, int l, int t) {
  int b = t / TB, tb = t - b * TB;
  int bi = tb < LC ? 8 : b;
  return (const float*)(p.ws + OFF_MOD) + ((size_t)(l * 9 + bi)) * 6144;
}

enum { EP_P = 0, EP_RES1 = 1, EP_GU = 2, EP_RES2 = 3, EP_FT = 4, EP_FTC = 5, EP_DUMMY = 6 };
#ifndef EXP
#define EXP 0
#endif

DI int lds_byte(int r, int c) {
  const int st = (r >> 4) * 2 + (c >> 5), ob = (r & 15) * 64 + (c & 31) * 2;
  return st * 1024 + (ob ^ (((ob >> 9) & 1) << 5));
}
DI void stage_rc(int b, int& R, int& C) {
  const int st = b >> 10, sb = b & 1023, swz = sb ^ (((sb >> 9) & 1) << 5);
  R = (st >> 1) * 16 + swz / 64;
  C = (st & 1) * 32 + (swz % 64) / 2;
}

template <int MODE>
DI void gemm_epilogue(const Params& p, int l, const f32x4 (&acc)[8][4], int m0, int n0, int wr, int wc, int fr, int fq, const LAS float* cst) {
#pragma unroll
  for (int i = 0; i < 8; ++i) {
    const int m = m0 + wr * 128 + i * 16 + fr;
    if (MODE == EP_P) {
      bf16_t* Pp = (bf16_t*)(p.ws + OFF_P) + (size_t)m * PW;
      bf16_t* Zp = (bf16_t*)(p.ws + OFF_Z) + (size_t)m * 256;
      const float rs = rsqrtf(cst[wr * 128 + i * 16 + fr] * (1.f / 1024.f) + EPS);
#pragma unroll
      for (int j = 0; j < 4; ++j) {
        const int n = n0 + wc * 64 + j * 16 + fq * 4;
        const f32x4 bq = *(const LAS f32x4*)(cst + 256 + wc * 64 + j * 16 + fq * 4);
        uint2 v = {pk(acc[i][j][0] * rs + bq[0], acc[i][j][1] * rs + bq[1]), pk(acc[i][j][2] * rs + bq[2], acc[i][j][3] * rs + bq[3])};
        if (n < 768) *(uint2*)(Pp + n) = v;
        else if (n < 1024) *(uint2*)(Zp + (n - 768)) = v;
        else if (n < 2320) *(uint2*)(Pp + (n - 256)) = v;
      }
    } else if (MODE == EP_RES1 || MODE == EP_RES2) {
      float* xo = xrow(p, m);
      const bool emit = (MODE == EP_RES1) || (l < 3);
      bf16_t* hb = (bf16_t*)(p.ws + OFF_HB) + (size_t)m * 1024;
      float4 xv[4];
#pragma unroll
      for (int j = 0; j < 4; ++j) xv[j] = *(const float4*)(xo + n0 + wc * 64 + j * 16 + fq * 4);
      float ssq = 0.f;
#pragma unroll
      for (int j = 0; j < 4; ++j) {
        const int n = n0 + wc * 64 + j * 16 + fq * 4;
        const f32x4 gq = *(const LAS f32x4*)(cst + 256 + wc * 64 + j * 16 + fq * 4), mq = *(const LAS f32x4*)(cst + 512 + wc * 64 + j * 16 + fq * 4);
        const float4 gv = {gq[0], gq[1], gq[2], gq[3]}, mv = {mq[0], mq[1], mq[2], mq[3]};
        xv[j].x += gv.x * acc[i][j][0]; xv[j].y += gv.y * acc[i][j][1]; xv[j].z += gv.z * acc[i][j][2]; xv[j].w += gv.w * acc[i][j][3];
        *(float4*)(xo + n) = xv[j];
        if (emit) {
          ssq += xv[j].x * xv[j].x + xv[j].y * xv[j].y + xv[j].z * xv[j].z + xv[j].w * xv[j].w;
          *(uint2*)(hb + n) = uint2{pk(xv[j].x * mv.x, xv[j].y * mv.y), pk(xv[j].z * mv.z, xv[j].w * mv.w)};
        }
      }
      if (emit) {
        ssq += __shfl_xor(ssq, 16);
        ssq += __shfl_xor(ssq, 32);
        if (fq == 0) unsafeAtomicAdd((float*)(p.ws + (MODE == EP_RES1 ? OFF_RSS2 : OFF_RSS1)) + m, ssq);
      }
    } else if (MODE == EP_GU) {
      bf16_t* hp = (bf16_t*)(p.ws + OFF_HM) + (size_t)m * HID;
      const float rs = rsqrtf(cst[wr * 128 + i * 16 + fr] * (1.f / 1024.f) + EPS);
#pragma unroll
      for (int jj = 0; jj < 2; ++jj) {
        const int hcol = ((n0 + wc * 64) >> 1) + jj * 16 + fq * 4;
        const f32x4 bg = *(const LAS f32x4*)(cst + 256 + wc * 64 + (2 * jj) * 16 + fq * 4), bu = *(const LAS f32x4*)(cst + 256 + wc * 64 + (2 * jj + 1) * 16 + fq * 4);
        const float bgv[4] = {bg[0], bg[1], bg[2], bg[3]}, buv[4] = {bu[0], bu[1], bu[2], bu[3]};
        float o[4];
#pragma unroll
        for (int r = 0; r < 4; ++r) o[r] = silu_f(acc[i][2 * jj][r] * rs + bgv[r]) * (acc[i][2 * jj + 1][r] * rs + buv[r]);
        uint2 v = {pk(o[0], o[1]), pk(o[2], o[3])};
        *(uint2*)(hp + hcol) = v;
      }
    } else if (MODE == EP_DUMMY) {
      bf16_t* dp = (bf16_t*)(p.ws + OFF_DN + (size_t)40 * 1024 * 1024) + (size_t)m * 1024;
#pragma unroll
      for (int j = 0; j < 4; ++j) {
        const int n = n0 + wc * 64 + j * 16 + fq * 4;
        *(uint2*)(dp + n) = uint2{pk(acc[i][j][0], acc[i][j][1]), pk(acc[i][j][2], acc[i][j][3])};
      }
    } else {
      bf16_t* Y = (bf16_t*)(p.ws + OFF_YMIX);
      const float scale = (MODE == EP_FT) ? (1.f / 512.f) : (1.f / 128.f);
#pragma unroll
      for (int j = 0; j < 4; ++j) {
        const int n = n0 + wc * 64 + j * 16 + fq * 4;
        const int b = n >> 8;
        const size_t row = (size_t)b * TB + (MODE == EP_FT ? LC : 0) + m;
        uint2 v = {pk(acc[i][j][0] * scale, acc[i][j][1] * scale), pk(acc[i][j][2] * scale, acc[i][j][3] * scale)};
        *(uint2*)(Y + row * 1024 + 768 + (n & 255)) = v;
      }
    }
  }
}

constexpr int G8_TILE_B = 256 * 64 * 2, G8_STAGE_B = 2 * G8_TILE_B;
#define G8_STAGE(Ab_, Bb_, buf, kt)                                                                                                            \
  do {                                                                                                                                        \
    _Pragma("unroll") for (int i = 0; i < 4; ++i) {                                                                                           \
      __builtin_amdgcn_global_load_lds((const unsigned*)((Ab_) + offA[i] + (kt) * 64), (LAS unsigned*)(lds + (buf) * G8_STAGE_B + wid * 1024 + i * 8192), 16, 0, 0);               \
      __builtin_amdgcn_global_load_lds((const unsigned*)((Bb_) + offB[i] + (kt) * 64), (LAS unsigned*)(lds + (buf) * G8_STAGE_B + G8_TILE_B + wid * 1024 + i * 8192), 16, 0, 0);   \
    }                                                                                                                                         \
  } while (0)
#define G8_COMPUTE(buf)                                                                                                                       \
  do {                                                                                                                                        \
    const LAS char* sa = lds + (buf) * G8_STAGE_B;                                                                                            \
    const LAS char* sb = sa + G8_TILE_B;                                                                                                      \
    _Pragma("unroll") for (int ks = 0; ks < 2; ++ks) {                                                                                        \
      bf16x8 bfr[4];                                                                                                                          \
      _Pragma("unroll") for (int j = 0; j < 4; ++j) bfr[j] = *(const LAS bf16x8*)(sb + lds_byte(wc * 64 + j * 16 + fr, ks * 32 + fq * 8));    \
      bf16x8 a_cur = *(const LAS bf16x8*)(sa + lds_byte(wr * 128 + fr, ks * 32 + fq * 8));                                                    \
      _Pragma("unroll") for (int i = 0; i < 8; ++i) {                                                                                         \
        bf16x8 a_nxt = a_cur;                                                                                                                 \
        if (i < 7) a_nxt = *(const LAS bf16x8*)(sa + lds_byte(wr * 128 + (i + 1) * 16 + fr, ks * 32 + fq * 8));          \
        __builtin_amdgcn_s_setprio(1);                                                                                                        \
        _Pragma("unroll") for (int j = 0; j < 4; ++j) acc[i][j] = MFMA16(bfr[j], a_cur, acc[i][j]);                                           \
        __builtin_amdgcn_s_setprio(0);                                                                                                        \
        __builtin_amdgcn_sched_group_barrier(0x100, 1, 0);                                                                                    \
        __builtin_amdgcn_sched_group_barrier(0x008, 4, 0);                                                                                    \
        a_cur = a_nxt;                                                                                                                        \
      }                                                                                                                                       \
    }                                                                                                                                         \
  } while (0)
#define G8_SETUP()                                                                                                                            \
  const int tid = ltid_full(), wid = tid >> 6, lane = tid & 63;                                                                               \
  const int wr = wid >> 2, wc = wid & 3, fr = lane & 15, fq = lane >> 4;                                                                      \
  int offA[4], offB[4];                                                                                                                       \
  _Pragma("unroll") for (int i = 0; i < 4; ++i) {                                                                                             \
    int R, C;                                                                                                                                 \
    stage_rc(wid * 1024 + i * 8192 + lane * 16, R, C);                                                                                        \
    offA[i] = R * lda + C;                                                                                                                    \
    offB[i] = R * ldb + C;                                                                                                                    \
  }

template <int MODE>
DI void gemm8(const Params& p, int l, const bf16_t* A, int lda, const bf16_t* Bt, int ldb, int K, int m0, int n0, LAS char* lds) {
  G8_SETUP();
  f32x4 acc[8][4];
#pragma unroll
  for (int i = 0; i < 8; ++i)
#pragma unroll
    for (int j = 0; j < 4; ++j) acc[i][j] = f32x4{0.f, 0.f, 0.f, 0.f};
  const bf16_t* Ab = A + (size_t)m0 * lda;
  const bf16_t* Bb = Bt + (size_t)n0 * ldb;
  const int nt = K >> 6;
  G8_STAGE(Ab, Bb, 0, 0);
  WAIT_V(0);
  __syncthreads();
  for (int t = 0; t < nt; ++t) {
    const int cur = t & 1;
    if (t + 1 < nt) G8_STAGE(Ab, Bb, cur ^ 1, t + 1);
    G8_COMPUTE(cur);
    WAIT_V(0);
    __syncthreads();
  }
  gemm_epilogue<MODE>(p, l, acc, m0, n0, wr, wc, fr, fq, (const LAS float*)(lds + 131072));
}

struct GTile { int m0, n0, kb, nk, atomic; };
template <int MODE>
DI bool gemm_next_tile(int k, int nM, int nN, int Kit, GTile& g, bool skipctx = false) {
  const int ntl = nM * nN, per = ntl >> 3;
  const int nb8 = gridDim.x >> 3, xcd = blockIdx.x & 7, j = blockIdx.x >> 3;
  const int R = per / nb8, rem = per - R * nb8;
  int loc;
  g.kb = 0; g.nk = Kit; g.atomic = 0;
  if (k < R) loc = k * nb8 + j;
  else if (k == R && rem > 0) {
    int S = 1;
    if (false) { S = nb8 / rem; while (S > 1 && (Kit % S)) --S; }
    if (j >= rem * S) return false;
    loc = R * nb8 + j / S;
    if (S > 1) { g.nk = Kit / S; g.kb = (j % S) * g.nk; g.atomic = 1; }
  } else return false;
  const int L = xcd * per + loc;
  const int nig = 8 * nN, gid = L / nig, fm = gid * 8, gsz = (nM - fm) < 8 ? (nM - fm) : 8;
  int pm = fm + ((L % nig) % gsz);
  if (skipctx) pm += pm / 16 + 1;
  g.m0 = pm * 256;
  g.n0 = ((L % nig) / gsz) * 256;
  return true;
}

template <int MODE>
DI void gemm_phase(const Params& p, int l, const bf16_t* A, int lda, const bf16_t* Bt, int ldb, int K, int nM, int nN, LAS char* lds, bool skipctx = false) {
  G8_SETUP();
  const int Kit = K >> 6;
  GTile cur, nxt;
  bool have = gemm_next_tile<MODE>(0, nM, nN, Kit, cur, skipctx);
  if (have) G8_STAGE(A + (size_t)cur.m0 * lda, Bt + (size_t)cur.n0 * ldb, 0, cur.kb);
  for (int k = 0; have; ++k) {
    const bool hn = gemm_next_tile<MODE>(k + 1, nM, nN, Kit, nxt, skipctx);
    f32x4 acc[8][4];
#pragma unroll
    for (int i = 0; i < 8; ++i)
#pragma unroll
      for (int j = 0; j < 4; ++j) acc[i][j] = f32x4{0.f, 0.f, 0.f, 0.f};
    const bf16_t* Ab = A + (size_t)cur.m0 * lda;
    const bf16_t* Bb = Bt + (size_t)cur.n0 * ldb;
    LAS float* cst = (LAS float*)(lds + 131072 + (k & 1) * 4096);
    if (MODE == EP_P || MODE == EP_GU) {
      const float* rss = (const float*)(p.ws + (MODE == EP_P ? OFF_RSS1 : OFF_RSS2));
      const float* bias = (const float*)(p.ws + (MODE == EP_P ? OFF_BIAS1 : OFF_BIAS2)) + ((size_t)(l * 9 + bidx_of(cur.m0))) * (MODE == EP_P ? 2560 : 5632);
      cst[tid] = tid < 256 ? rss[cur.m0 + tid] : bias[cur.n0 + tid - 256];
    }
    if (MODE == EP_RES1 || MODE == EP_RES2) {
      const float* mrow = modrow(p, l, cur.m0);
      const int c = cur.n0 + (tid & 255);
      if (tid < 256) cst[256 + tid] = mrow[(MODE == EP_RES1 ? 2048 : 5120) + c];
      else {
        const float* ng = (MODE == EP_RES1) ? p.norm2_g + l * 1024 : p.norm1_g + (l < 3 ? l + 1 : 0) * 1024;
        const float* nsc = (MODE == EP_RES1) ? mrow + 4096 : modrow(p, l < 3 ? l + 1 : 0, cur.m0) + 1024;
        cst[256 + tid] = ng[c] * (1.f + nsc[c]);
      }
    }
    WAIT_V(0);
    __syncthreads();
    for (int t = 0; t < cur.nk; ++t) {
      const int cb = t & 1;
      if (t + 1 < cur.nk) G8_STAGE(Ab, Bb, cb ^ 1, cur.kb + t + 1);
      G8_COMPUTE(cb);
      WAIT_V(0);
      __syncthreads();
    }
    if (hn) G8_STAGE(A + (size_t)nxt.m0 * lda, Bt + (size_t)nxt.n0 * ldb, 0, nxt.kb);
    gemm_epilogue<MODE>(p, l, acc, cur.m0, cur.n0, wr, wc, fr, fq, cst);
    cur = nxt;
    have = hn;
  }
}

template <int MODE>
DI void gemm_epilogue8(const Params& p, int l, const f32x4 (&acc)[2][2][4][2], int m0, int n0, int wr, int wc, int fr, int fq, const LAS float* cst, bool half) {
#pragma unroll
  for (int ai = 0; ai < 2; ++ai)
#pragma unroll
    for (int mm = 0; mm < 4; ++mm) {
      if (ai == 1 && half) continue;
      const int rl = ai * 128 + wr * 64 + mm * 16 + fr;
      const int m = m0 + rl;
      if (MODE == EP_P) {
        bf16_t* Pp = (bf16_t*)(p.ws + OFF_P) + (size_t)m * PW;
        bf16_t* Zp = (bf16_t*)(p.ws + OFF_Z) + (size_t)m * 256;
        const float rs = rsqrtf(cst[rl] * (1.f / 1024.f) + EPS);
#pragma unroll
        for (int bj = 0; bj < 2; ++bj)
#pragma unroll
          for (int nn = 0; nn < 2; ++nn) {
            const int cl = bj * 128 + wc * 32 + nn * 16 + fq * 4, n = n0 + cl;
            const f32x4 bq = *(const LAS f32x4*)(cst + 256 + cl);
            const f32x4& a = acc[ai][bj][mm][nn];
            uint2 v = {pk(a[0] * rs + bq[0], a[1] * rs + bq[1]), pk(a[2] * rs + bq[2], a[3] * rs + bq[3])};
            if (n < 768) *(uint2*)(Pp + n) = v;
            else if (n < 1024) *(uint2*)(Zp + (n - 768)) = v;
            else if (n < 2320) *(uint2*)(Pp + (n - 256)) = v;
          }
      } else if (MODE == EP_RES1 || MODE == EP_RES2) {
        float* xo = xrow(p, m);
        const bool emit = (MODE == EP_RES1) || (l < 3);
        bf16_t* hb = (bf16_t*)(p.ws + OFF_HB) + (size_t)m * 1024;
        float4 xv[4];
#pragma unroll
        for (int q4 = 0; q4 < 4; ++q4) xv[q4] = *(const float4*)(xo + n0 + (q4 >> 1) * 128 + wc * 32 + (q4 & 1) * 16 + fq * 4);
        float ssq = 0.f;
#pragma unroll
        for (int q4 = 0; q4 < 4; ++q4) {
          const int cl = (q4 >> 1) * 128 + wc * 32 + (q4 & 1) * 16 + fq * 4, n = n0 + cl;
          const f32x4 gq = *(const LAS f32x4*)(cst + 256 + cl), mq = *(const LAS f32x4*)(cst + 512 + cl);
          const f32x4& a = acc[ai][q4 >> 1][mm][q4 & 1];
          xv[q4].x += gq[0] * a[0]; xv[q4].y += gq[1] * a[1]; xv[q4].z += gq[2] * a[2]; xv[q4].w += gq[3] * a[3];
          *(float4*)(xo + n) = xv[q4];
          if (emit) {
            ssq += xv[q4].x * xv[q4].x + xv[q4].y * xv[q4].y + xv[q4].z * xv[q4].z + xv[q4].w * xv[q4].w;
            *(uint2*)(hb + n) = uint2{pk(xv[q4].x * mq[0], xv[q4].y * mq[1]), pk(xv[q4].z * mq[2], xv[q4].w * mq[3])};
          }
        }
        if (emit) {
          ssq += __shfl_xor(ssq, 16);
          ssq += __shfl_xor(ssq, 32);
          if (fq == 0) unsafeAtomicAdd((float*)(p.ws + (MODE == EP_RES1 ? OFF_RSS2 : OFF_RSS1)) + m, ssq);
        }
      } else if (MODE == EP_GU) {
        bf16_t* hp = (bf16_t*)(p.ws + OFF_HM) + (size_t)m * HID;
        const float rs = rsqrtf(cst[rl] * (1.f / 1024.f) + EPS);
#pragma unroll
        for (int bj = 0; bj < 2; ++bj) {
          const int cl = bj * 128 + wc * 32 + fq * 4;
          const int hcol = ((n0 + bj * 128 + wc * 32) >> 1) + fq * 4;
          const f32x4 bg = *(const LAS f32x4*)(cst + 256 + cl), bu = *(const LAS f32x4*)(cst + 256 + cl + 16);
          const f32x4& ag = acc[ai][bj][mm][0];
          const f32x4& au = acc[ai][bj][mm][1];
          float o[4];
#pragma unroll
          for (int r = 0; r < 4; ++r) o[r] = silu_f(ag[r] * rs + bg[r]) * (au[r] * rs + bu[r]);
          *(uint2*)(hp + hcol) = uint2{pk(o[0], o[1]), pk(o[2], o[3])};
        }
      } else {
        bf16_t* dp = (bf16_t*)(p.ws + OFF_DN + (size_t)40 * 1024 * 1024) + (size_t)m * 1024;
#pragma unroll
        for (int q4 = 0; q4 < 4; ++q4) {
          const f32x4& a = acc[ai][q4 >> 1][mm][q4 & 1];
          *(uint2*)(dp + n0 + (q4 >> 1) * 128 + wc * 32 + (q4 & 1) * 16 + fq * 4) = uint2{pk(a[0], a[1]), pk(a[2], a[3])};
        }
      }
    }
}

DI bool next_tile8(int k, int nM, int nN, int Kit, GTile& g, int ctxmode) {
  if (ctxmode != 2) return gemm_next_tile<EP_P>(k, nM, nN, Kit, g, ctxmode == 1);
  if (gemm_next_tile<EP_P>(k, 128, nN, Kit, g, true)) return true;
  const int nb8 = gridDim.x >> 3, per = 16 * nN, R = per / nb8, kx = R + ((per - R * nb8) > 0 ? 1 : 0);
  const int j = blockIdx.x >> 3;
  if (k != kx || j >= 2 * nN) return false;
  const int u = (blockIdx.x & 7) * (2 * nN) + j;
  g.m0 = (blockIdx.x & 7) * 17 * 256 + ((j / nN) & 1) * 128;
  g.n0 = (j % nN) * 256;
  g.kb = 0; g.nk = Kit; g.atomic = 1;
  (void)u;
  return true;
}

template <int MODE>
DI void gemm_phase8(const Params& p, int l, const bf16_t* A, const bf16_t* Bt, int K, int nM, int nN, LAS char* lds, int ctxmode) {
  constexpr int HT = 128 * 64;
  const int tid = ltid_full(), wid = tid >> 6, lane = tid & 63;
  const int wr = wid >> 2, wc = wid & 3, fr = lane & 15, fq = lane >> 4;
  unsigned soff[2];
#pragma unroll
  for (int i = 0; i < 2; ++i) { int R, C; stage_rc(tid * 16 + i * 8192, R, C); soff[i] = (unsigned)(R * K + C) * 2u; }
#define P8_SA(b, h) (lds + (((b) * 2 + (h)) * HT) * 2)
#define P8_SB(b, h) (lds + ((4 + (b) * 2 + (h)) * HT) * 2)
#define P8_STAGE(P_, BASE_, br_, kt_)                                                                                                          \
  do {                                                                                                                                        \
    const unsigned long long _gi = (unsigned long long)((BASE_) + (size_t)(br_) * K + (size_t)(kt_) * 64);                                       \
    const char* _g = (const char*)(((unsigned long long)(unsigned)__builtin_amdgcn_readfirstlane((int)(_gi >> 32)) << 32) |                    \
                                   (unsigned)__builtin_amdgcn_readfirstlane((int)(unsigned)_gi));     \
    _Pragma("unroll") for (int _i = 0; _i < 2; ++_i)                                                                                          \
      __builtin_amdgcn_global_load_lds((const unsigned*)(_g + soff[_i]), (LAS unsigned*)((P_) + wid * 1024 + _i * 8192), 16, 0, 0);            \
  } while (0)
#define P8_LDA(dst, b, h)                                                                                                                     \
  _Pragma("unroll") for (int m_ = 0; m_ < 4; ++m_) _Pragma("unroll") for (int k_ = 0; k_ < 2; ++k_)                                           \
    dst[m_][k_] = *(const LAS bf16x8*)(P8_SA(b, h) + lds_byte(wr * 64 + m_ * 16 + fr, k_ * 32 + fq * 8))
#define P8_LDB(dst, b, h)                                                                                                                     \
  _Pragma("unroll") for (int n_ = 0; n_ < 2; ++n_) _Pragma("unroll") for (int k_ = 0; k_ < 2; ++k_)                                           \
    dst[n_][k_] = *(const LAS bf16x8*)(P8_SB(b, h) + lds_byte(wc * 32 + n_ * 16 + fr, k_ * 32 + fq * 8))
#define P8_MMA(ai, bj, At_, Bt_)                                                                                                              \
  do {                                                                                                                                        \
    __builtin_amdgcn_s_setprio(1);                                                                                                            \
    _Pragma("unroll") for (int m_ = 0; m_ < 4; ++m_) _Pragma("unroll") for (int n_ = 0; n_ < 2; ++n_) _Pragma("unroll") for (int k_ = 0; k_ < 2; ++k_) \
      acc[ai][bj][m_][n_] = MFMA16(Bt_[n_][k_], At_[m_][k_], acc[ai][bj][m_][n_]);                                                            \
    __builtin_amdgcn_s_setprio(0);                                                                                                            \
  } while (0)
#define P8_MMA_B1(ai, bj, At_, Bt_) do { if (!skipb1 && !((ai) == 1 && half)) P8_MMA(ai, bj, At_, Bt_); } while (0)
#define P8_MMA_A1(ai, bj, At_, Bt_) do { if (!half) P8_MMA(ai, bj, At_, Bt_); } while (0)
#define P8_WAIT_L(n) asm volatile("s_waitcnt lgkmcnt(%0)" ::"n"(n) : "memory")
#define P8_BAR __builtin_amdgcn_s_barrier()
#define P8_SCHED __builtin_amdgcn_sched_barrier(0)
  const int nt = K >> 6;
  GTile cur;
  for (int k = 0; next_tile8(k, nM, nN, nt, cur, ctxmode); ++k) {
    const int brow = cur.m0, bcol = cur.n0;
    const bool half = cur.atomic != 0;
    const bool skipb1 = (MODE == EP_P) && (bcol + 128 >= 2320);
    LAS float* cst = (LAS float*)(lds + 131072 + (k & 1) * 4096);
    if (MODE == EP_P || MODE == EP_GU) {
      const float* rss = (const float*)(p.ws + (MODE == EP_P ? OFF_RSS1 : OFF_RSS2));
      const float* bias = (const float*)(p.ws + (MODE == EP_P ? OFF_BIAS1 : OFF_BIAS2)) + ((size_t)(l * 9 + bidx_of(brow))) * (MODE == EP_P ? 2560 : 5632);
      cst[tid] = tid < 256 ? rss[brow + tid] : bias[bcol + tid - 256];
    }
    if (MODE == EP_RES1 || MODE == EP_RES2) {
      const float* mrow = modrow(p, l, brow);
      const int c = bcol + (tid & 255);
      if (tid < 256) cst[256 + tid] = mrow[(MODE == EP_RES1 ? 2048 : 5120) + c];
      else {
        const float* ng = (MODE == EP_RES1) ? p.norm2_g + l * 1024 : p.norm1_g + (l < 3 ? l + 1 : 0) * 1024;
        const float* nsc = (MODE == EP_RES1) ? mrow + 4096 : modrow(p, l < 3 ? l + 1 : 0, brow) + 1024;
        cst[256 + tid] = ng[c] * (1.f + nsc[c]);
      }
    }
    f32x4 acc[2][2][4][2];
#pragma unroll
    for (int a_ = 0; a_ < 2; ++a_)
#pragma unroll
      for (int b_ = 0; b_ < 2; ++b_)
#pragma unroll
        for (int m_ = 0; m_ < 4; ++m_)
#pragma unroll
          for (int n_ = 0; n_ < 2; ++n_) acc[a_][b_][m_][n_] = f32x4{0.f, 0.f, 0.f, 0.f};
    bf16x8 At[4][2], B0[2][2], B1[2][2];
    __syncthreads();
    P8_STAGE(P8_SB(0, 0), Bt, bcol, 0); P8_STAGE(P8_SA(0, 0), A, brow, 0);
    P8_STAGE(P8_SB(0, 1), Bt, bcol + 128, 0); P8_STAGE(P8_SA(0, 1), A, brow + 128, 0);
    if (wr == 1) P8_BAR;
    WAIT_V(4); P8_BAR;
    P8_STAGE(P8_SB(1, 0), Bt, bcol, 1); P8_STAGE(P8_SA(1, 0), A, brow, 1); P8_STAGE(P8_SB(1, 1), Bt, bcol + 128, 1);
    WAIT_V(6); P8_BAR;
    for (int t = 0; t < nt - 2; t += 2) {
      P8_LDB(B0, 0, 0); P8_SCHED; P8_LDA(At, 0, 0); P8_STAGE(P8_SA(1, 1), A, brow + 128, t + 1);
      P8_WAIT_L(8); P8_BAR; P8_WAIT_L(0); P8_MMA(0, 0, At, B0); P8_BAR; P8_SCHED;
      P8_LDB(B1, 0, 1); P8_STAGE(P8_SB(0, 0), Bt, bcol, t + 2);
      P8_BAR; P8_WAIT_L(0); P8_MMA_B1(0, 1, At, B1); P8_BAR;
      P8_LDA(At, 0, 1); P8_STAGE(P8_SA(0, 0), A, brow, t + 2);
      P8_BAR; P8_WAIT_L(0); P8_MMA_A1(1, 0, At, B0); P8_BAR; P8_SCHED;
      P8_STAGE(P8_SB(0, 1), Bt, bcol + 128, t + 2);
      WAIT_V(6); P8_BAR; P8_MMA_B1(1, 1, At, B1); P8_BAR;
      P8_LDB(B0, 1, 0); P8_SCHED; P8_LDA(At, 1, 0); P8_STAGE(P8_SA(0, 1), A, brow + 128, t + 2);
      P8_WAIT_L(8); P8_BAR; P8_WAIT_L(0); P8_MMA(0, 0, At, B0); P8_BAR; P8_SCHED;
      P8_LDB(B1, 1, 1); P8_STAGE(P8_SB(1, 0), Bt, bcol, t + 3);
      P8_BAR; P8_WAIT_L(0); P8_MMA_B1(0, 1, At, B1); P8_BAR;
      P8_LDA(At, 1, 1); P8_STAGE(P8_SA(1, 0), A, brow, t + 3);
      P8_BAR; P8_WAIT_L(0); P8_MMA_A1(1, 0, At, B0); P8_BAR; P8_SCHED;
      P8_STAGE(P8_SB(1, 1), Bt, bcol + 128, t + 3);
      WAIT_V(6); P8_BAR; P8_MMA_B1(1, 1, At, B1); P8_BAR;
    }
    { P8_LDB(B0, 0, 0); P8_LDA(At, 0, 0); P8_STAGE(P8_SA(1, 1), A, brow + 128, nt - 1);
      P8_BAR; P8_WAIT_L(0); P8_MMA(0, 0, At, B0); P8_BAR;
      P8_LDB(B1, 0, 1); P8_BAR; P8_WAIT_L(0); P8_MMA_B1(0, 1, At, B1); P8_BAR;
      P8_LDA(At, 0, 1); WAIT_V(4); P8_BAR; P8_WAIT_L(0); P8_MMA_A1(1, 0, At, B0); P8_MMA_B1(1, 1, At, B1); P8_BAR; }
    { P8_LDB(B0, 1, 0); P8_LDA(At, 1, 0); WAIT_V(2); P8_BAR; P8_WAIT_L(0); P8_MMA(0, 0, At, B0); P8_BAR;
      P8_LDB(B1, 1, 1); WAIT_V(0); P8_BAR; P8_WAIT_L(0); P8_MMA_B1(0, 1, At, B1); P8_BAR;
      P8_LDA(At, 1, 1); P8_BAR; P8_WAIT_L(0); P8_MMA_A1(1, 0, At, B0); P8_MMA_B1(1, 1, At, B1); P8_BAR; }
    if (wr == 0) P8_BAR;
    gemm_epilogue8<MODE>(p, l, acc, brow, bcol, wr, wc, fr, fq, cst, half);
  }
}

template <bool BIAS>
DI void wconv_tile(const float* src0, const float* src1, int N, int K, bf16_t* dst, int kind, int kt, int nt, char* smem, const float* shvec = nullptr, float* bias = nullptr, int npad = 0) {
  float* tile = (float*)smem;
  const int tid = ltid();
  __syncthreads();
  {
    const int nn = tid & 63, kk0 = tid >> 6;
    const int R = nt * 64 + nn;
    const float* src = src0;
    int col = R;
    bool ok = true;
    if (kind == 1) {
      const int grp = R >> 5, up = (R >> 4) & 1;
      col = grp * 16 + (R & 15);
      src = up ? src1 : src0;
    } else ok = R < N;
    float wv[16];
#pragma unroll
    for (int i = 0; i < 16; ++i) wv[i] = ok ? src[(size_t)(kt * 64 + kk0 + i * 4) * N + col] : 0.f;
#pragma unroll
    for (int i = 0; i < 16; ++i) tile[(kk0 + i * 4) * 65 + nn] = wv[i];
    if (BIAS) {
      float* svs = tile + 64 * 65;
      for (int o = tid; o < 9 * 64; o += 256) svs[o] = shvec[(size_t)(o >> 6) * 6144 + kt * 64 + (o & 63)];
    }
  }
  __syncthreads();
  {
    const int rr = tid >> 2, kc = (tid & 3) * 16;
    unsigned o[8];
#pragma unroll
    for (int e = 0; e < 8; ++e) o[e] = pk(tile[(kc + 2 * e) * 65 + rr], tile[(kc + 2 * e + 1) * 65 + rr]);
    bf16_t* d = dst + (size_t)(nt * 64 + rr) * K + kt * 64 + kc;
    *(uint4*)d = uint4{o[0], o[1], o[2], o[3]};
    *(uint4*)(d + 8) = uint4{o[4], o[5], o[6], o[7]};
  }
  if (BIAS) {
    for (int o = tid; o < 9 * 64; o += 256) {
      const int bq = o >> 6, nn = o & 63;
      const float* sv = tile + 64 * 65 + bq * 64;
      float a = 0.f;
#pragma unroll 8
      for (int kk = 0; kk < 64; ++kk) a += sv[kk] * tile[kk * 65 + nn];
      unsafeAtomicAdd(bias + (size_t)bq * npad + nt * 64 + nn, a);
    }
  }
}

DI void mod_item(const Params& p, int item, char* smem) {
  const int l = item / 96, cgp = item % 96;
  float* sc = (float*)smem;
  float* red = sc + 9 * 1024;
  const int tid = ltid();
  __syncthreads();
  for (int i = tid; i < 9 * 1024; i += 256) {
    const int r = i >> 10, k = i & 1023;
    const float v = r < 8 ? p.c[r * 1024 + k] : p.c_ctx[k];
    sc[i] = silu_f(v);
  }
  __syncthreads();
  const int kq = tid >> 6, cc = tid & 63, col = cgp * 64 + cc;
  float acc[9];
#pragma unroll
  for (int r = 0; r < 9; ++r) acc[r] = 0.f;
  const float* wp = p.w_ada + (size_t)l * 1024 * 6144 + col;
#pragma unroll 8
  for (int k = kq * 256; k < kq * 256 + 256; ++k) {
    const float wv = wp[(size_t)k * 6144];
#pragma unroll
    for (int r = 0; r < 9; ++r) acc[r] += sc[r * 1024 + k] * wv;
  }
#pragma unroll
  for (int r = 0; r < 9; ++r) red[(kq * 9 + r) * 64 + cc] = acc[r];
  __syncthreads();
  for (int i = tid; i < 9 * 64; i += 256) {
    const int r = i >> 6, c2 = i & 63;
    const float s = red[(0 * 9 + r) * 64 + c2] + red[(1 * 9 + r) * 64 + c2] + red[(2 * 9 + r) * 64 + c2] + red[(3 * 9 + r) * 64 + c2];
    ((float*)(p.ws + OFF_MOD))[((size_t)(l * 9 + r)) * 6144 + cgp * 64 + c2] = s + p.b_ada[l * 6144 + cgp * 64 + c2];
  }
}

DI void phase0(const Params& p, char* smem) {
  const int tid = ltid(), hf = ltid_full() >> 8;
  constexpr int N_MOD_IT = 384, N_ROPE = 512, N_CS = 32, N_ADC = 512, N_AD = 4160;
  constexpr int TOT = N_MOD_IT + N_ROPE + N_CS + N_ADC + N_AD;
  if (blockIdx.x == 0 && hf == 0 && tid < 64) ((int*)(p.ws + OFF_CTR))[tid] = 0;
  for (int i = blockIdx.x * 512 + ltid_full(); i < 4 * 9 * (2560 + 5632); i += gridDim.x * 512) ((float*)(p.ws + OFF_BIAS1))[i] = 0.f;
  for (int pi = blockIdx.x; pi < TOT / 2; pi += gridDim.x) {
    int i = pi * 2 + hf;
    if (i < N_MOD_IT) { mod_item(p, i, smem + hf * HALF_SMEM); continue; }
    i -= N_MOD_IT;
    if (i < N_ROPE) {
      const int e = i * 256 + tid;
      const int pos = e >> 5, f = e & 31;
      const float pv = (f < 16) ? (float)(pos >> 6) : (float)(pos & 63);
      const float invf = powf(10000.f, -(float)(f & 15) / 16.f);
      const float ang = pv * invf;
      float s, c;
      sincosf(ang, &s, &c);
      ((float*)(p.ws + OFF_ROPEC))[e] = c;
      ((float*)(p.ws + OFF_ROPES))[e] = s;
      continue;
    }
    i -= N_ROPE;
    if (i < N_CS) {
      const int e = i * 256 + tid;
      const int r = e >> 6, n2 = e & 63;
      const int idx = ((r & 63) * n2) & 63;
      float s, c;
      sincospif((float)idx / 32.f, &s, &c);
      ((bf16_t*)(p.ws + OFF_CS64))[e] = f2bf(r < 64 ? c : s);
      continue;
    }
    i -= N_CS;
    if (i < N_ADC) {
      const int e = i * 256 + tid;
      const int k1 = e >> 9, cc = e & 511, n1 = cc & 255;
      const int idx = (k1 * n1) & 255;
      float s, c;
      sincospif((float)idx / 128.f, &s, &c);
      ((bf16_t*)(p.ws + OFF_ADFTC))[e] = f2bf(cc < 256 ? c : -s);
      continue;
    }
    i -= N_ADC;
    if (i < N_AD) {
      const size_t e0 = (size_t)i * 4096 + (size_t)tid * 16;
      const int k1 = (int)(e0 / 4160), c0 = (int)(e0 % 4160);
      unsigned o[8];
#pragma unroll
      for (int e = 0; e < 8; ++e) {
        float v[2];
#pragma unroll
        for (int h = 0; h < 2; ++h) {
          const int cc = c0 + 2 * e + h;
          const int n1 = cc < 2112 ? cc : cc - 2112;
          const int idx = (k1 * n1) & 4095;
          float sn, cs;
          sincospif((float)idx / 2048.f, &sn, &cs);
          v[h] = cc < 2112 ? (cc <= 2048 ? cs : 0.f) : -sn;
        }
        o[e] = pk(v[0], v[1]);
      }
      bf16_t* dd = (bf16_t*)(p.ws + OFF_ADFT) + e0;
      *(uint4*)dd = uint4{o[0], o[1], o[2], o[3]};
      *(uint4*)(dd + 8) = uint4{o[4], o[5], o[6], o[7]};
      continue;
    }
  }
}

DI void norm_item(const Params& p, int item) {
  const int tid = ltid();
  const int w = tid >> 6, lane = tid & 63;
  const int t = item * 4 + w;
  const float* xr = xrow_in(p, t);
  const float* md = modrow(p, 0, t);
  const float* g = p.norm1_g;
  float4 v[4];
  float ss = 0.f;
#pragma unroll
  for (int j = 0; j < 4; ++j) {
    v[j] = *(const float4*)(xr + j * 256 + lane * 4);
    ss += v[j].x * v[j].x + v[j].y * v[j].y + v[j].z * v[j].z + v[j].w * v[j].w;
  }
#pragma unroll
  for (int off = 32; off >= 1; off >>= 1) ss += __shfl_xor(ss, off);
  if (lane == 0) ((float*)(p.ws + OFF_RSS1))[t] = ss;
  float* xo = xrow(p, t);
  bf16_t* hb = (bf16_t*)(p.ws + OFF_HB) + (size_t)t * 1024;
#pragma unroll
  for (int j = 0; j < 4; ++j) {
    const int c = j * 256 + lane * 4;
    *(float4*)(xo + c) = v[j];
    const float4 gg = *(const float4*)(g + c), sc = *(const float4*)(md + 1024 + c);
    *(uint2*)(hb + c) = uint2{pk(v[j].x * gg.x * (1.f + sc.x), v[j].y * gg.y * (1.f + sc.y)), pk(v[j].z * gg.z * (1.f + sc.z), v[j].w * gg.w * (1.f + sc.w))};
  }
}

DI void aprep_item(const Params& p, int l, int item, char* smem) {
  const int b = item / NCH, c = item % NCH;
  const int tok0 = b * TB + c * 64;
  const bool isctx = c < 4;
  int tid_ = ltid();
  const int tid = tid_, lane = tid & 63, w = tid >> 6;
  const bf16_t* P = (const bf16_t*)(p.ws + OFF_P);
  for (int it = 0; it < 12; ++it) {
    const int task = it * 64 + (tid >> 2);
    const int cq = tid & 3;
    const int type = task / 384, rem = task % 384, hr = rem >> 6, tk = rem & 63;
    const int t = tok0 + tk;
    const int pcol = (type ? 1296 : 784) + hr * 64;
    const bf16_t* src = P + (size_t)t * PW + pcol;
    const uint4 u1 = *(const uint4*)(src + cq * 8), u2 = *(const uint4*)(src + 32 + cq * 8);
    float a[8], bb[8];
    a[0] = bflo(u1.x); a[1] = bfhi(u1.x); a[2] = bflo(u1.y); a[3] = bfhi(u1.y); a[4] = bflo(u1.z); a[5] = bfhi(u1.z); a[6] = bflo(u1.w); a[7] = bfhi(u1.w);
    bb[0] = bflo(u2.x); bb[1] = bfhi(u2.x); bb[2] = bflo(u2.y); bb[3] = bfhi(u2.y); bb[4] = bflo(u2.z); bb[5] = bfhi(u2.z); bb[6] = bflo(u2.w); bb[7] = bfhi(u2.w);
    float ss = 0.f;
#pragma unroll
    for (int e = 0; e < 8; ++e) ss += a[e] * a[e] + bb[e] * bb[e];
    ss += __shfl_xor(ss, 1);
    ss += __shfl_xor(ss, 2);
    const float rs = rsqrtf(ss * (1.f / 64.f) + EPS);
    const float* gn = (type ? (hr < 4 ? p.wa_qn : p.wa_kn) : (hr < 4 ? p.ga_qn : p.ga_kn)) + l * 64;
    const float qs = hr < 4 ? 0.125f * LOG2E : 1.f;
    float o1[8], o2[8];
#pragma unroll
    for (int e = 0; e < 8; ++e) {
      a[e] = a[e] * rs * gn[cq * 8 + e];
      bb[e] = bb[e] * rs * gn[32 + cq * 8 + e];
    }
    if (!isctx) {
      const int pos = c * 64 + tk - LC;
      const float* rc = (const float*)(p.ws + OFF_ROPEC) + pos * 32 + cq * 8;
      const float* rsn = (const float*)(p.ws + OFF_ROPES) + pos * 32 + cq * 8;
#pragma unroll
      for (int e = 0; e < 8; ++e) {
        const float cs = rc[e], sn = rsn[e];
        o1[e] = (a[e] * cs - bb[e] * sn) * qs;
        o2[e] = (a[e] * sn + bb[e] * cs) * qs;
      }
    } else {
#pragma unroll
      for (int e = 0; e < 8; ++e) { o1[e] = a[e] * qs; o2[e] = bb[e] * qs; }
    }
    bf16_t* dst = hr < 4 ? (bf16_t*)(p.ws + OFF_QA) + ((size_t)type * T + t) * 256 + hr * 64
                         : (bf16_t*)(p.ws + OFF_KA) + ((size_t)type * T + t) * 128 + (hr - 4) * 64;
    *(uint4*)(dst + cq * 8) = uint4{pk(o1[0], o1[1]), pk(o1[2], o1[3]), pk(o1[4], o1[5]), pk(o1[6], o1[7])};
    *(uint4*)(dst + 32 + cq * 8) = uint4{pk(o2[0], o2[1]), pk(o2[2], o2[3]), pk(o2[4], o2[5]), pk(o2[6], o2[7])};
  }
  {
    bf16_t* sT = (bf16_t*)smem;
#pragma unroll 1
    for (int type = 0; type < 2; ++type) {
      const int vcol = (type ? 1296 : 784) + 384;
      __syncthreads();
#pragma unroll
      for (int i = 0; i < 4; ++i) {
        const int q = tid + i * 256, tk = q >> 4, ch = q & 15;
        *(uint4*)(sT + tk * 136 + ch * 8) = *(const uint4*)(P + (size_t)(tok0 + tk) * PW + vcol + ch * 8);
      }
      __syncthreads();
      const int kd = tid & 127, th = tid >> 7;
      bf16_t* dst = (bf16_t*)(p.ws + OFF_VT) + (((size_t)(type * NB + b) * 128 + kd)) * TB + c * 64 + th * 32;
#pragma unroll
      for (int j0 = 0; j0 < 32; j0 += 8) {
        unsigned o[4];
#pragma unroll
        for (int e = 0; e < 4; ++e) {
          const unsigned lo = sT[(th * 32 + j0 + 2 * e) * 136 + kd], hi = sT[(th * 32 + j0 + 2 * e + 1) * 136 + kd];
          o[e] = lo | (hi << 16);
        }
        *(uint4*)(dst + j0) = uint4{o[0], o[1], o[2], o[3]};
      }
    }
  }
  {
    const int g = w, lr = lane & 15, lq = lane >> 4;
    const bf16_t* CS = (const bf16_t*)(p.ws + OFF_CS64);
    const int cl = c - 4;
    if (isctx || cl <= 32) {
#pragma unroll 1
      for (int nh = 0; nh < 2; ++nh) {
      bf16x8 bs[2][2], bd[2][2];
#pragma unroll
      for (int ntl = 0; ntl < 2; ++ntl) {
        const int nt = nh * 2 + ntl;
        const int n1 = cl * 64 + nt * 16 + lr;
        const bool mir = !isctx && n1 >= 1 && n1 <= 2047;
        const bool zero = !isctx && n1 > 2048;
#pragma unroll
        for (int ks = 0; ks < 2; ++ks) {
          const int coff = 1808 + g * 64 + ks * 32 + lq * 8;
          uint4 a = *(const uint4*)(P + (size_t)(tok0 + nt * 16 + lr) * PW + coff);
          uint4 m = {0u, 0u, 0u, 0u};
          if (mir) m = *(const uint4*)(P + (size_t)(b * TB + LC + 4096 - n1) * PW + coff);
          if (zero) a = uint4{0u, 0u, 0u, 0u};
          const unsigned ua[4] = {a.x, a.y, a.z, a.w}, um[4] = {m.x, m.y, m.z, m.w};
          unsigned os[4], od[4];
#pragma unroll
          for (int e = 0; e < 4; ++e) {
            const float a0 = bflo(ua[e]), a1 = bfhi(ua[e]), m0 = bflo(um[e]), m1 = bfhi(um[e]);
            os[e] = pk(a0 + m0, a1 + m1);
            od[e] = pk(a0 - m0, a1 - m1);
          }
          bs[ntl][ks] = __builtin_bit_cast(bf16x8, uint4{os[0], os[1], os[2], os[3]});
          bd[ntl][ks] = __builtin_bit_cast(bf16x8, uint4{od[0], od[1], od[2], od[3]});
        }
      }
#pragma unroll 1
      for (int mt = 0; mt < 8; ++mt) {
        bf16x8 af[2];
#pragma unroll
        for (int ks = 0; ks < 2; ++ks) af[ks] = *(const bf16x8*)(CS + (mt * 16 + lr) * 64 + ks * 32 + lq * 8);
#pragma unroll
        for (int ntl = 0; ntl < 2; ++ntl) {
          const int nt = nh * 2 + ntl;
          f32x4 acc = {0.f, 0.f, 0.f, 0.f};
          const bool sinpart = mt >= 4;
          acc = MFMA16(af[0], (sinpart && !isctx) ? bd[ntl][0] : bs[ntl][0], acc);
          acc = MFMA16(af[1], (sinpart && !isctx) ? bd[ntl][1] : bs[ntl][1], acc);
#pragma unroll
          for (int r = 0; r < 4; ++r) {
            const int k2row = mt * 16 + lq * 4 + r, k2 = k2row & 63, part = k2row >> 6;
            const int tk = c * 64 + nt * 16 + lr;
            if (isctx) ((bf16_t*)(p.ws + OFF_BTFTC))[((size_t)(b * 256 + g * 64 + k2)) * 512 + part * 256 + tk] = f2bf(acc[r]);
            else {
              const int n1 = tk - LC;
              if (part == 0 || n1 < 2048) ((bf16_t*)(p.ws + OFF_BTFT))[((size_t)(b * 256 + g * 64 + k2)) * 4160 + part * 2112 + n1] = f2bf(acc[r]);
            }
          }
        }
      }
      }
    }
  }
}

DI int dn_step(int c, int d) { return c < 4 ? (d ? 3 - c : c) : 4 + (d ? 67 - c : c - 4); }

DI void dnprep_item(const Params& p, int l, int item, char* smem, char* dsm0) {
  const int b = item / (4 * NCH), h = (item / NCH) & 3, c = item % NCH;
  bf16_t* qb = (bf16_t*)smem;
  bf16_t* kb = qb + 64 * 72;
  float* kf = (float*)(smem + 18432);
  float* vf = kf + 4096;
  float* Am = kf;
  int tid_ = ltid();
  const int tid = tid_, lane = tid & 63, w = tid >> 6, lr = lane & 15, lq = lane >> 4;
  const int tok0 = b * TB + c * 64;
  const bool isctx = c < 4;
  const int sbeg = isctx ? b * TB : b * TB + LC, send = isctx ? b * TB + LC : (b + 1) * TB;
  const bf16_t* P = (const bf16_t*)(p.ws + OFF_P);
  const int tau = tid >> 2, cq = tid & 3;
  const int t = tok0 + tau;
  float qv[16], kv[16], vv[16];
  __syncthreads();
#pragma unroll
  for (int part = 0; part < 3; ++part) {
    const int col = part * 256 + h * 64 + cq * 16;
    const float* cw = p.conv_w + (size_t)l * 3 * 768 + col;
    const bool hasp = t - 1 >= sbeg, hasn = t + 1 < send;
    const u32x4 z4 = {0u, 0u, 0u, 0u};
    const u32x4 a1l = *(const u32x4*)(P + (size_t)t * PW + col), a1h = *(const u32x4*)(P + (size_t)t * PW + col + 8);
    u32x4 a0l = z4, a0h = z4, a2l = z4, a2h = z4;
    if (hasp) { a0l = *(const u32x4*)(P + (size_t)(t - 1) * PW + col); a0h = *(const u32x4*)(P + (size_t)(t - 1) * PW + col + 8); }
    if (hasn) { a2l = *(const u32x4*)(P + (size_t)(t + 1) * PW + col); a2h = *(const u32x4*)(P + (size_t)(t + 1) * PW + col + 8); }
#pragma unroll
    for (int e = 0; e < 16; ++e) {
      const unsigned w0 = e < 8 ? a0l[(e & 7) >> 1] : a0h[(e & 7) >> 1];
      const unsigned w1 = e < 8 ? a1l[(e & 7) >> 1] : a1h[(e & 7) >> 1];
      const unsigned w2 = e < 8 ? a2l[(e & 7) >> 1] : a2h[(e & 7) >> 1];
      const float x0 = (e & 1) ? bfhi(w0) : bflo(w0);
      const float x1 = (e & 1) ? bfhi(w1) : bflo(w1);
      const float x2 = (e & 1) ? bfhi(w2) : bflo(w2);
      const float y = x0 * cw[e] + x1 * cw[768 + e] + x2 * cw[1536 + e];
      const float sv = silu_f(y);
      if (part == 0) qv[e] = sv; else if (part == 1) kv[e] = sv; else vv[e] = sv;
    }
    asm volatile("" ::: "memory");
  }
  {
    float sq = 0.f, sk = 0.f;
#pragma unroll
    for (int e = 0; e < 16; ++e) { sq += qv[e] * qv[e]; sk += kv[e] * kv[e]; }
    sq += __shfl_xor(sq, 1); sq += __shfl_xor(sq, 2);
    sk += __shfl_xor(sk, 1); sk += __shfl_xor(sk, 2);
    const float rq = rsqrtf(sq + EPS) * 0.125f, rk = rsqrtf(sk + EPS);
#pragma unroll
    for (int e = 0; e < 16; ++e) { qv[e] *= rq; kv[e] *= rk; }
  }
  float* gl = (float*)(dsm0 + (ltid_full() >> 8) * HALF_SMEM + 18432 + 32768);
  float* bl = gl + 128;
  float* gc = bl + 128;
  float* bd = gc + 128;
  if (tid < 128) {
    const int d = tid >> 6, i = tid & 63, ta = d ? 63 - i : i;
    const bf16_t* pr = P + (size_t)(tok0 + ta) * PW + 768;
    const float a = bf2f(pr[d * 4 + h]), bb = bf2f(pr[8 + d * 4 + h]);
    const float xx = a + p.dt_bias[l * 8 + d * 4 + h];
    const float ex = __expf(xx);
    const float sp = xx > 20.f ? xx : (ex < 0.03f ? ex * (1.f - ex * (0.5f - ex * (1.f / 3.f - 0.25f * ex))) : __logf(1.f + ex));
    float v = -__expf(p.A_log[l * 8 + d * 4 + h]) * sp;
#pragma unroll
    for (int off = 1; off < 64; off <<= 1) {
      const float tq = __shfl_up(v, off);
      if (i >= off) v += tq;
    }
    gc[d * 64 + i] = v;
    bd[d * 64 + i] = 1.f / (1.f + __expf(-bb));
  }
  {
#pragma unroll
    for (int e = 0; e < 16; e += 4) {
      *(uint2*)(qb + tau * 72 + cq * 16 + e) = uint2{pk(qv[e], qv[e + 1]), pk(qv[e + 2], qv[e + 3])};
      *(uint2*)(kb + tau * 72 + cq * 16 + e) = uint2{pk(kv[e], kv[e + 1]), pk(kv[e + 2], kv[e + 3])};
      *(float4*)(kf + tau * 64 + cq * 16 + e) = float4{kv[e], kv[e + 1], kv[e + 2], kv[e + 3]};
      *(float4*)(vf + tau * 64 + cq * 16 + e) = float4{vv[e], vv[e + 1], vv[e + 2], vv[e + 3]};
    }
  }
  __syncthreads();
#pragma unroll
  for (int d = 0; d < 2; ++d) {
    const int i = d ? 63 - tau : tau;
    const int cb = ((b * 4 + h) * 2 + d) * NCH + dn_step(c, d);
    bf16_t* base = (bf16_t*)(p.ws + OFF_DN + (size_t)cb * SZ_CB);
    const float eg = __expf(gc[d * 64 + i]);
    bf16_t* qd = base + 4096 + i * 64;
#pragma unroll
    for (int q4 = 0; q4 < 4; ++q4) {
      const int pos = (cq >> 1) * 32 + q4 * 8 + (cq & 1) * 4;
      *(uint2*)(qd + pos) = uint2{pk(qv[q4 * 4] * eg, qv[q4 * 4 + 1] * eg), pk(qv[q4 * 4 + 2] * eg, qv[q4 * 4 + 3] * eg)};
    }
  }
#pragma unroll
  for (int d = 0; d < 2; ++d) {
    const int cb = ((b * 4 + h) * 2 + d) * NCH + dn_step(c, d);
    bf16_t* kt = (bf16_t*)(p.ws + OFF_DN + (size_t)cb * SZ_CB) + 3 * 4096 + tau * 64 + cq * 16;
    const float gl63 = gc[d * 64 + 63];
    unsigned o[8];
#pragma unroll
    for (int e2 = 0; e2 < 8; ++e2) {
      float vals[2];
#pragma unroll
      for (int hq = 0; hq < 2; ++hq) {
        const int e = e2 * 2 + hq;
        const int i = (2 * (cq >> 1) + ((e >> 2) & 1)) * 16 + ((((cq & 1) << 1) | (e >> 3)) << 2) + (e & 3);
        const int ta = d ? 63 - i : i;
        vals[hq] = kf[ta * 64 + tau] * __expf(gl63 - gc[d * 64 + i]);
      }
      o[e2] = pk(vals[0], vals[1]);
    }
    *(uint4*)kt = uint4{o[0], o[1], o[2], o[3]};
    *(uint4*)(kt + 8) = uint4{o[4], o[5], o[6], o[7]};
  }
  if (tid < 128) {
    const int d = tid >> 6;
    const int cb = ((b * 4 + h) * 2 + d) * NCH + dn_step(c, d);
    ((float*)(p.ws + OFF_GEND))[(size_t)cb * 64 + (tid & 63)] = __expf(gc[d * 64 + 63]);
  }
  f32x4 KK[4], QK[4];
  {
    bf16x8 ak[2], aq[2];
#pragma unroll
    for (int ks = 0; ks < 2; ++ks) {
      ak[ks] = *(const bf16x8*)(kb + (w * 16 + lr) * 72 + ks * 32 + lq * 8);
      aq[ks] = *(const bf16x8*)(qb + (w * 16 + lr) * 72 + ks * 32 + lq * 8);
    }
#pragma unroll
    for (int nt = 0; nt < 4; ++nt) {
      KK[nt] = f32x4{0.f, 0.f, 0.f, 0.f};
      QK[nt] = f32x4{0.f, 0.f, 0.f, 0.f};
#pragma unroll
      for (int ks = 0; ks < 2; ++ks) {
        const bf16x8 bk = *(const bf16x8*)(kb + (nt * 16 + lr) * 72 + ks * 32 + lq * 8);
        KK[nt] = MFMA16(ak[ks], bk, KK[nt]);
        QK[nt] = MFMA16(aq[ks], bk, QK[nt]);
      }
    }
  }
  const int sd = w >> 1, half = w & 1;
  float xs[64];
#pragma unroll
  for (int i = 0; i < 64; ++i) {
    const int ta = sd ? 63 - i : i;
    const float bt = bd[sd * 64 + i];
    xs[i] = half ? kf[ta * 64 + lane] * bt * __expf(gc[sd * 64 + i]) : vf[ta * 64 + lane] * bt;
    if ((i & 7) == 7) asm volatile("" ::: "memory");
  }
  __syncthreads();
#pragma unroll
  for (int d = 0; d < 2; ++d) {
    const int cb = ((b * 4 + h) * 2 + d) * NCH + dn_step(c, d);
    bf16_t* inb = (bf16_t*)(p.ws + OFF_DN + (size_t)cb * SZ_CB) + 2 * 4096;
#pragma unroll
    for (int nt = 0; nt < 4; ++nt)
#pragma unroll
      for (int r = 0; r < 4; ++r) {
        const int ti = w * 16 + lq * 4 + r, tj = nt * 16 + lr;
        const int i = d ? 63 - ti : ti, j = d ? 63 - tj : tj;
        const float dec = (i >= j) ? __expf(gc[d * 64 + i] - gc[d * 64 + j]) : 0.f;
        Am[d * 4096 + i * 64 + j] = (i > j) ? bd[d * 64 + i] * KK[nt][r] * dec : 0.f;
        inb[i * 64 + permk(j)] = f2bf(QK[nt][r] * dec);
        if (r == 3) asm volatile("" ::: "memory");
      }
  }
  __syncthreads();
  {
    const float* Ad = Am + sd * 4096;
    f32x4 an[16];
    an[0] = *(const f32x4*)(Ad + 1 * 64);
#pragma unroll
    for (int i = 1; i < 64; ++i) {
      f32x4 ac[16];
#pragma unroll
      for (int j4 = 0; j4 <= (i - 1) / 4; ++j4) ac[j4] = an[j4];
      if (i + 1 < 64) {
#pragma unroll
        for (int j4 = 0; j4 <= i / 4; ++j4) an[j4] = *(const f32x4*)(Ad + (i + 1) * 64 + j4 * 4);
      }
      float sacc = xs[i];
#pragma unroll
      for (int j4 = 0; j4 <= (i - 1) / 4; ++j4) {
        sacc -= ac[j4][0] * xs[j4 * 4];
        sacc -= ac[j4][1] * xs[j4 * 4 + 1];
        sacc -= ac[j4][2] * xs[j4 * 4 + 2];
        sacc -= ac[j4][3] * xs[j4 * 4 + 3];
      }
      xs[i] = sacc;
      asm volatile("" ::: "memory");
    }
    const int cb = ((b * 4 + h) * 2 + sd) * NCH + dn_step(c, sd);
    bf16_t* base = (bf16_t*)(p.ws + OFF_DN + (size_t)cb * SZ_CB);
    if (half == 0) {
      bf16_t* U = base + 4 * 4096;
#pragma unroll
      for (int i4 = 0; i4 < 16; ++i4) {
        const int mt = i4 >> 2, q4 = i4 & 3;
        *(uint2*)(U + ((((mt * 4 + (lane >> 4)) * 4 + q4) * 16 + (lane & 15)) << 2)) = uint2{pk(xs[i4 * 4], xs[i4 * 4 + 1]), pk(xs[i4 * 4 + 2], xs[i4 * 4 + 3])};
      }
    } else {
      bf16_t* Wn = base;
      const int pc = permk(lane);
#pragma unroll
      for (int i = 0; i < 64; ++i) Wn[i * 64 + pc] = f2bf(-xs[i]);
    }
  }
}

DI bf16x8 pack8(const f32x4& a, const f32x4& b) {
  uint4 u = {pk(a[0], a[1]), pk(a[2], a[3]), pk(b[0], b[1]), pk(b[2], b[3])};
  return __builtin_bit_cast(bf16x8, u);
}

DI void dnscan_item(const Params& p, int item, LAS char* lb) {
  const int b = item >> 3, h = (item >> 1) & 3, d = item & 1;
  int tid_ = ltid();
  const int lane = tid_ & 63, w = tid_ >> 6, lr = lane & 15, lq = lane >> 4;
  f32x4 S[4];
#pragma unroll
  for (int mt = 0; mt < 4; ++mt) S[mt] = f32x4{0.f, 0.f, 0.f, 0.f};
  const int cb0 = ((b * 4 + h) * 2 + d) * NCH;
  unsigned pfacc = 0u;
  int soff[8];
#pragma unroll
  for (int i = 0; i < 8; ++i) {
    const int j = w * 512 + i * 64 + lane, jj = j & 511, row = jj >> 3, ch = jj & 7;
    soff[i] = (j >> 9) * 4096 + row * 64 + ((ch ^ (row & 7)) << 3);
  }
#define SC_STAGE(buf, step)                                                                                                                   \
  do {                                                                                                                                        \
    const bf16_t* gb_ = (const bf16_t*)(p.ws + OFF_DN + (size_t)(cb0 + (step)) * SZ_CB);                                                       \
    _Pragma("unroll") for (int i = 0; i < 8; ++i)                                                                                             \
      __builtin_amdgcn_global_load_lds((const unsigned*)(gb_ + soff[i]), (LAS unsigned*)(lb + (buf) * 32768 + (w * 512 + i * 64) * 16), 16, 0, 0); \
  } while (0)
  int foff[4][2];
#pragma unroll
  for (int mt = 0; mt < 4; ++mt)
#pragma unroll
    for (int ks = 0; ks < 2; ++ks) { const int row = mt * 16 + lr; foff[mt][ks] = row * 128 + (((ks * 4 + lq) ^ (row & 7)) << 4); }
  SC_STAGE(0, 0);
  uint2 uu[4];
  float ge;
  {
    const bf16_t* base = (const bf16_t*)(p.ws + OFF_DN + (size_t)cb0 * SZ_CB);
#pragma unroll
    for (int mt = 0; mt < 4; ++mt) uu[mt] = *(const uint2*)(base + 4 * 4096 + ((((mt * 4 + w) * 4 + lq) * 16 + lr) << 2));
    ge = ((const float*)(p.ws + OFF_GEND))[(size_t)cb0 * 64 + lane];
  }
  WAIT_V(0);
#pragma unroll 1
  for (int s = 0; s < NCH; ++s) {
    WAIT_V(8);
    __syncthreads();
    if (s + 1 < NCH) SC_STAGE((s + 1) & 1, s + 1);
    uint2 un[4] = {uu[0], uu[1], uu[2], uu[3]};
    float gn = ge;
    if (s + 1 < NCH) {
      const bf16_t* nb = (const bf16_t*)(p.ws + OFF_DN + (size_t)(cb0 + s + 1) * SZ_CB);
#pragma unroll
      for (int mt = 0; mt < 4; ++mt) un[mt] = *(const uint2*)(nb + 4 * 4096 + ((((mt * 4 + w) * 4 + lq) * 16 + lr) << 2));
      gn = ((const float*)(p.ws + OFF_GEND))[(size_t)(cb0 + s + 1) * 64 + lane];
    }
    unsigned pf0 = 0u, pf1 = 0u;
    if (s + 2 < NCH) {
      const unsigned* nb = (const unsigned*)(p.ws + OFF_DN + (size_t)(cb0 + s + 2) * SZ_CB);
      pf0 = nb[(w * 80 + lane) * 32];
      if (lane < 16) pf1 = nb[(w * 80 + 64 + lane) * 32];
    }
    const LAS char* sb = lb + (s & 1) * 32768;
    bf16x8 sB[2];
    sB[0] = pack8(S[0], S[1]);
    sB[1] = pack8(S[2], S[3]);
    f32x4 vn[4], o[4];
#pragma unroll
    for (int mt = 0; mt < 4; ++mt) {
      vn[mt] = f32x4{bflo(uu[mt].x), bfhi(uu[mt].x), bflo(uu[mt].y), bfhi(uu[mt].y)};
      o[mt] = f32x4{0.f, 0.f, 0.f, 0.f};
#pragma unroll
      for (int ks = 0; ks < 2; ++ks) {
        const bf16x8 aw = *(const LAS bf16x8*)(sb + foff[mt][ks]);
        const bf16x8 aq = *(const LAS bf16x8*)(sb + 8192 + foff[mt][ks]);
        vn[mt] = MFMA16(aw, sB[ks], vn[mt]);
        o[mt] = MFMA16(aq, sB[ks], o[mt]);
      }
    }
    bf16x8 vB[2];
    vB[0] = pack8(vn[0], vn[1]);
    vB[1] = pack8(vn[2], vn[3]);
#pragma unroll
    for (int mt = 0; mt < 4; ++mt) {
#pragma unroll
      for (int r = 0; r < 4; ++r) S[mt][r] *= ge;
#pragma unroll
      for (int ks = 0; ks < 2; ++ks) {
        const bf16x8 ai = *(const LAS bf16x8*)(sb + 16384 + foff[mt][ks]);
        const bf16x8 ak = *(const LAS bf16x8*)(sb + 24576 + foff[mt][ks]);
        o[mt] = MFMA16(ai, vB[ks], o[mt]);
        S[mt] = MFMA16(ak, vB[ks], S[mt]);
      }
    }
    pfacc ^= pf0 ^ pf1;
#pragma unroll
    for (int mt = 0; mt < 4; ++mt) uu[mt] = un[mt];
    ge = gn;
    int dl = d;
    asm volatile("" : "+v"(dl));
    float* Od = (float*)(p.ws + OFF_ODN) + (size_t)dl * T * 256;
    const int c = s < 4 ? (d ? 3 - s : s) : 4 + (d ? 67 - s : s - 4);
#pragma unroll
    for (int mt = 0; mt < 4; ++mt)
#pragma unroll
      for (int r = 0; r < 4; ++r) {
        const int i = mt * 16 + lq * 4 + r;
        const int ta = d ? 63 - i : i;
        Od[((size_t)(b * TB + c * 64 + ta)) * 256 + h * 64 + w * 16 + lr] = o[mt][r];
      }
  }
#undef SC_STAGE
  __syncthreads();
  if (pfacc == 0x9e3779b9u && ((const float*)(p.ws + OFF_GEND))[0] == 123.456f) ((float*)(p.ws + OFF_ODN))[0] = 0.f;
}

DI void attn_item(const Params& p, int l, int type, int b, int kvh, int qb, char* smem) {
  constexpr int KB = 64 * 64 * 2, VB = 64 * 72 * 2, SB = KB + VB;
  int tid_ = ltid();
  const int tid = tid_, lane = tid & 63, w = tid >> 6, lr = lane & 15, lq = lane >> 4;
  const int g = w >> 1, qh = kvh * 2 + g;
  const int qloc0 = qb * 64 + (w & 1) * 32;
  const bool isctx = qb < 4;
  const bf16_t* Qa = (const bf16_t*)(p.ws + OFF_QA) + ((size_t)type * T + (size_t)b * TB) * 256 + qh * 64;
  const bf16_t* Kg = (const bf16_t*)(p.ws + OFF_KA) + ((size_t)type * T + (size_t)b * TB) * 128 + kvh * 64;
  const bf16_t* Vg = (const bf16_t*)(p.ws + OFF_VT) + ((size_t)(type * NB + b) * 128 + kvh * 64) * TB;
  bf16x8 qf[2][2];
#pragma unroll
  for (int nt = 0; nt < 2; ++nt)
#pragma unroll
    for (int ks = 0; ks < 2; ++ks) qf[nt][ks] = *(const bf16x8*)(Qa + (size_t)(qloc0 + nt * 16 + lr) * 256 + ks * 32 + lq * 8);
  float neg_big;
  asm volatile("v_mov_b32 %0, 0xf149f2ca" : "=v"(neg_big));
  float mrun[2];
  f32x4 O[4][2], Ls[2];
  const bf16x8 ones8 = {(short)0x3F80, (short)0x3F80, (short)0x3F80, (short)0x3F80, (short)0x3F80, (short)0x3F80, (short)0x3F80, (short)0x3F80};
#pragma unroll
  for (int nt = 0; nt < 2; ++nt) {
    if (type == 1) { mrun[nt] = p.wa_sink[l * 4 + qh] * LOG2E; Ls[nt] = f32x4{1.f, 1.f, 1.f, 1.f}; }
    else { mrun[nt] = neg_big; Ls[nt] = f32x4{0.f, 0.f, 0.f, 0.f}; }
#pragma unroll
    for (int mt = 0; mt < 4; ++mt) O[mt][nt] = f32x4{0.f, 0.f, 0.f, 0.f};
  }
  const int n_lat_lo = (!isctx && type == 1) ? qb - 2 : 4;
  const int ntiles = isctx ? 4 : (type == 0 ? NCH : 9);
  const int lrow = tid >> 3, lch = tid & 7;
  u32x4 rk[2], rv[2];
#pragma unroll
  for (int i = 0; i < 2; ++i) {
    rk[i] = *(const u32x4*)(Kg + (size_t)(lrow + i * 32) * 128 + lch * 8);
    rv[i] = *(const u32x4*)(Vg + (size_t)(lrow + i * 32) * TB + lch * 8);
  }
#pragma unroll
  for (int i = 0; i < 2; ++i) {
    const int r = lrow + i * 32;
    *(u32x4*)(smem + r * 128 + ((lch ^ (r & 7)) << 4)) = rk[i];
    *(u32x4*)(smem + KB + r * 144 + lch * 16) = rv[i];
  }
  __syncthreads();
  for (int ti = 0; ti < ntiles; ++ti) {
    const int jraw = ti < 4 ? ti : n_lat_lo + (ti - 4);
    const bool tvalid = ti < 4 || (jraw >= 4 && jraw < NCH);
    const int jt = ti < 4 ? ti : (jraw < 4 ? 4 : (jraw > NCH - 1 ? NCH - 1 : jraw));
    const char* sK = smem + (ti & 1) * SB;
    const char* sV = sK + KB;
    if (ti + 1 < ntiles) {
      const int jn0 = (ti + 1) < 4 ? ti + 1 : n_lat_lo + (ti + 1 - 4);
      const int jn = (ti + 1) < 4 ? jn0 : (jn0 < 4 ? 4 : (jn0 > NCH - 1 ? NCH - 1 : jn0));
#pragma unroll
      for (int i = 0; i < 2; ++i) {
        rk[i] = *(const u32x4*)(Kg + (size_t)(jn * 64 + lrow + i * 32) * 128 + lch * 8);
        rv[i] = *(const u32x4*)(Vg + (size_t)(lrow + i * 32) * TB + jn * 64 + lch * 8);
      }
    }
    f32x4 sc[4][2];
    __builtin_amdgcn_s_setprio(1);
#pragma unroll
    for (int mt = 0; mt < 4; ++mt) {
      const int r = mt * 16 + lr;
      const bf16x8 kf0 = *(const bf16x8*)(sK + r * 128 + ((lq ^ (r & 7)) << 4));
      const bf16x8 kf1 = *(const bf16x8*)(sK + r * 128 + (((4 + lq) ^ (r & 7)) << 4));
#pragma unroll
      for (int nt = 0; nt < 2; ++nt) {
        f32x4 a = {0.f, 0.f, 0.f, 0.f};
        a = MFMA16(kf0, qf[nt][0], a);
        a = MFMA16(kf1, qf[nt][1], a);
        sc[mt][nt] = a;
      }
    }
    __builtin_amdgcn_s_setprio(0);
    const bool domask = (type == 1) && !isctx && (jt >= 4);
#pragma unroll
    for (int nt = 0; nt < 2; ++nt) {
      if (domask) {
#pragma unroll
        for (int mt = 0; mt < 4; ++mt)
#pragma unroll
          for (int r = 0; r < 4; ++r) {
            const int kpos = jt * 64 + mt * 16 + lq * 4 + r, qpos = qloc0 + nt * 16 + lr;
            const int df = qpos - kpos;
            if (df > 128 || df < -128 || !tvalid) sc[mt][nt][r] = neg_big;
          }
      }
      float mx = fmaxf(fmaxf(sc[0][nt][0], sc[0][nt][1]), fmaxf(sc[0][nt][2], sc[0][nt][3]));
#pragma unroll
      for (int mt = 1; mt < 4; ++mt) mx = fmaxf(mx, fmaxf(fmaxf(sc[mt][nt][0], sc[mt][nt][1]), fmaxf(sc[mt][nt][2], sc[mt][nt][3])));
      mx = fmaxf(mx, __shfl_xor(mx, 16));
      mx = fmaxf(mx, __shfl_xor(mx, 32));
      if (__builtin_amdgcn_ballot_w64(mx > mrun[nt] + 8.f) != 0ull) {
        const float mnew = fmaxf(mrun[nt], mx);
        const float alpha = __builtin_amdgcn_exp2f(mrun[nt] - mnew);
        mrun[nt] = mnew;
#pragma unroll
        for (int r = 0; r < 4; ++r) Ls[nt][r] *= alpha;
#pragma unroll
        for (int mt = 0; mt < 4; ++mt)
#pragma unroll
          for (int r = 0; r < 4; ++r) O[mt][nt][r] *= alpha;
      }
      const float mref = mrun[nt];
#pragma unroll
      for (int mt = 0; mt < 4; ++mt)
#pragma unroll
        for (int r = 0; r < 4; ++r) sc[mt][nt][r] = __builtin_amdgcn_exp2f(sc[mt][nt][r] - mref);
    }
    bf16x8 pB[2][2];
#pragma unroll
    for (int nt = 0; nt < 2; ++nt) {
      pB[nt][0] = pack8(sc[0][nt], sc[1][nt]);
      pB[nt][1] = pack8(sc[2][nt], sc[3][nt]);
      Ls[nt] = MFMA16(ones8, pB[nt][0], Ls[nt]);
      Ls[nt] = MFMA16(ones8, pB[nt][1], Ls[nt]);
    }
    __builtin_amdgcn_s_setprio(1);
#pragma unroll
    for (int mt = 0; mt < 4; ++mt)
#pragma unroll
      for (int ks = 0; ks < 2; ++ks) {
        const bf16x4 v0 = *(const bf16x4*)(sV + (mt * 16 + lr) * 144 + ((2 * ks) * 16 + lq * 4) * 2);
        const bf16x4 v1 = *(const bf16x4*)(sV + (mt * 16 + lr) * 144 + ((2 * ks + 1) * 16 + lq * 4) * 2);
        const bf16x8 vfr = __builtin_shufflevector(v0, v1, 0, 1, 2, 3, 4, 5, 6, 7);
#pragma unroll
        for (int nt = 0; nt < 2; ++nt) O[mt][nt] = MFMA16(vfr, pB[nt][ks], O[mt][nt]);
      }
    __builtin_amdgcn_s_setprio(0);
    if (ti + 1 < ntiles) {
      char* dK = smem + ((ti + 1) & 1) * SB;
#pragma unroll
      for (int i = 0; i < 2; ++i) {
        const int r = lrow + i * 32;
        *(u32x4*)(dK + r * 128 + ((lch ^ (r & 7)) << 4)) = rk[i];
        *(u32x4*)(dK + KB + r * 144 + lch * 16) = rv[i];
      }
    }
    __syncthreads();
  }
  bf16_t* Y = (bf16_t*)(p.ws + OFF_YMIX);
#pragma unroll
  for (int nt = 0; nt < 2; ++nt) {
    const float inv = 1.f / Ls[nt][0];
    const size_t row = (size_t)b * TB + qloc0 + nt * 16 + lr;
#pragma unroll
    for (int mt = 0; mt < 4; ++mt) {
      uint2 v = {pk(O[mt][nt][0] * inv, O[mt][nt][1] * inv), pk(O[mt][nt][2] * inv, O[mt][nt][3] * inv)};
      *(uint2*)(Y + row * 1024 + (type ? 512 : 256) + qh * 64 + mt * 16 + lq * 4) = v;
    }
  }
}

DI void dnmerge_item(const Params& p, int l, int item) {
  const int tid = ltid();
  const int w = tid >> 6, lane = tid & 63;
  const int t = item * 4 + w;
  const float* o0 = (const float*)(p.ws + OFF_ODN) + (size_t)t * 256 + lane * 4;
  const float* o1 = o0 + (size_t)T * 256;
  const float4 a = *(const float4*)o0, bq = *(const float4*)o1;
  float v[4] = {a.x + bq.x, a.y + bq.y, a.z + bq.z, a.w + bq.w};
  float ss = v[0] * v[0] + v[1] * v[1] + v[2] * v[2] + v[3] * v[3];
  ss += __shfl_xor(ss, 1); ss += __shfl_xor(ss, 2); ss += __shfl_xor(ss, 4); ss += __shfl_xor(ss, 8);
  const float rs = rsqrtf(ss * (1.f / 64.f) + EPS);
  const int dim = (lane & 15) * 4;
  const float4 gn = *(const float4*)(p.dn_norm_g + l * 64 + dim);
  const uint2 zz = *(const uint2*)((const bf16_t*)(p.ws + OFF_Z) + (size_t)t * 256 + lane * 4);
  const float z0 = bflo(zz.x), z1 = bfhi(zz.x), z2 = bflo(zz.y), z3 = bfhi(zz.y);
  const float y0 = v[0] * rs * gn.x * silu_f(z0), y1 = v[1] * rs * gn.y * silu_f(z1), y2 = v[2] * rs * gn.z * silu_f(z2), y3 = v[3] * rs * gn.w * silu_f(z3);
  *(uint2*)((bf16_t*)(p.ws + OFF_YMIX) + (size_t)t * 1024 + lane * 4) = uint2{pk(y0, y1), pk(y2, y3)};
  if (lane == 0) { ((float*)(p.ws + OFF_RSS1))[t] = 0.f; ((float*)(p.ws + OFF_RSS2))[t] = 0.f; }
}


#define XB_TMO      128
#define XB_XCNT(j)  (256  + 64 * (j))
#define XB_XSUB(j)  (1280 + 64 * (j))
#define XB_XGEN(j)  (2304 + 64 * (j))
#define XB_TOP      3328
#define XB_TOPGEN   3392
#define XCD_BAR_WORDS 3456
#define XB_SPIN_CAP (1u << 18)
DI unsigned xb_ld(unsigned* p) { return __hip_atomic_load(p, __ATOMIC_RELAXED, __HIP_MEMORY_SCOPE_AGENT); }
DI unsigned xb_add(unsigned* p, unsigned v) { return __hip_atomic_fetch_add(p, v, __ATOMIC_RELAXED, __HIP_MEMORY_SCOPE_AGENT); }
DI unsigned xb_xcc_id() { return (unsigned)__builtin_amdgcn_s_getreg((3 << 11) | 20) & 0xFu; }
#define XB_SPIN(cond, bar) do { unsigned _sp = 0; while (cond) { __builtin_amdgcn_s_sleep(1); \
    if ((++_sp & 255u) == 0u) { if (xb_ld(&(bar)[XB_TMO])) break; if (_sp > XB_SPIN_CAP) { atomicAdd(&(bar)[XB_TMO], 1u); break; } } } } while (0)
struct XcdBarrier { unsigned* bar; unsigned x; volatile LAS unsigned* st; };
DI XcdBarrier xcd_barrier_post(unsigned* bar, volatile LAS unsigned* st) {
  XcdBarrier b; b.bar = bar; b.x = xb_xcc_id(); b.st = st;
  if (threadIdx.x == 0) (void)xb_add(&bar[XB_XCNT(b.x)], 1u);
  return b;
}
DI void xcd_barrier_complete(unsigned* bar, unsigned x, unsigned& nloc, unsigned& nx) {
  const unsigned G = gridDim.x * gridDim.y * gridDim.z;
  unsigned sum, cnt, mine, sp = 0u;
  for (;;) {
    sum = 0u; cnt = 0u; mine = 0u;
#pragma unroll
    for (unsigned j = 0; j < 16; ++j) { const unsigned c = xb_ld(&bar[XB_XCNT(j)]); sum += c; cnt += (c > 0u) ? 1u : 0u; mine = (j == x) ? c : mine; }
    if (sum == G) break;
    __builtin_amdgcn_s_sleep(1);
    if ((++sp & 255u) == 0u) { if (xb_ld(&bar[XB_TMO])) break; if (sp > XB_SPIN_CAP) { atomicAdd(&bar[XB_TMO], 1u); break; } }
  }
  nloc = mine > 0u ? mine : 1u; nx = cnt > 0u ? cnt : 1u;
}
DI void xcd_barrier(const XcdBarrier& b) {
  asm volatile("s_waitcnt vmcnt(0)" ::: "memory");
  __syncthreads();
  if (ltid_full() == 0) {
    unsigned* bar = b.bar;
    asm volatile("" : "+s"(bar));
    __builtin_amdgcn_s_waitcnt(0);
    unsigned nloc = b.st[0], nx = b.st[1];
    if (nloc == 0u) { xcd_barrier_complete(bar, b.x, nloc, nx); b.st[0] = nloc; b.st[1] = nx; }
    const unsigned old = xb_add(&bar[XB_XSUB(b.x)], 1u);
    const unsigned gen = old / nloc;
    if (old + 1u == (gen + 1u) * nloc) {
      __builtin_amdgcn_fence(__ATOMIC_RELEASE, "agent");
      asm volatile("s_waitcnt vmcnt(0)" ::: "memory");
      const unsigned og = xb_add(&bar[XB_TOP], 1u);
      const unsigned tg = og / nx;
      if (og + 1u == (tg + 1u) * nx) xb_add(&bar[XB_TOPGEN], 1u);
      else XB_SPIN(xb_ld(&bar[XB_TOPGEN]) == tg, bar);
      __builtin_amdgcn_fence(__ATOMIC_ACQUIRE, "agent");
      xb_add(&bar[XB_XGEN(b.x)], 1u);
      asm volatile("s_waitcnt vmcnt(0)" ::: "memory");
    } else {
      XB_SPIN(xb_ld(&bar[XB_XGEN(b.x)]) == gen, bar);
      __builtin_amdgcn_fence(__ATOMIC_ACQUIRE, "agent");
      asm volatile("s_waitcnt vmcnt(0)" ::: "memory");
    }
  }
  __syncthreads();
}


DI Params load_params(const volatile LAS unsigned* sp) {
  Params q;
  unsigned long long* dst = (unsigned long long*)&q;
#pragma unroll
  for (int i = 0; i < (int)(sizeof(Params) / 8); ++i) {
    const unsigned lo = (unsigned)__builtin_amdgcn_readfirstlane((int)sp[2 * i]), hi = (unsigned)__builtin_amdgcn_readfirstlane((int)sp[2 * i + 1]);
    dst[i] = ((unsigned long long)hi << 32) | lo;
  }
  return q;
}
#define GSYNC() do { XcdBarrier xb_; xb_.bar = (unsigned*)(q.ws + OFF_BAR); xb_.x = xb_xcc_id(); xb_.st = (volatile LAS unsigned*)&xb_words; xcd_barrier(xb_); } while (0)
__global__ void __launch_bounds__(512, 2) mega(Params p) {
  extern __shared__ __attribute__((aligned(1024))) char dsm[];
  __shared__ uint4 xb_words;
  __shared__ int s_item;
  cg::grid_group grid = cg::this_grid();
  __shared__ unsigned sparams[sizeof(Params) / 4];
  if (threadIdx.x == 0) xb_words = make_uint4(0u, 0u, 0u, 0u);
  if (threadIdx.x < sizeof(Params) / 4) sparams[threadIdx.x] = ((const unsigned*)&p)[threadIdx.x];
  __syncthreads();
  (void)xcd_barrier_post((unsigned*)(p.ws + OFF_BAR), (volatile LAS unsigned*)&xb_words);
  const int nblk = gridDim.x, bid = blockIdx.x;
  LAS char* lds = (LAS char*)dsm;
  phase0(p, dsm);
#if EXP == 6
  __syncthreads();
  phase0(p, dsm);
#endif
  if (p.ws == nullptr) grid.sync();
  { const Params q0 = load_params((const volatile LAS unsigned*)sparams); XcdBarrier xb_; xb_.bar = (unsigned*)(q0.ws + OFF_BAR); xb_.x = xb_xcc_id(); xb_.st = (volatile LAS unsigned*)&xb_words; xcd_barrier(xb_); }
  for (int l = 0; l < 4; ++l) {
    Params q = load_params((const volatile LAS unsigned*)sparams);
#define RELAUNDER() q = load_params((const volatile LAS unsigned*)sparams)
#define Hb ((const bf16_t*)(q.ws + OFF_HB))
    RELAUNDER();
    if (l == 0) {
      { const int hf = ltid_full() >> 8; char* smem = dsm + hf * HALF_SMEM; (void)smem;
      for (int pi = bid; pi < (T / 4 + 16 * 40) / 2; pi += nblk) {
        const int it = pi * 2 + hf;
        if (it < T / 4) norm_item(q, it);
        else { const int j = it - T / 4; wconv_tile<true>(q.w_in, nullptr, 2320, 1024, (bf16_t*)(q.ws + OFF_WIN), 0, j % 16, j / 16, smem, (const float*)(q.ws + OFF_MOD), (float*)(q.ws + OFF_BIAS1), 2560); }
      }
      }
      GSYNC();
    }
    RELAUNDER();
    gemm_phase8<EP_P>(q, l, Hb, (const bf16_t*)(q.ws + OFF_WIN), 1024, 136, 10, lds, 2);
#if EXP == 1
    gemm_phase<EP_P>(q, l, Hb, 1024, (const bf16_t*)(q.ws + OFF_WIN), 1024, 1024, 136, 10, lds);
#endif
    GSYNC();
    RELAUNDER();
    {
      int* ctrc = (int*)(q.ws + OFF_CTR) + 8 + l;
      constexpr int NPAIR = (NB * 4 * NCH + NB * NCH) / 2;
      while (true) {
        __syncthreads();
        if (ltid_full() == 0) s_item = atomicAdd(ctrc, 1);
        __syncthreads();
        const int pi = s_item;
        if (pi >= NPAIR) break;
        const int hf = ltid_full() >> 8; char* smem = dsm + hf * HALF_SMEM;
        const int it = pi * 2 + hf;
        if (it < NB * 4 * NCH) dnprep_item(q, l, it, smem, dsm);
        else aprep_item(q, l, it - NB * 4 * NCH, smem);
      }
    }
    GSYNC();
    RELAUNDER();
    {
    {
#if EXP == 2
      for (int rep = 0; rep < 2; ++rep) {
      int* ctr = (int*)(q.ws + OFF_CTR) + l + rep * 8;
#else
      {
      int* ctr = (int*)(q.ws + OFF_CTR) + l;
#endif
      constexpr int N_SCAN = 32, N_FT = 128, N_FTC = 8, N_GA = 512, N_WA = 512, N_CTXA = 64;
      constexpr int N_WO = 16 * 16 / 2, N_GU = 16 * 88 / 2, N_WD = 44 * 16 / 2, N_WI = 16 * 40 / 2;
      const int n_ctxa = l < 3 ? N_CTXA : 0;
      const int TOT = N_SCAN + N_FT + N_FTC + N_GA + N_WA + n_ctxa + N_WO + N_GU + N_WD + (l < 3 ? N_WI : 0);
      while (true) {
        __syncthreads();
        if (ltid_full() == 0) s_item = atomicAdd(ctr, 1);
        __syncthreads();
        int it = s_item;
        if (it >= TOT) break;
        const int hf = ltid_full() >> 8; char* smem = dsm + hf * HALF_SMEM;
        if (it < N_SCAN) { dnscan_item(q, it * 2 + hf, lds + hf * 65536); continue; }
        it -= N_SCAN;
        if (it < N_FT) { gemm8<EP_FT>(q, l, (const bf16_t*)(q.ws + OFF_ADFT), 4160, (const bf16_t*)(q.ws + OFF_BTFT), 4160, 4160, (it >> 3) * 256, (it & 7) * 256, lds); continue; }
        it -= N_FT;
        if (it < N_FTC) { gemm8<EP_FTC>(q, l, (const bf16_t*)(q.ws + OFF_ADFTC), 512, (const bf16_t*)(q.ws + OFF_BTFTC), 512, 512, 0, it * 256, lds); continue; }
        it -= N_FTC;
        if (it < N_GA) { const int j = it * 2 + hf; attn_item(q, l, 0, j >> 7, (j >> 6) & 1, 4 + (j & 63), smem); continue; }
        it -= N_GA;
        if (it < N_WA) { const int j = it * 2 + hf; attn_item(q, l, 1, j >> 7, (j >> 6) & 1, 4 + (j & 63), smem); continue; }
        it -= N_WA;
        if (it < n_ctxa) { const int j = it * 2 + hf; const int type = j >> 6, r = j & 63; attn_item(q, l, type, r >> 3, (r >> 2) & 1, r & 3, smem); continue; }
        it -= n_ctxa;
        {
          int j = it * 2 + hf;
          if (j < 2 * N_WO) { wconv_tile<false>(q.w_out + (size_t)l * 1024 * 1024, nullptr, 1024, 1024, (bf16_t*)(q.ws + OFF_WOUT), 0, j % 16, j / 16, smem); continue; }
          j -= 2 * N_WO;
          if (j < 2 * N_GU) { wconv_tile<true>(q.w_gate + (size_t)l * 1024 * HID, q.w_up + (size_t)l * 1024 * HID, HID, 1024, (bf16_t*)(q.ws + OFF_WGU), 1, j % 16, j / 16, smem,
                                     (const float*)(q.ws + OFF_MOD) + (size_t)l * 9 * 6144 + 3072, (float*)(q.ws + OFF_BIAS2) + (size_t)l * 9 * 5632, 5632); continue; }
          j -= 2 * N_GU;
          if (j < 2 * N_WD) { wconv_tile<false>(q.w_down + (size_t)l * HID * 1024, nullptr, 1024, HID, (bf16_t*)(q.ws + OFF_WD), 0, j % 44, j / 44, smem); continue; }
          j -= 2 * N_WD;
          wconv_tile<true>(q.w_in + (size_t)(l + 1) * 1024 * 2320, nullptr, 2320, 1024, (bf16_t*)(q.ws + OFF_WIN), 0, j % 16, j / 16, smem,
                           (const float*)(q.ws + OFF_MOD) + (size_t)(l + 1) * 9 * 6144, (float*)(q.ws + OFF_BIAS1) + (size_t)(l + 1) * 9 * 2560, 2560);
        }
      }
      }
    }
    }
    GSYNC();
    RELAUNDER();
    { const int hf = ltid_full() >> 8; char* smem = dsm + hf * HALF_SMEM; (void)smem;
    {
      for (int pi = bid; pi < T / 8; pi += nblk) dnmerge_item(q, l, pi * 2 + hf);
    }
    }
    GSYNC();
    RELAUNDER();
#if EXP == 1
    gemm_phase<EP_DUMMY>(q, l, (const bf16_t*)(q.ws + OFF_YMIX), 1024, (const bf16_t*)(q.ws + OFF_WOUT), 1024, 1024, 136, 4, lds);
#endif
    gemm_phase8<EP_RES1>(q, l, (const bf16_t*)(q.ws + OFF_YMIX), (const bf16_t*)(q.ws + OFF_WOUT), 1024, l == 3 ? 128 : 136, 4, lds, l == 3 ? 1 : 2);
    GSYNC();
    RELAUNDER();
    gemm_phase8<EP_GU>(q, l, Hb, (const bf16_t*)(q.ws + OFF_WGU), 1024, l == 3 ? 128 : 136, 22, lds, l == 3 ? 1 : 0);
#if EXP == 1
    gemm_phase<EP_GU>(q, l, Hb, 1024, (const bf16_t*)(q.ws + OFF_WGU), 1024, 1024, l == 3 ? 128 : 136, 22, lds, l == 3);
#endif
    GSYNC();
    RELAUNDER();
#if EXP == 1
    gemm_phase<EP_DUMMY>(q, l, (const bf16_t*)(q.ws + OFF_HM), HID, (const bf16_t*)(q.ws + OFF_WD), HID, HID, 136, 4, lds);
#endif
    gemm_phase8<EP_RES2>(q, l, (const bf16_t*)(q.ws + OFF_HM), (const bf16_t*)(q.ws + OFF_WD), HID, l == 3 ? 128 : 136, 4, lds, l == 3 ? 1 : 2);
    GSYNC();
  }
}

#undef Hb
extern "C" void kernel_launch(void* const* d_in, const int* in_sizes, int n_in, void* d_out, int out_size, void* d_ws, size_t ws_size,
                              hipStream_t stream) {
  if (ws_size < WS_NEED) { fprintf(stderr, "workspace too small: %zu < %zu\n", ws_size, (size_t)WS_NEED); return; }
  static int grid_blocks = 0;
  if (!grid_blocks) {
    int dev = 0, cus = 0, per_cu = 0;
    (void)hipGetDevice(&dev);
    (void)hipDeviceGetAttribute(&cus, hipDeviceAttributeMultiprocessorCount, dev);
    if (hipFuncSetAttribute((const void*)mega, hipFuncAttributeMaxDynamicSharedMemorySize, LDS_BYTES) != hipSuccess) fprintf(stderr, "hipFuncSetAttribute failed\n");
    (void)hipOccupancyMaxActiveBlocksPerMultiprocessor(&per_cu, mega, 512, LDS_BYTES);
    if (per_cu < 1) { fprintf(stderr, "occupancy query returned %d\n", per_cu); per_cu = 1; }
    grid_blocks = (cus / 8) * 8;
  }
  Params p{};
  const float** pf = (const float**)&p;
  for (int i = 0; i < 22; ++i) pf[i] = (const float*)d_in[i];
  p.out = (float*)d_out;
  p.ws = (char*)d_ws;
  (void)hipMemsetAsync((char*)d_ws + OFF_BAR, 0, XCD_BAR_WORDS * 4, stream);
  void* args[] = {&p};
  hipError_t e = hipLaunchCooperativeKernel((void*)mega, dim3(grid_blocks), dim3(512), args, LDS_BYTES, stream);
  if (e != hipSuccess) fprintf(stderr, "cooperative launch failed: %s (grid %d)\n", hipGetErrorString(e), grid_blocks);
}
```
